# Optimizing an MI355X kernel written in HIP

```python
import jax, jax.numpy as jnp
from jax import lax
import numpy as np

D_MODEL = 1024
BATCH = 8
SEQ = 4096
DEPTH = 4

CHUNK = 64
GMLP_BLOCK = 128
GMLP_GROUPS = 8
GMLP_WIDTH = D_MODEL
GMLP_GROUP_DIM = GMLP_WIDTH // GMLP_GROUPS
LRU_WIDTH = D_MODEL
LRU_HEADS = 8
LRU_HEAD_DIM = LRU_WIDTH // LRU_HEADS
LRU_C = 8.0
CONV_WIDTH = 4
MEM_LEN = 256
MEM_HEADS = 4
MEM_HEAD_DIM = D_MODEL // MEM_HEADS
MEM_WIDTH = MEM_HEADS * MEM_HEAD_DIM
N_BRANCH = 3
EPS = 1e-6
IN_SPLITS = (GMLP_WIDTH, GMLP_WIDTH, GMLP_WIDTH, LRU_WIDTH, LRU_WIDTH, MEM_WIDTH, MEM_WIDTH, N_BRANCH * D_MODEL)
IN_WIDTH = sum(IN_SPLITS)

kernel_name = 'hybrid_gmlp_rglru_memxattn_trunk'


def _rmsnorm(x, g):
    xf = x.astype(jnp.float32)
    y = xf * lax.rsqrt(jnp.mean(xf * xf, axis=-1, keepdims=True) + EPS)
    return (y * g.astype(jnp.float32)).astype(x.dtype)


def _layernorm(x, g, b):
    xf = x.astype(jnp.float32)
    mu = jnp.mean(xf, axis=-1, keepdims=True)
    var = jnp.mean(jnp.square(xf - mu), axis=-1, keepdims=True)
    y = (xf - mu) * lax.rsqrt(var + EPS)
    return (y * g.astype(jnp.float32) + b.astype(jnp.float32)).astype(x.dtype)


def _split_columns(z):
    idx, acc = [], 0
    for w in IN_SPLITS[:-1]:
        acc += w
        idx.append(acc)
    return jnp.split(z, idx, axis=-1)


def _gmlp_spatial(u, v, ln_g, ln_b, ws, bs):
    b, s, _ = u.shape
    n = s // GMLP_BLOCK
    vn = _layernorm(v, ln_g, ln_b).reshape(b, n, GMLP_BLOCK, GMLP_GROUPS, GMLP_GROUP_DIM)
    chunk_id = jnp.arange(GMLP_BLOCK) // CHUNK
    mask = chunk_id[:, None] >= chunk_id[None, :]
    w = jnp.where(mask[None], ws, jnp.zeros_like(ws))
    sv = jnp.einsum('gij,bnjgc->bnigc', w, vn) + jnp.transpose(bs)[None, None, :, :, None]
    return u * sv.reshape(b, s, GMLP_WIDTH)


def _rg_lru(xb, conv_w, conv_b, wr, br, wi, bi, lam):
    b, s, _ = xb.shape
    xp = jnp.pad(xb, ((0, 0), (CONV_WIDTH - 1, 0), (0, 0)))
    xc = conv_b + sum(xp[:, k:k + s] * conv_w[k] for k in range(CONV_WIDTH))
    xh = xc.reshape(b, s, LRU_HEADS, LRU_HEAD_DIM)
    r = jax.nn.sigmoid(jnp.einsum('bshc,hcd->bshd', xh, wr).reshape(b, s, LRU_WIDTH) + br)
    i = jax.nn.sigmoid(jnp.einsum('bshc,hcd->bshd', xh, wi).reshape(b, s, LRU_WIDTH) + bi)
    log_a = -LRU_C * r.astype(jnp.float32) * jax.nn.softplus(-lam.astype(jnp.float32))
    a = jnp.exp(log_a)
    mult = jnp.sqrt(-jnp.expm1(2.0 * log_a))
    u = mult * (i * xc).astype(jnp.float32)

    def combine(left, right):
        a1, h1 = left
        a2, h2 = right
        return a1 * a2, a2 * h1 + h2

    _, h = lax.associative_scan(combine, (a, u), axis=1)
    return h.astype(xb.dtype)


def _mem_attention(q, k, v):
    b, s, _ = q.shape
    qh = q.reshape(b, s, MEM_HEADS, MEM_HEAD_DIM)
    kh = k.reshape(b, MEM_LEN, MEM_HEADS, MEM_HEAD_DIM)
    vh = v.reshape(b, MEM_LEN, MEM_HEADS, MEM_HEAD_DIM)
    scores = jnp.einsum('bshd,bmhd->bhsm', qh, kh).astype(jnp.float32) * (MEM_HEAD_DIM ** -0.5)
    p = jax.nn.softmax(scores, axis=-1).astype(v.dtype)
    return jnp.einsum('bhsm,bmhd->bshd', p, vh).reshape(b, s, MEM_WIDTH)


def setup_inputs(seed: int = 0) -> dict:
    key = jax.random.key(seed)
    ks = jax.random.split(key, 32)

    def nrm(k, shape, scale):
        return jax.random.normal(k, shape, jnp.float32) * scale

    L = DEPTH
    u_a = jax.random.uniform(ks[20], (L, LRU_WIDTH), jnp.float32, 0.9, 0.999)
    a_base = u_a ** (1.0 / LRU_C)
    lru_lambda = jnp.log(a_base) - jnp.log1p(-a_base)
    return {
        'x': nrm(ks[0], (BATCH, SEQ, D_MODEL), 1.0),
        'mem': nrm(ks[1], (BATCH, MEM_LEN, D_MODEL), 1.0),
        'mem_norm_g': 1.0 + nrm(ks[2], (D_MODEL,), 0.05),
        'pre_norm_g': 1.0 + nrm(ks[3], (L, D_MODEL), 0.05),
        'post_norm_g': 1.0 + nrm(ks[4], (L, D_MODEL), 0.05),
        'w_in': nrm(ks[5], (L, D_MODEL, IN_WIDTH), D_MODEL ** -0.5),
        'gmlp_ln_g': 1.0 + nrm(ks[6], (L, GMLP_WIDTH), 0.05),
        'gmlp_ln_b': nrm(ks[7], (L, GMLP_WIDTH), 0.02),
        'gmlp_ws': nrm(ks[8], (L, GMLP_GROUPS, GMLP_BLOCK, GMLP_BLOCK), GMLP_BLOCK ** -0.5),
        'gmlp_bs': 1.0 + nrm(ks[9], (L, GMLP_GROUPS, GMLP_BLOCK), 0.05),
        'conv_w': nrm(ks[10], (L, CONV_WIDTH, LRU_WIDTH), CONV_WIDTH ** -0.5),
        'conv_b': nrm(ks[11], (L, LRU_WIDTH), 0.02),
        'lru_wr': nrm(ks[12], (L, LRU_HEADS, LRU_HEAD_DIM, LRU_HEAD_DIM), LRU_HEAD_DIM ** -0.5),
        'lru_br': nrm(ks[13], (L, LRU_WIDTH), 0.02),
        'lru_wi': nrm(ks[14], (L, LRU_HEADS, LRU_HEAD_DIM, LRU_HEAD_DIM), LRU_HEAD_DIM ** -0.5),
        'lru_bi': nrm(ks[15], (L, LRU_WIDTH), 0.02),
        'lru_lambda': lru_lambda,
        'w_kv': nrm(ks[16], (L, D_MODEL, 2 * MEM_WIDTH), D_MODEL ** -0.5),
        'w_pa': nrm(ks[17], (L, GMLP_WIDTH, D_MODEL), GMLP_WIDTH ** -0.5),
        'w_pb': nrm(ks[18], (L, LRU_WIDTH, D_MODEL), LRU_WIDTH ** -0.5),
        'w_pc': nrm(ks[19], (L, MEM_WIDTH, D_MODEL), MEM_WIDTH ** -0.5),
        'w_out': nrm(ks[21], (L, D_MODEL, D_MODEL), D_MODEL ** -0.5),
    }


def reference(x, mem, mem_norm_g, pre_norm_g, post_norm_g, w_in, gmlp_ln_g, gmlp_ln_b, gmlp_ws, gmlp_bs,
              conv_w, conv_b, lru_wr, lru_br, lru_wi, lru_bi, lru_lambda, w_kv, w_pa, w_pb, w_pc, w_out):
    b, s, _ = x.shape
    mem_n = _rmsnorm(mem, mem_norm_g)
    for l in range(DEPTH):
        h = _rmsnorm(x, pre_norm_g[l])
        z = h @ w_in[l]
        u, v, g_a, xb, g_b, q, g_c, merge_logits = _split_columns(z)
        y_a = _gmlp_spatial(u, v, gmlp_ln_g[l], gmlp_ln_b[l], gmlp_ws[l], gmlp_bs[l]) * jax.nn.silu(g_a)
        y_b = _rg_lru(xb, conv_w[l], conv_b[l], lru_wr[l], lru_br[l], lru_wi[l], lru_bi[l], lru_lambda[l]) * jax.nn.silu(g_b)
        k_m, v_m = jnp.split(mem_n @ w_kv[l], 2, axis=-1)
        y_c = _mem_attention(q, k_m, v_m) * jax.nn.silu(g_c)
        gates = jax.nn.sigmoid(merge_logits).reshape(b, s, N_BRANCH, D_MODEL)
        merged = (gates[:, :, 0] * (y_a @ w_pa[l])
                  + gates[:, :, 1] * (y_b @ w_pb[l])
                  + gates[:, :, 2] * (y_c @ w_pc[l]))
        x = x + _rmsnorm(merged @ w_out[l], post_norm_g[l])
    return x
```

```cpp
#include <hip/hip_runtime.h>
#include <hip/hip_cooperative_groups.h>
#include <cstdio>
#include <cstdint>
namespace cg = cooperative_groups;

#ifndef MK_MULTI
#define MK_MULTI 1
#endif

#ifndef PH_MASK
#define PH_MASK 0x3FF
#endif
#define LAS __attribute__((address_space(3)))
typedef unsigned short bf16_t;
typedef short bf16x8 __attribute__((ext_vector_type(8)));
typedef short s16x4 __attribute__((ext_vector_type(4)));
typedef float f32x4 __attribute__((ext_vector_type(4)));
typedef float f32x2 __attribute__((ext_vector_type(2)));
typedef float f32x16 __attribute__((ext_vector_type(16)));
typedef unsigned u32x4 __attribute__((ext_vector_type(4)));
typedef unsigned u32x2 __attribute__((ext_vector_type(2)));

constexpr int D = 1024, NB = 8, SEQ = 4096, DEPTH = 4, NT = NB * SEQ;
constexpr int NCH = 2, TC = NT / NCH, BPC = NB / NCH;
constexpr int INW = 10240, MEML = 256, MROWS = NB * MEML;
constexpr float EPS = 1e-6f;
constexpr int NTHR = 512;

constexpr size_t MiB = 1u << 20;
constexpr size_t WS_STATS = 0;
constexpr size_t WS_AGG = 256 * 1024;
constexpr size_t WS_WIN = 1 * MiB;
constexpr size_t WS_WP = 81 * MiB;
constexpr size_t WS_WOUT = 105 * MiB;
constexpr size_t WS_WLRU = 113 * MiB;
constexpr size_t WS_WG = 115 * MiB;
constexpr size_t WS_KM = 116 * MiB;
constexpr size_t WS_VT = 132 * MiB;
constexpr size_t WS_H = 148 * MiB;
constexpr size_t WS_Z = 180 * MiB;
constexpr size_t ZSLOT = (size_t)TC * D * 2;
constexpr size_t WS_WKV = WS_Z;
constexpr size_t WS_MEMN = WS_Z + 16 * MiB;
constexpr size_t WS_END = WS_Z + 10 * ZSLOT;

constexpr int LDS_BYTES = 147456;

__device__ __forceinline__ unsigned cvt_pk_bf16(float lo, float hi) { unsigned r; asm volatile("v_cvt_pk_bf16_f32 %0, %1, %2" : "=v"(r) : "v"(lo), "v"(hi)); return r; }
__device__ __forceinline__ float bflo(unsigned w) { return __uint_as_float(w << 16); }
__device__ __forceinline__ float bfhi(unsigned w) { return __uint_as_float(w & 0xffff0000u); }
__device__ __forceinline__ float bf1(bf16_t b) { return __uint_as_float(((unsigned)b) << 16); }
__device__ __forceinline__ bf16_t f2bf(float f) { return (bf16_t)(cvt_pk_bf16(f, 0.f) & 0xffffu); }
__device__ __forceinline__ float wave_sum(float v) {
#pragma unroll
    for (int o = 1; o < 64; o <<= 1) v += __shfl_xor(v, o);
    return v;
}
__device__ __forceinline__ int otid() { int t = threadIdx.x; asm volatile("" : "+v"(t)); return t; }
__device__ __forceinline__ float sigm(float x) { return 1.0f / (1.0f + __expf(-x)); }
__device__ __forceinline__ float silu(float x) { return x / (1.0f + __expf(-x)); }

namespace pg8 {
constexpr int BM = 256, BK = 64, HALF = 128, HTB = HALF * BK * 2, STAGE_BYTES = 8 * HTB, NXCD = 8, WGM = 8;
__host__ __device__ __forceinline__ int lds_byte(int r, int c) { const int st = (r >> 4) * 2 + (c >> 5), rr = r & 15, cc = c & 31, ob = rr * 64 + cc * 2; return st * 1024 + (ob ^ (((ob >> 9) & 1) << 5)); }
__host__ __device__ __forceinline__ void stage_rc(int b, int& R, int& C) { const int st = b / 1024, sb = b % 1024, swz = sb ^ (((sb >> 9) & 1) << 5); R = (st >> 1) * 16 + swz / 64; C = (st & 1) * 32 + (swz % 64) / 2; }
__host__ __device__ __forceinline__ int perm32(int rho) { const int n = rho >> 4, i = rho & 15; return 8 * (i >> 2) + 4 * n + (i & 3); }

struct Unit { const char* A; const char* B; int r0, c0, aux; };

template <class Epi, class Sched, bool ALIGN_EPI>
__device__ __forceinline__ void gemm_phase(LAS unsigned char* lds, const int K, const Sched& S, const Epi& E) {
    const int tid = otid(), wid = __builtin_amdgcn_readfirstlane(tid >> 6), lane = tid & 63, wr = wid >> 2, wc = wid & 3, fr = lane & 15, fq = lane >> 4;
    const int nt = K / BK;
    unsigned voffA[2], voffB[2];
#pragma unroll
    for (int i = 0; i < 2; ++i) { int R, C; stage_rc(tid * 16 + i * 8192, R, C); const int Rb = Epi::PERM ? ((R & ~31) + perm32(R & 31)) : R;
        voffA[i] = (unsigned)(R * K + C) * 2u; voffB[i] = (unsigned)(Rb * K + C) * 2u; }
    const size_t kstep = (size_t)(BK * 2);
    const size_t hstep = (size_t)HALF * K * 2;
    const unsigned ldsw = (unsigned)wid * 1024u;
    const int aoff = lds_byte(wr * 64 + fr, fq * 8), boff = lds_byte(wc * 32 + fr, fq * 8);
#define PG8_SA(b, h) (((b) * 2 + (h)) * HTB)
#define PG8_SB(b, h) ((4 + (b) * 2 + (h)) * HTB)
#define PG8_STAGE(bufoff, gbase, voff) do { _Pragma("unroll") for (int _i = 0; _i < 2; ++_i) \
        __builtin_amdgcn_global_load_lds((const unsigned*)((const char*)(gbase) + (voff)[_i]), (LAS unsigned*)(lds + (bufoff) + ldsw + _i * 8192), 16, 0, 0); } while (0)
#define PG8_LDA(dst, b, h) do { _Pragma("unroll") for (int m = 0; m < 4; ++m) _Pragma("unroll") for (int k = 0; k < 2; ++k) dst[m][k] = *(const LAS bf16x8*)(lds + PG8_SA(b, h) + aoff + m * 2048 + k * 1024); } while (0)
#define PG8_LDB(dst, b, h) do { _Pragma("unroll") for (int n = 0; n < 2; ++n) _Pragma("unroll") for (int k = 0; k < 2; ++k) dst[n][k] = *(const LAS bf16x8*)(lds + PG8_SB(b, h) + boff + n * 2048 + k * 1024); } while (0)
#define PG8_MMA(ai, bj, At, Bt) do { __builtin_amdgcn_s_setprio(1); _Pragma("unroll") for (int m = 0; m < 4; ++m) _Pragma("unroll") for (int n = 0; n < 2; ++n) _Pragma("unroll") for (int k = 0; k < 2; ++k) \
        acc[ai][bj][m][n] = __builtin_amdgcn_mfma_f32_16x16x32_bf16(Bt[n][k], At[m][k], acc[ai][bj][m][n], 0, 0, 0); __builtin_amdgcn_s_setprio(0); } while (0)
#define PG8_WAIT_V(n) asm volatile("s_waitcnt vmcnt(" #n ")" ::: "memory")
#define PG8_WAIT_L(n) asm volatile("s_waitcnt lgkmcnt(" #n ")" ::: "memory")
#define PG8_BAR __builtin_amdgcn_s_barrier()
#define PG8_SCHED __builtin_amdgcn_sched_barrier(0)
    Unit cur, nxt; int ui = 0;
    if (!S.next(0, cur)) return;
    f32x4 acc[2][2][4][2];
#pragma unroll
    for (int a = 0; a < 2; ++a)
#pragma unroll
        for (int b = 0; b < 2; ++b)
#pragma unroll
            for (int m = 0; m < 4; ++m)
#pragma unroll
                for (int n = 0; n < 2; ++n) acc[a][b][m][n] = (f32x4){0.f, 0.f, 0.f, 0.f};
    bf16x8 At[4][2], B0[2][2], B1[2][2];
    const char* cA = cur.A; const char* cB = cur.B;
    PG8_STAGE(PG8_SB(0, 0), cB, voffB); PG8_STAGE(PG8_SB(0, 1), cB + hstep, voffB); PG8_STAGE(PG8_SA(0, 0), cA, voffA); PG8_STAGE(PG8_SA(0, 1), cA + hstep, voffA);
    if (wr == 1) PG8_BAR;
    PG8_WAIT_V(2); PG8_BAR;
    PG8_STAGE(PG8_SB(1, 0), cB + kstep, voffB); PG8_STAGE(PG8_SA(1, 0), cA + kstep, voffA); PG8_STAGE(PG8_SB(1, 1), cB + hstep + kstep, voffB);
    PG8_WAIT_V(6); PG8_BAR;
    for (;;) {
        const bool has_next = S.next(ui + 1, nxt);
        const char* nA = has_next ? nxt.A : cA; const char* nB = has_next ? nxt.B : cB;
        for (int t = 0; t < nt; t += 2) {
            const bool last = (t == nt - 2);
            const char* a1 = cA + (size_t)(t + 1) * kstep;
            const char* a2 = last ? nA : cA + (size_t)(t + 2) * kstep; const char* b2 = last ? nB : cB + (size_t)(t + 2) * kstep;
            const char* a3 = a2 + kstep; const char* b3 = b2 + kstep;
            PG8_LDB(B0, 0, 0); PG8_LDB(B1, 0, 1); PG8_SCHED; PG8_LDA(At, 0, 0); PG8_STAGE(PG8_SA(1, 1), a1 + hstep, voffA);
            PG8_WAIT_V(8); PG8_WAIT_L(0); PG8_BAR; PG8_MMA(0, 0, At, B0); PG8_MMA(0, 1, At, B1); PG8_BAR; PG8_SCHED;
            PG8_LDA(At, 0, 1); PG8_STAGE(PG8_SB(0, 0), b2, voffB); PG8_STAGE(PG8_SB(0, 1), b2 + hstep, voffB); PG8_STAGE(PG8_SA(0, 0), a2, voffA);
            PG8_WAIT_V(8); PG8_WAIT_L(0); PG8_BAR; PG8_MMA(1, 0, At, B0); PG8_MMA(1, 1, At, B1); PG8_BAR; PG8_SCHED;
            PG8_LDB(B0, 1, 0); PG8_LDB(B1, 1, 1); PG8_SCHED; PG8_LDA(At, 1, 0); PG8_STAGE(PG8_SA(0, 1), a2 + hstep, voffA);
            PG8_WAIT_V(8); PG8_WAIT_L(0); PG8_BAR; PG8_MMA(0, 0, At, B0); PG8_MMA(0, 1, At, B1); PG8_BAR; PG8_SCHED;
            PG8_LDA(At, 1, 1); PG8_STAGE(PG8_SB(1, 0), b3, voffB); PG8_STAGE(PG8_SB(1, 1), b3 + hstep, voffB); PG8_STAGE(PG8_SA(1, 0), a3, voffA);
            PG8_WAIT_V(8); PG8_WAIT_L(0); PG8_BAR; PG8_MMA(1, 0, At, B0); PG8_MMA(1, 1, At, B1); PG8_BAR; PG8_SCHED;
        }
        if constexpr (ALIGN_EPI) { if (wr == 0) PG8_BAR; }
        const bool zero = E(acc, cur, wr, wc, fr, fq);
        if (!has_next) break;
        if (zero) {
#pragma unroll
            for (int a = 0; a < 2; ++a)
#pragma unroll
                for (int b = 0; b < 2; ++b)
#pragma unroll
                    for (int m = 0; m < 4; ++m)
#pragma unroll
                        for (int n = 0; n < 2; ++n) acc[a][b][m][n] = (f32x4){0.f, 0.f, 0.f, 0.f};
        }
        cur = nxt; cA = nA; cB = nB; ++ui;
        if constexpr (ALIGN_EPI) { if (wr == 1) PG8_BAR; }
    }
    PG8_WAIT_V(0);
    if constexpr (!ALIGN_EPI) { if (wr == 0) PG8_BAR; }
    PG8_BAR;
#undef PG8_SA
#undef PG8_SB
#undef PG8_STAGE
#undef PG8_LDA
#undef PG8_LDB
#undef PG8_MMA
#undef PG8_WAIT_V
#undef PG8_WAIT_L
#undef PG8_BAR
#undef PG8_SCHED
}

struct EpiBf16 {
    static constexpr bool PERM = true;
    bf16_t* O; int ldc; size_t split_stride; int split;
    __device__ __forceinline__ bool operator()(f32x4 (&acc)[2][2][4][2], const Unit& u, int wr, int wc, int fr, int fq) const {
        const int row0 = u.r0 + wr * 64 + fr; int colt = u.c0; bf16_t* base = O;
        if (split) { const int t = colt >> 10; base += (size_t)t * split_stride; colt &= 1023; }
        const int col0 = colt + wc * 32 + 8 * fq;
#pragma unroll
        for (int ai = 0; ai < 2; ++ai)
#pragma unroll
            for (int m = 0; m < 4; ++m) { bf16_t* rowp = base + (size_t)(row0 + ai * HALF + m * 16) * ldc + col0;
#pragma unroll
                for (int bj = 0; bj < 2; ++bj) { const f32x4 v0 = acc[ai][bj][m][0], v1 = acc[ai][bj][m][1];
                    u32x4 w; w.x = cvt_pk_bf16(v0[0], v0[1]); w.y = cvt_pk_bf16(v0[2], v0[3]); w.z = cvt_pk_bf16(v1[0], v1[1]); w.w = cvt_pk_bf16(v1[2], v1[3]);
                    *(u32x4*)(rowp + bj * HALF) = w; } }
        return true;
    }
};
struct EpiKV {
    static constexpr bool PERM = true;
    bf16_t* KM; bf16_t* VT;
    __device__ __forceinline__ bool operator()(f32x4 (&acc)[2][2][4][2], const Unit& u, int wr, int wc, int fr, int fq) const {
        const int l = u.aux >> 1, isv = u.aux & 1; const int ldc = isv ? MROWS : D;
        bf16_t* base = (isv ? VT : KM) + (size_t)l * MROWS * D;
        const int row0 = u.r0 + wr * 64 + fr, col0 = u.c0 + wc * 32 + 8 * fq;
#pragma unroll
        for (int ai = 0; ai < 2; ++ai)
#pragma unroll
            for (int m = 0; m < 4; ++m) { bf16_t* rowp = base + (size_t)(row0 + ai * HALF + m * 16) * ldc + col0;
#pragma unroll
                for (int bj = 0; bj < 2; ++bj) { const f32x4 v0 = acc[ai][bj][m][0], v1 = acc[ai][bj][m][1];
                    u32x4 w; w.x = cvt_pk_bf16(v0[0], v0[1]); w.y = cvt_pk_bf16(v0[2], v0[3]); w.z = cvt_pk_bf16(v1[0], v1[1]); w.w = cvt_pk_bf16(v1[2], v1[3]);
                    *(u32x4*)(rowp + bj * HALF) = w; } }
        return true;
    }
};
struct EpiF32 {
    static constexpr bool PERM = false;
    float* C;
    __device__ __forceinline__ bool operator()(f32x4 (&acc)[2][2][4][2], const Unit& u, int wr, int wc, int fr, int fq) const {
        const int row0 = u.r0 + wr * 64 + fr, col0 = u.c0 + wc * 32 + 4 * fq;
#pragma unroll
        for (int ai = 0; ai < 2; ++ai)
#pragma unroll
            for (int m = 0; m < 4; ++m) { float* rowp = C + (size_t)(row0 + ai * HALF + m * 16) * D + col0;
#pragma unroll
                for (int bj = 0; bj < 2; ++bj)
#pragma unroll
                    for (int n = 0; n < 2; ++n) *(f32x4*)(rowp + bj * HALF + n * 16) = acc[ai][bj][m][n]; }
        return true;
    }
};
struct EpiMerge {
    static constexpr bool PERM = true;
    const bf16_t* ML;
    bf16_t* O;
    __device__ __forceinline__ bool operator()(f32x4 (&acc)[2][2][4][2], const Unit& u, int wr, int wc, int fr, int fq) const {
        const int sub = u.aux;
        const int row0 = u.r0 + wr * 64 + fr, col0 = u.c0 + wc * 32 + 8 * fq;
        const bf16_t* l0 = ML + (size_t)sub * TC * D;
#pragma unroll
        for (int ai = 0; ai < 2; ++ai)
#pragma unroll
            for (int m = 0; m < 4; ++m) { const size_t off = (size_t)(row0 + ai * HALF + m * 16) * D + col0;
#pragma unroll
                for (int bj = 0; bj < 2; ++bj) {
                    const u32x4 a = *(const u32x4*)(l0 + off + bj * HALF);
                    float la[8] = {bflo(a.x), bfhi(a.x), bflo(a.y), bfhi(a.y), bflo(a.z), bfhi(a.z), bflo(a.w), bfhi(a.w)};
                    float f[8];
                    if (sub < 2) {
                        const u32x4 b = *(const u32x4*)(l0 + (size_t)TC * D + off + bj * HALF);
                        float lb[8] = {bflo(b.x), bfhi(b.x), bflo(b.y), bfhi(b.y), bflo(b.z), bfhi(b.z), bflo(b.w), bfhi(b.w)};
#pragma unroll
                        for (int j = 0; j < 8; ++j) { const float ea = __expf(-fminf(fmaxf(la[j], -60.f), 60.f)), eb = __expf(-fminf(fmaxf(lb[j], -60.f), 60.f)); f[j] = (1.0f + eb) / (1.0f + ea); }
                    } else {
#pragma unroll
                        for (int j = 0; j < 8; ++j) f[j] = 1.0f / (1.0f + __expf(-fminf(fmaxf(la[j], -60.f), 60.f)));
                    }
                    f32x4 v0 = acc[ai][bj][m][0], v1 = acc[ai][bj][m][1];
                    v0[0] *= f[0]; v0[1] *= f[1]; v0[2] *= f[2]; v0[3] *= f[3]; v1[0] *= f[4]; v1[1] *= f[5]; v1[2] *= f[6]; v1[3] *= f[7];
                    if (sub < 2) { acc[ai][bj][m][0] = v0; acc[ai][bj][m][1] = v1; }
                    else { u32x4 w; w.x = cvt_pk_bf16(v0[0], v0[1]); w.y = cvt_pk_bf16(v0[2], v0[3]); w.z = cvt_pk_bf16(v1[0], v1[1]); w.w = cvt_pk_bf16(v1[2], v1[3]);
                        *(u32x4*)(O + off + bj * HALF) = w; }
                } }
        return sub == 2;
    }
};

struct SchedGrid {
    const char* A; const char* B; int nM, nN, nwg, G, c; size_t tstep;
    __device__ __forceinline__ bool next(int i, Unit& u) const {
        const long L = (long)i * G + c; if (L >= nwg) return false;
        int wgid = (int)L; { const int q = nwg / NXCD, r = nwg % NXCD, xcd = wgid % NXCD, off = wgid / NXCD; wgid = (xcd < r ? xcd * (q + 1) : r * (q + 1) + (xcd - r) * q) + off; }
        const int nig = WGM * nN, gid = wgid / nig, fm = gid * WGM, gsz = (nM - fm) < WGM ? (nM - fm) : WGM;
        const int pm = fm + ((wgid % nig) % gsz), pn = (wgid % nig) / gsz;
        u.A = A + (size_t)pm * tstep; u.B = B + (size_t)pn * tstep; u.r0 = pm * BM; u.c0 = pn * BM; u.aux = 0; return true;
    }
};
struct SchedKV {
    const char* MEMN; const char* WKV; int G, c;
    __device__ __forceinline__ bool next(int i, Unit& u) const {
        const int id = i * G + c; if (id >= 256) return false;
        const size_t tstep = (size_t)BM * D * 2;
        const int l = id >> 6, r = id & 63; const char* w = WKV + (size_t)l * 2048 * D * 2;
        if (r < 32) { const int pm = r >> 2, pn = r & 3; u.A = MEMN + pm * tstep; u.B = w + pn * tstep; u.r0 = pm * BM; u.c0 = pn * BM; u.aux = l << 1; }
        else { const int rr = r - 32, pm = rr >> 3, pn = rr & 7; u.A = w + (size_t)(4 + pm) * tstep; u.B = MEMN + pn * tstep; u.r0 = pm * BM; u.c0 = pn * BM; u.aux = (l << 1) | 1; }
        return true;
    }
};
struct SchedMerge {
    const char* Z; const char* WP; int G, c;
    __device__ __forceinline__ bool next(int i, Unit& u) const {
        const int tile = (i / 3) * G + c, sub = i % 3; if (tile >= (TC / BM) * 4) return false;
        const size_t tstep = (size_t)BM * D * 2;
        const int pm = tile >> 2, pn = tile & 3; const int slot = sub == 0 ? 0 : (sub == 1 ? 4 : 6);
        u.A = Z + (size_t)slot * ZSLOT + pm * tstep; u.B = WP + (size_t)sub * D * D * 2 + pn * tstep; u.r0 = pm * BM; u.c0 = pn * BM; u.aux = sub; return true;
    }
};
}

struct Params { const float* in[22]; float* out; unsigned char* ws; int ph_lo, ph_hi; };
enum { I_X = 0, I_MEM, I_MEMG, I_PREG, I_POSTG, I_WIN, I_LNG, I_LNB, I_WS, I_BS, I_CONVW, I_CONVB, I_WR, I_BR, I_WI, I_BI, I_LAM, I_WKV, I_WPA, I_WPB, I_WPC, I_WOUT };

__device__ __forceinline__ void transpose_item(const float* W, int ldw, bf16_t* WT, int ldt, int nblk, LAS float* scr, int item, int lane) {
    const int kb = item / nblk, nb = item % nblk, k0 = 64 * kb, n0 = 32 * nb;
#pragma unroll 8
    for (int i = 0; i < 32; ++i) { const int kk = 2 * i + (lane >> 5); scr[kk * 33 + (lane & 31)] = W[(size_t)(k0 + kk) * ldw + n0 + (lane & 31)]; }
    asm volatile("s_waitcnt lgkmcnt(0)" ::: "memory");
    const int c = lane & 7;
#pragma unroll
    for (int j = 0; j < 4; ++j) { const int n = (lane >> 3) + 8 * j; const LAS float* s = scr + (8 * c) * 33 + n;
        u32x4 o; o.x = cvt_pk_bf16(s[0 * 33], s[1 * 33]); o.y = cvt_pk_bf16(s[2 * 33], s[3 * 33]); o.z = cvt_pk_bf16(s[4 * 33], s[5 * 33]); o.w = cvt_pk_bf16(s[6 * 33], s[7 * 33]);
        *(u32x4*)(WT + (size_t)(n0 + n) * ldt + k0 + 8 * c) = o; }
    asm volatile("s_waitcnt lgkmcnt(0)" ::: "memory");
}
__device__ __forceinline__ void rms_row_to_bf16(const float* xrow, const float* g, bf16_t* orow, int lane) {
    const f32x4* xr = (const f32x4*)xrow + lane; const f32x4* gr = (const f32x4*)g + lane;
    f32x4 v[4]; float s = 0.f;
#pragma unroll
    for (int j = 0; j < 4; ++j) { v[j] = xr[64 * j]; s += (v[j].x * v[j].x + v[j].y * v[j].y) + (v[j].z * v[j].z + v[j].w * v[j].w); }
    const float r = 1.0f / sqrtf(wave_sum(s) * (1.0f / D) + EPS);
    u32x2* o8 = (u32x2*)orow + lane;
#pragma unroll
    for (int j = 0; j < 4; ++j) { const f32x4 gv = gr[64 * j]; u32x2 w; w.x = cvt_pk_bf16(v[j].x * r * gv.x, v[j].y * r * gv.y); w.y = cvt_pk_bf16(v[j].z * r * gv.z, v[j].w * r * gv.w); o8[64 * j] = w; }
}
__device__ __forceinline__ void phase_prologue(const Params& p, LAS unsigned char* lds) {
    const int tid = otid(), lane = tid & 63, wave = tid >> 6;
    const int gw = blockIdx.x * 8 + wave, NGW = gridDim.x * 8;
    LAS float* scr = (LAS float*)(lds + wave * 16384);
    unsigned char* ws = p.ws;
    constexpr int PER_L = 5120 + 1024 + 4 * 512 + 128;
    for (int it = gw; it < DEPTH * PER_L; it += NGW) {
        const int l = it / PER_L; int r = it % PER_L;
        if (r < 5120) { transpose_item(p.in[I_WIN] + (size_t)l * D * INW, INW, (bf16_t*)(ws + WS_WIN) + (size_t)l * INW * D, D, INW / 32, scr, r, lane); continue; } r -= 5120;
        if (r < 1024) { transpose_item(p.in[I_WKV] + (size_t)l * D * 2048, 2048, (bf16_t*)(ws + WS_WKV) + (size_t)l * 2048 * D, D, 64, scr, r, lane); continue; } r -= 1024;
        if (r < 1536) { const int b = r / 512; transpose_item(p.in[I_WPA + b] + (size_t)l * D * D, D, (bf16_t*)(ws + WS_WP) + (size_t)(l * 3 + b) * D * D, D, 32, scr, r % 512, lane); continue; } r -= 1536;
        if (r < 512) { transpose_item(p.in[I_WOUT] + (size_t)l * D * D, D, (bf16_t*)(ws + WS_WOUT) + (size_t)l * D * D, D, 32, scr, r, lane); continue; } r -= 512;
        { const int ri = r >> 6, h = (r >> 3) & 7, sub = r & 7;
          transpose_item(p.in[ri ? I_WI : I_WR] + (size_t)(l * 8 + h) * 128 * 128, 128, (bf16_t*)(ws + WS_WLRU) + ((size_t)(l * 8 + h) * 256 + ri * 128) * 128, 128, 4, scr, sub, lane); }
    }
    { const float* W = p.in[I_WS]; bf16_t* O = (bf16_t*)(ws + WS_WG);
      for (int i4 = blockIdx.x * NTHR + tid; i4 < DEPTH * 8 * 128 * 128 / 4; i4 += gridDim.x * NTHR) {
          const int e = i4 * 4, j = e & 127, i = (e >> 7) & 127; f32x4 v = *(const f32x4*)(W + e);
          if (i < 64 && j >= 64) v = (f32x4){0.f, 0.f, 0.f, 0.f};
          u32x2 w; w.x = cvt_pk_bf16(v.x, v.y); w.y = cvt_pk_bf16(v.z, v.w); *(u32x2*)(O + e) = w; } }
    for (int m = gw; m < MROWS; m += NGW) rms_row_to_bf16(p.in[I_MEM] + (size_t)m * D, p.in[I_MEMG], (bf16_t*)(ws + WS_MEMN) + (size_t)m * D, lane);
    for (int m = gw; m < TC; m += NGW) rms_row_to_bf16(p.in[I_X] + (size_t)m * D, p.in[I_PREG], (bf16_t*)(ws + WS_H) + (size_t)m * D, lane);
}

__device__ __forceinline__ int crow(int reg, int h) { return (reg & 3) + 8 * (reg >> 2) + 4 * h; }
constexpr int LR_XB = 0, LR_XA = 17408, LR_UA = 34816, LR_UU = 67584, LR_SEG = 100352, LR_CAR = 104448, LR_CW = 106496, LR_END = 109568;
template <int PASS>
__device__ __forceinline__ void lru_item(const Params& p, LAS unsigned char* lds, int l, int item) {
    const int tid = otid(), lane = tid & 63, wave = tid >> 6, l31 = lane & 31, hh = lane >> 5;
    const int e8 = item & 7, head = (item >> 3) & 7, bl = item >> 6;
    unsigned char* ws = p.ws;
    bf16_t* zxb = (bf16_t*)(ws + WS_Z + 3 * ZSLOT); bf16_t* zgb = (bf16_t*)(ws + WS_Z + 4 * ZSLOT);
    float* agg = (float*)(ws + WS_AGG);
    const int rowbase = bl * SEQ + e8 * 512;
    const int tb = wave & 1, dblk = wave >> 1;
    bf16x8 wr_f[8], wi_f[8];
    { const bf16_t* w = (const bf16_t*)(ws + WS_WLRU) + ((size_t)(l * 8 + head) * 256 + dblk * 32 + l31) * 128 + 8 * hh;
#pragma unroll
      for (int s = 0; s < 8; ++s) { wr_f[s] = *(const bf16x8*)(w + 16 * s); wi_f[s] = *(const bf16x8*)(w + 128 * 128 + 16 * s); } }
    const int dl = dblk * 32 + l31, dg = l * D + head * 128 + dl;
    const float br = p.in[I_BR][dg], bi = p.in[I_BI][dg];
    float c8; { const float lam = p.in[I_LAM][dg]; const float nl = -lam; const float sp = nl > 20.f ? nl : log1pf(__expf(nl)); c8 = 8.0f * sp; }
    LAS float* CW = (LAS float*)(lds + LR_CW);
    for (int i = tid; i < 640; i += NTHR) { const int k = i >> 7, c = i & 127; CW[i] = (k < 4) ? p.in[I_CONVW][(size_t)(l * 4 + k) * D + head * 128 + c] : p.in[I_CONVB][l * D + head * 128 + c]; }
    LAS float* CAR = (LAS float*)(lds + LR_CAR);
    if (tid < 128) {
        float A = 1.f, H = 0.f;
        if (PASS == 2) { for (int e = 0; e < e8; ++e) { const float a2 = agg[((size_t)(item - e8 + e) * 128 + tid) * 2], h2 = agg[((size_t)(item - e8 + e) * 128 + tid) * 2 + 1]; H = a2 * H + h2; } }
        CAR[tid * 2] = A; CAR[tid * 2 + 1] = H;
    }
    LAS float* UA = (LAS float*)(lds + LR_UA); LAS float* UU = (LAS float*)(lds + LR_UU); LAS float* SEG = (LAS float*)(lds + LR_SEG);
    for (int tile = 0; tile < 8; ++tile) {
        const int row0 = rowbase + tile * 64;
        const int spos0 = e8 * 512 + tile * 64;
        for (int i = tid; i < 67 * 16; i += NTHR) { const int r = i >> 4, ch = i & 15; u32x4 v = (u32x4){0u, 0u, 0u, 0u};
            if (spos0 + r - 3 >= 0) v = *(const u32x4*)(zxb + (size_t)(row0 + r - 3) * D + head * 128 + ch * 8);
            *(LAS u32x4*)(lds + LR_XB + r * 256 + ch * 16) = v; }
        __syncthreads();
#pragma unroll
        for (int k2 = 0; k2 < 2; ++k2) { const int idx = tid + k2 * NTHR, t = idx >> 4, ch = idx & 15;
            float xc[8];
#pragma unroll
            for (int e = 0; e < 8; ++e) xc[e] = CW[512 + ch * 8 + e];
#pragma unroll
            for (int k = 0; k < 4; ++k) { const u32x4 v = *(const LAS u32x4*)(lds + LR_XB + (t + k) * 256 + ch * 16);
                const float x[8] = {bflo(v.x), bfhi(v.x), bflo(v.y), bfhi(v.y), bflo(v.z), bfhi(v.z), bflo(v.w), bfhi(v.w)};
#pragma unroll
                for (int e = 0; e < 8; ++e) xc[e] += x[e] * CW[k * 128 + ch * 8 + e]; }
            u32x4 w; w.x = cvt_pk_bf16(xc[0], xc[1]); w.y = cvt_pk_bf16(xc[2], xc[3]); w.z = cvt_pk_bf16(xc[4], xc[5]); w.w = cvt_pk_bf16(xc[6], xc[7]);
            *(LAS u32x4*)(lds + LR_XA + t * 272 + ch * 16) = w;
            *(LAS f32x4*)(UU + t * 128 + ch * 8) = (f32x4){xc[0], xc[1], xc[2], xc[3]}; *(LAS f32x4*)(UU + t * 128 + ch * 8 + 4) = (f32x4){xc[4], xc[5], xc[6], xc[7]}; }
        __syncthreads();
        f32x16 ar, ai;
#pragma unroll
        for (int i = 0; i < 16; ++i) { ar[i] = 0.f; ai[i] = 0.f; }
#pragma unroll
        for (int s = 0; s < 8; ++s) { const bf16x8 a = *(const LAS bf16x8*)(lds + LR_XA + (tb * 32 + l31) * 272 + (16 * s + 8 * hh) * 2);
            ar = __builtin_amdgcn_mfma_f32_32x32x16_bf16(a, wr_f[s], ar, 0, 0, 0); ai = __builtin_amdgcn_mfma_f32_32x32x16_bf16(a, wi_f[s], ai, 0, 0, 0); }
#pragma unroll
        for (int i = 0; i < 16; ++i) { const int t = tb * 32 + crow(i, hh);
            const float r = sigm(ar[i] + br), ig = sigm(ai[i] + bi);
            const float la = -c8 * r; const float a = __expf(la); const float mult = sqrtf(fmaxf(-expm1f(2.0f * la), 0.f));
            const float xcv = UU[t * 128 + dl];
            UA[t * 128 + dl] = a; UU[t * 128 + dl] = mult * ig * xcv; }
        __syncthreads();
        { const int d = tid & 127, seg = tid >> 7; float A = 1.f, H = 0.f;
#pragma unroll
          for (int t = 0; t < 16; ++t) { const float a = UA[(seg * 16 + t) * 128 + d], uu = UU[(seg * 16 + t) * 128 + d]; H = a * H + uu; A *= a; }
          SEG[(seg * 128 + d) * 2] = A; SEG[(seg * 128 + d) * 2 + 1] = H;
          __syncthreads();
          const int cb = tile & 1; float cA = CAR[(cb * 128 + d) * 2], cH = CAR[(cb * 128 + d) * 2 + 1];
          for (int s2 = 0; s2 < seg; ++s2) { const float a2 = SEG[(s2 * 128 + d) * 2], h2 = SEG[(s2 * 128 + d) * 2 + 1]; cH = a2 * cH + h2; cA *= a2; }
          if (PASS == 2) { float h = cH; bf16_t* gp = zgb + (size_t)(row0 + seg * 16) * D + head * 128 + d;
#pragma unroll
              for (int t = 0; t < 16; ++t) { const float a = UA[(seg * 16 + t) * 128 + d], uu = UU[(seg * 16 + t) * 128 + d]; h = a * h + uu;
                  const float g = bf1(gp[(size_t)t * D]); gp[(size_t)t * D] = f2bf(h * silu(g)); } }
          if (seg == 3) { CAR[((cb ^ 1) * 128 + d) * 2] = cA * A; CAR[((cb ^ 1) * 128 + d) * 2 + 1] = A * cH + H; }
        }
    }
    __syncthreads();
    if (PASS == 1 && tid < 128) { agg[((size_t)item * 128 + tid) * 2] = CAR[tid * 2]; agg[((size_t)item * 128 + tid) * 2 + 1] = CAR[tid * 2 + 1]; }
    __syncthreads();
}
__device__ __forceinline__ void ln_stats(const Params& p) {
    const int tid = otid(), lane = tid & 63, wave = tid >> 6;
    const bf16_t* zv = (const bf16_t*)(p.ws + WS_Z + 1 * ZSLOT); float* st = (float*)(p.ws + WS_STATS);
    for (int k = 0; k < 8; ++k) { const int row = blockIdx.x * 64 + wave * 8 + k; if (row >= TC) break;
        const u32x4* r = (const u32x4*)(zv + (size_t)row * D) + lane; const u32x4 a = r[0], b = r[64];
        float x[16] = {bflo(a.x), bfhi(a.x), bflo(a.y), bfhi(a.y), bflo(a.z), bfhi(a.z), bflo(a.w), bfhi(a.w), bflo(b.x), bfhi(b.x), bflo(b.y), bfhi(b.y), bflo(b.z), bfhi(b.z), bflo(b.w), bfhi(b.w)};
        float s = 0.f;
#pragma unroll
        for (int i = 0; i < 16; ++i) s += x[i];
        const float mean = wave_sum(s) * (1.0f / D); float q = 0.f;
#pragma unroll
        for (int i = 0; i < 16; ++i) { const float d = x[i] - mean; q += d * d; }
        const float rstd = 1.0f / sqrtf(wave_sum(q) * (1.0f / D) + EPS);
        if (lane == 0) { st[row * 2] = mean; st[row * 2 + 1] = rstd; } }
}

__device__ __forceinline__ void gmlp_item(const Params& p, LAS unsigned char* lds, int l, int item) {
    const int tid = otid(), lane = tid & 63, wave = tid >> 6, l31 = lane & 31, hh = lane >> 5;
    const int g = item & 7, nb = item >> 3, row0 = nb * 128;
    unsigned char* ws = p.ws;
    bf16_t* zu = (bf16_t*)(ws + WS_Z); const bf16_t* zv = (const bf16_t*)(ws + WS_Z + 1 * ZSLOT); const bf16_t* zga = (const bf16_t*)(ws + WS_Z + 2 * ZSLOT);
    const float* st = (const float*)(ws + WS_STATS);
#pragma unroll
    for (int k = 0; k < 4; ++k) { const int idx = tid + k * NTHR, j = idx & 127, c8 = idx >> 7;
        const u32x4 v = *(const u32x4*)(zv + (size_t)(row0 + j) * D + g * 128 + c8 * 8);
        const float mean = st[(row0 + j) * 2], rstd = st[(row0 + j) * 2 + 1];
        const float x[8] = {bflo(v.x), bfhi(v.x), bflo(v.y), bfhi(v.y), bflo(v.z), bfhi(v.z), bflo(v.w), bfhi(v.w)};
        const float* lg = p.in[I_LNG] + l * D + g * 128 + c8 * 8; const float* lb = p.in[I_LNB] + l * D + g * 128 + c8 * 8;
#pragma unroll
        for (int e = 0; e < 8; ++e) { const float y = (x[e] - mean) * rstd * lg[e] + lb[e]; *(LAS bf16_t*)(lds + (c8 * 8 + e) * 272 + j * 2) = f2bf(y); } }
    __syncthreads();
    const int cb = wave & 3, ib0 = (wave >> 2) * 2;
    f32x16 acc[2];
#pragma unroll
    for (int q = 0; q < 2; ++q)
#pragma unroll
        for (int i = 0; i < 16; ++i) acc[q][i] = 0.f;
    const bf16_t* wg = (const bf16_t*)(ws + WS_WG) + (size_t)(l * 8 + g) * 128 * 128;
#pragma unroll
    for (int s = 0; s < 8; ++s) { const bf16x8 a = *(const LAS bf16x8*)(lds + (cb * 32 + l31) * 272 + (16 * s + 8 * hh) * 2);
#pragma unroll
        for (int q = 0; q < 2; ++q) { const bf16x8 b = *(const bf16x8*)(wg + (size_t)((ib0 + q) * 32 + l31) * 128 + 16 * s + 8 * hh);
            acc[q] = __builtin_amdgcn_mfma_f32_32x32x16_bf16(a, b, acc[q], 0, 0, 0); } }
#pragma unroll
    for (int q = 0; q < 2; ++q) { const int i = (ib0 + q) * 32 + l31; const float bsv = p.in[I_BS][(size_t)(l * 8 + g) * 128 + i];
#pragma unroll
        for (int rg = 0; rg < 4; ++rg) { const int c = cb * 32 + 8 * rg + 4 * hh; const size_t off = (size_t)(row0 + i) * D + g * 128 + c;
            const u32x2 uu = *(const u32x2*)(zu + off), ga = *(const u32x2*)(zga + off);
            const float u4[4] = {bflo(uu.x), bfhi(uu.x), bflo(uu.y), bfhi(uu.y)}, g4[4] = {bflo(ga.x), bfhi(ga.x), bflo(ga.y), bfhi(ga.y)};
            float y[4];
#pragma unroll
            for (int j = 0; j < 4; ++j) y[j] = u4[j] * (acc[q][4 * rg + j] + bsv) * silu(g4[j]);
            u32x2 w; w.x = cvt_pk_bf16(y[0], y[1]); w.y = cvt_pk_bf16(y[2], y[3]); *(u32x2*)(zu + off) = w; } }
    __syncthreads();
}

constexpr int AT_STRIDE = 528;
__device__ __forceinline__ void attn_item(const Params& p, LAS unsigned char* lds, int l, int chunk, int item) {
    const int tid = otid(), lane = tid & 63, wave = tid >> 6, l31 = lane & 31, hh = lane >> 5;
    const int tile = item & 15, hd = (item >> 4) & 3, bl = item >> 6, bg = chunk * BPC + bl;
    unsigned char* ws = p.ws;
    const bf16_t* zq = (const bf16_t*)(ws + WS_Z + 5 * ZSLOT); bf16_t* zgc = (bf16_t*)(ws + WS_Z + 6 * ZSLOT);
    const bf16_t* KM = (const bf16_t*)(ws + WS_KM) + (size_t)l * MROWS * D + (size_t)bg * MEML * D + hd * 256;
    const bf16_t* VT = (const bf16_t*)(ws + WS_VT) + (size_t)l * D * MROWS + (size_t)hd * 256 * MROWS + bg * MEML;
    const int trow = bl * SEQ + tile * 256 + wave * 32 + l31;
#pragma unroll
    for (int k = 0; k < 16; ++k) { const int idx = tid + k * NTHR, m = idx >> 5, ch = idx & 31;
        *(LAS u32x4*)(lds + m * AT_STRIDE + ch * 16) = *(const u32x4*)(KM + (size_t)m * D + ch * 8); }
    __syncthreads();
    f32x16 sc[8];
#pragma unroll
    for (int mb = 0; mb < 8; ++mb)
#pragma unroll
        for (int i = 0; i < 16; ++i) sc[mb][i] = 0.f;
    { const bf16_t* qp = zq + (size_t)trow * D + hd * 256 + 8 * hh;
#pragma unroll 4
      for (int s = 0; s < 16; ++s) { const bf16x8 qv = *(const bf16x8*)(qp + 16 * s);
#pragma unroll
        for (int mb = 0; mb < 8; ++mb) { const bf16x8 a = *(const LAS bf16x8*)(lds + (mb * 32 + l31) * AT_STRIDE + (16 * s + 8 * hh) * 2);
            sc[mb] = __builtin_amdgcn_mfma_f32_32x32x16_bf16(a, qv, sc[mb], 0, 0, 0); } } }
    float mx = -3.0e38f;
#pragma unroll
    for (int mb = 0; mb < 8; ++mb)
#pragma unroll
        for (int i = 0; i < 16; ++i) mx = fmaxf(mx, sc[mb][i]);
    mx = fmaxf(mx, __shfl_xor(mx, 32));
    const float k2 = 0.0625f * 1.44269504089f; float sum = 0.f;
#pragma unroll
    for (int mb = 0; mb < 8; ++mb)
#pragma unroll
        for (int i = 0; i < 16; ++i) { const float e = exp2f((sc[mb][i] - mx) * k2); sc[mb][i] = e; sum += e; }
    sum += __shfl_xor(sum, 32);
    const float inv = 1.0f / sum;
    bf16x8 pf[8][2];
#pragma unroll
    for (int mb = 0; mb < 8; ++mb)
#pragma unroll
        for (int s2 = 0; s2 < 2; ++s2) { u32x4 w;
            w.x = cvt_pk_bf16(sc[mb][8 * s2 + 0], sc[mb][8 * s2 + 1]); w.y = cvt_pk_bf16(sc[mb][8 * s2 + 2], sc[mb][8 * s2 + 3]);
            w.z = cvt_pk_bf16(sc[mb][8 * s2 + 4], sc[mb][8 * s2 + 5]); w.w = cvt_pk_bf16(sc[mb][8 * s2 + 6], sc[mb][8 * s2 + 7]);
            pf[mb][s2] = __builtin_bit_cast(bf16x8, w); }
    __syncthreads();
#pragma unroll
    for (int k = 0; k < 16; ++k) { const int idx = tid + k * NTHR, d = idx >> 5, ch = idx & 31;
        *(LAS u32x4*)(lds + d * AT_STRIDE + ch * 16) = *(const u32x4*)(VT + (size_t)d * MROWS + ch * 8); }
    __syncthreads();
#pragma unroll
    for (int db = 0; db < 8; ++db) { f32x16 o;
#pragma unroll
        for (int i = 0; i < 16; ++i) o[i] = 0.f;
#pragma unroll
        for (int mb = 0; mb < 8; ++mb)
#pragma unroll
            for (int s2 = 0; s2 < 2; ++s2) { const LAS unsigned char* vp = lds + (db * 32 + l31) * AT_STRIDE + (mb * 32 + 16 * s2 + 4 * hh) * 2;
                const s16x4 lo = *(const LAS s16x4*)vp, hi = *(const LAS s16x4*)(vp + 16);
                const bf16x8 a = __builtin_shufflevector(lo, hi, 0, 1, 2, 3, 4, 5, 6, 7);
                o = __builtin_amdgcn_mfma_f32_32x32x16_bf16(a, pf[mb][s2], o, 0, 0, 0); }
#pragma unroll
        for (int rg = 0; rg < 4; ++rg) { const size_t off = (size_t)trow * D + hd * 256 + db * 32 + 8 * rg + 4 * hh;
            const u32x2 gc = *(const u32x2*)(zgc + off); const float g4[4] = {bflo(gc.x), bfhi(gc.x), bflo(gc.y), bfhi(gc.y)};
            float y[4];
#pragma unroll
            for (int j = 0; j < 4; ++j) y[j] = o[4 * rg + j] * inv * silu(g4[j]);
            u32x2 w; w.x = cvt_pk_bf16(y[0], y[1]); w.y = cvt_pk_bf16(y[2], y[3]); *(u32x2*)(zgc + off) = w; } }
    __syncthreads();
}

__device__ __forceinline__ void row_phase(const Params& p, int l, int chunk) {
    const int tid = otid(), lane = tid & 63, wave = tid >> 6;
    const int gw = blockIdx.x * 8 + wave, NGW = gridDim.x * 8;
    const float* outf = (const float*)(p.ws + WS_Z);
    const float* xsrc = (l == 0) ? p.in[I_X] : p.out;
    const float* gpost = p.in[I_POSTG] + l * D; const float* gpre = p.in[I_PREG] + (l + 1 < DEPTH ? l + 1 : 0) * D;
    bf16_t* H = (bf16_t*)(p.ws + WS_H);
    for (int r = gw; r < TC; r += NGW) {
        const size_t grow = (size_t)chunk * TC + r;
        const f32x4* orow = (const f32x4*)(outf + (size_t)r * D) + lane; const f32x4* xr = (const f32x4*)(xsrc + grow * D) + lane;
        f32x4 o[4], x[4]; float s = 0.f;
#pragma unroll
        for (int j = 0; j < 4; ++j) { o[j] = orow[64 * j]; x[j] = xr[64 * j]; s += (o[j].x * o[j].x + o[j].y * o[j].y) + (o[j].z * o[j].z + o[j].w * o[j].w); }
        const float r1 = 1.0f / sqrtf(wave_sum(s) * (1.0f / D) + EPS); float s2 = 0.f;
        f32x4* xo = (f32x4*)(p.out + grow * D) + lane;
#pragma unroll
        for (int j = 0; j < 4; ++j) { const f32x4 gv = ((const f32x4*)gpost)[lane + 64 * j]; x[j] = x[j] + o[j] * r1 * gv; xo[64 * j] = x[j];
            s2 += (x[j].x * x[j].x + x[j].y * x[j].y) + (x[j].z * x[j].z + x[j].w * x[j].w); }
        if (l + 1 < DEPTH) {
            const float r2 = 1.0f / sqrtf(wave_sum(s2) * (1.0f / D) + EPS); u32x2* h8 = (u32x2*)(H + (size_t)r * D) + lane;
#pragma unroll
            for (int j = 0; j < 4; ++j) { const f32x4 gv = ((const f32x4*)gpre)[lane + 64 * j]; u32x2 w; w.x = cvt_pk_bf16(x[j].x * r2 * gv.x, x[j].y * r2 * gv.y); w.y = cvt_pk_bf16(x[j].z * r2 * gv.z, x[j].w * r2 * gv.w); h8[64 * j] = w; }
        } else if (chunk + 1 < NCH) {
            rms_row_to_bf16(p.in[I_X] + ((size_t)(chunk + 1) * TC + r) * D, p.in[I_PREG], H + (size_t)r * D, lane);
        }
    }
}

constexpr int N_PHASES = 2 + NCH * DEPTH * 6;
__global__ void __launch_bounds__(NTHR, 2) mk_fwd(Params p) {
    extern __shared__ __attribute__((aligned(16))) unsigned char lds_raw[];
    LAS unsigned char* lds = (LAS unsigned char*)lds_raw;
    unsigned char* ws = p.ws;
    const int G = gridDim.x, c = blockIdx.x;
    for (int ph = p.ph_lo; ph < p.ph_hi; ++ph) {
        if (ph == 0) { if constexpr ((PH_MASK & 1) != 0) phase_prologue(p, lds); }
        else if (ph == 1) { if constexpr ((PH_MASK & 2) != 0) {
            pg8::SchedKV S{(const char*)(ws + WS_MEMN), (const char*)(ws + WS_WKV), G, c};
            pg8::EpiKV E{(bf16_t*)(ws + WS_KM), (bf16_t*)(ws + WS_VT)};
            pg8::gemm_phase<pg8::EpiKV, pg8::SchedKV, true>(lds, D, S, E); }
        } else {
            const int s = (ph - 2) / 6, k = (ph - 2) % 6, chunk = s / DEPTH, l = s % DEPTH;
            if (k == 0) { if constexpr ((PH_MASK & 4) != 0) {
                pg8::SchedGrid S{(const char*)(ws + WS_H), (const char*)(ws + WS_WIN) + (size_t)l * INW * D * 2, TC / 256, INW / 256, (TC / 256) * (INW / 256), G, c, (size_t)256 * D * 2};
                pg8::EpiBf16 E{(bf16_t*)(ws + WS_Z), D, (size_t)TC * D, 1};
                pg8::gemm_phase<pg8::EpiBf16, pg8::SchedGrid, true>(lds, D, S, E); }
            } else if (k == 1) {
                if constexpr ((PH_MASK & 8) != 0) { for (int it = c; it < 256; it += G) lru_item<1>(p, lds, l, it);
                ln_stats(p); }
            } else if (k == 2) {
                if constexpr ((PH_MASK & 16) != 0) for (int it = c; it < 256; it += G) lru_item<2>(p, lds, l, it);
                if constexpr ((PH_MASK & 32) != 0) for (int it = c; it < 1024; it += G) gmlp_item(p, lds, l, it);
                if constexpr ((PH_MASK & 64) != 0) for (int it = c; it < 256; it += G) attn_item(p, lds, l, chunk, it);
            } else if (k == 3) { if constexpr ((PH_MASK & 128) != 0) {
                pg8::SchedMerge S{(const char*)(ws + WS_Z), (const char*)(ws + WS_WP) + (size_t)l * 3 * D * D * 2, G, c};
                pg8::EpiMerge E{(const bf16_t*)(ws + WS_Z + 7 * ZSLOT), (bf16_t*)(ws + WS_Z + 5 * ZSLOT)};
                pg8::gemm_phase<pg8::EpiMerge, pg8::SchedMerge, true>(lds, D, S, E); }
            } else if (k == 4) { if constexpr ((PH_MASK & 256) != 0) {
                pg8::SchedGrid S{(const char*)(ws + WS_Z + 5 * ZSLOT), (const char*)(ws + WS_WOUT) + (size_t)l * D * D * 2, TC / 256, 4, (TC / 256) * 4, G, c, (size_t)256 * D * 2};
                pg8::EpiF32 E{(float*)(ws + WS_Z)};
                pg8::gemm_phase<pg8::EpiF32, pg8::SchedGrid, true>(lds, D, S, E); }
            } else {
                if constexpr ((PH_MASK & 512) != 0) row_phase(p, l, chunk);
            }
        }
        if (ph + 1 < p.ph_hi) { __threadfence(); cg::this_grid().sync(); }
    }
}

extern "C" void kernel_launch(void* const* d_in, const int* in_sizes, int n_in, void* d_out, int out_size, void* d_ws, size_t ws_size, hipStream_t stream) {
    static int grid = 0;
    if (grid == 0) {
        if (n_in != 22 || out_size != NT * D || ws_size < WS_END) { fprintf(stderr, "kernel_launch: unexpected problem (n_in %d, out %d, ws %zu < %zu)\n", n_in, out_size, ws_size, (size_t)WS_END); grid = -1; return; }
        if (hipFuncSetAttribute((const void*)mk_fwd, hipFuncAttributeMaxDynamicSharedMemorySize, LDS_BYTES) != hipSuccess) { fprintf(stderr, "kernel_launch: hipFuncSetAttribute failed\n"); grid = -1; return; }
        int dev = 0, cus = 0, per_cu = 0;
        (void)hipGetDevice(&dev); (void)hipDeviceGetAttribute(&cus, hipDeviceAttributeMultiprocessorCount, dev);
        (void)hipOccupancyMaxActiveBlocksPerMultiprocessor(&per_cu, (const void*)mk_fwd, NTHR, LDS_BYTES);
        (void)hipGetLastError();
        grid = cus > 0 ? cus : 256;
        if (per_cu < 1) fprintf(stderr, "kernel_launch: occupancy query says %d blocks per CU\n", per_cu);
    }
    if (grid < 0) return;
    Params p{};
    for (int i = 0; i < 22; ++i) p.in[i] = (const float*)d_in[i];
    p.out = (float*)d_out; p.ws = (unsigned char*)d_ws;
#if MK_MULTI
    for (int ph = 0; ph < N_PHASES; ++ph) { p.ph_lo = ph; p.ph_hi = ph + 1; hipLaunchKernelGGL(mk_fwd, dim3(grid), dim3(NTHR), LDS_BYTES, stream, p); }
#else
    p.ph_lo = 0; p.ph_hi = N_PHASES;
    void* args[] = {&p};
    hipError_t e = hipLaunchCooperativeKernel((const void*)mk_fwd, dim3(grid), dim3(NTHR), args, LDS_BYTES, stream);
    if (e != hipSuccess) fprintf(stderr, "cooperative launch failed: %s (grid %d)\n", hipGetErrorString(e), grid);
#endif
}
```

```cpp
#include <hip/hip_runtime.h>
#include <hip/hip_cooperative_groups.h>
#include <cstdio>
#include <cstdint>
namespace cg = cooperative_groups;

#ifndef MK_MULTI
#define MK_MULTI 0
#endif

#ifndef DBL
#define DBL 0
#endif
#ifndef DRYM
#define DRYM 0
#endif
#ifndef PH_MASK
#define PH_MASK 0x3FF
#endif
#define LAS __attribute__((address_space(3)))
typedef unsigned short bf16_t;
typedef short bf16x8 __attribute__((ext_vector_type(8)));
typedef short s16x4 __attribute__((ext_vector_type(4)));
typedef float f32x4 __attribute__((ext_vector_type(4)));
typedef float f32x2 __attribute__((ext_vector_type(2)));
typedef float f32x16 __attribute__((ext_vector_type(16)));
typedef unsigned u32x4 __attribute__((ext_vector_type(4)));
typedef unsigned u32x2 __attribute__((ext_vector_type(2)));

constexpr int D = 1024, NB = 8, SEQ = 4096, DEPTH = 4, NT = NB * SEQ;
constexpr int NCH = 2, TC = NT / NCH, BPC = NB / NCH;
constexpr int INW = 10240, MEML = 256, MROWS = NB * MEML;
constexpr float EPS = 1e-6f;
constexpr int NTHR = 512;

constexpr size_t MiB = 1u << 20;
constexpr size_t WS_STATS = 0;
constexpr size_t WS_AGG = 256 * 1024;
constexpr size_t WS_BAR = 512 * 1024;
constexpr size_t WS_SS1 = 1 * MiB;
constexpr size_t WS_SS2 = WS_SS1 + 512 * 1024;
constexpr size_t WS_PCNT = 2 * MiB;
constexpr size_t WS_LFLAG = WS_PCNT + 16384;
constexpr size_t WS_ZERO_END = WS_LFLAG + 16384;
constexpr size_t WS_WIN = 3 * MiB;
constexpr size_t WS_WP = 83 * MiB;
constexpr size_t WS_WOUT = 107 * MiB;
constexpr size_t WS_WLRU = 115 * MiB;
constexpr size_t WS_WG = 117 * MiB;
constexpr size_t WS_KM = 118 * MiB;
constexpr size_t WS_VT = 134 * MiB;
constexpr size_t WS_H = 150 * MiB;
constexpr size_t WS_Z = 182 * MiB;
constexpr size_t ZSLOT = (size_t)TC * D * 2;
constexpr size_t WS_WKV = WS_Z;
constexpr size_t WS_MEMN = WS_Z + 16 * MiB;
constexpr size_t WS_LAU = WS_Z + 10 * ZSLOT;
constexpr size_t WS_LNP = WS_LAU + 2 * ZSLOT;
constexpr size_t WS_END = WS_LNP + (size_t)TC * 128;

constexpr int LDS_BYTES = 147456;

typedef __bf16 bf16x2_t __attribute__((ext_vector_type(2)));
__device__ __forceinline__ unsigned cvt_pk_bf16(float lo, float hi) { const f32x2 v = {lo, hi}; return __builtin_bit_cast(unsigned, __builtin_convertvector(v, bf16x2_t)); }
__device__ __forceinline__ float bflo(unsigned w) { return __uint_as_float(w << 16); }
__device__ __forceinline__ float bfhi(unsigned w) { return __uint_as_float(w & 0xffff0000u); }
__device__ __forceinline__ float bf1(bf16_t b) { return __uint_as_float(((unsigned)b) << 16); }
__device__ __forceinline__ bf16_t f2bf(float f) { return (bf16_t)(cvt_pk_bf16(f, 0.f) & 0xffffu); }
__device__ __forceinline__ float wave_sum(float v) {
#pragma unroll
    for (int o = 1; o < 64; o <<= 1) v += __shfl_xor(v, o);
    return v;
}
__device__ __forceinline__ int otid() { int t = threadIdx.x; asm volatile("" : "+v"(t)); return t; }
#define GAS __attribute__((address_space(1)))
template <class T> __device__ __forceinline__ T* asglobal(T* p) { return (T*)(GAS T*)p; }
__device__ __forceinline__ unsigned char* ows(unsigned char* w) { GAS unsigned char* g = (GAS unsigned char*)w; asm volatile("" : "+s"(g)); return (unsigned char*)g; }
__device__ __forceinline__ int obid() { int t = blockIdx.x; asm volatile("" : "+s"(t)); return t; }
__device__ __forceinline__ int ogrid() { int t = gridDim.x; asm volatile("" : "+s"(t)); return t; }
__device__ __forceinline__ float frcp(float x) { return __builtin_amdgcn_rcpf(x); }
__device__ __forceinline__ float fexp(float x) { return __builtin_amdgcn_exp2f(x * 1.44269504089f); }
__device__ __forceinline__ float sigm(float x) { return frcp(1.0f + fexp(-x)); }
__device__ __forceinline__ float silu(float x) { return x * frcp(1.0f + fexp(-x)); }
__device__ __forceinline__ float one_minus_exp(float x, float e, float w) {
    float q = 1.0f + x * (1.0f / 7.0f); q = 1.0f + x * (1.0f / 6.0f) * q; q = 1.0f + x * 0.2f * q; q = 1.0f + x * 0.25f * q; q = 1.0f + x * (1.0f / 3.0f) * q; q = 1.0f + x * 0.5f * q;
    const float d = 1.0f - e;
    return d + w * (-x * q - d);
}

namespace pg8 {
constexpr int BM = 256, BK = 64, HALF = 128, HTB = HALF * BK * 2, STAGE_BYTES = 8 * HTB, NXCD = 8, WGM = 8;
__host__ __device__ __forceinline__ int lds_byte(int r, int c) { const int st = (r >> 4) * 2 + (c >> 5), rr = r & 15, cc = c & 31, ob = rr * 64 + cc * 2; return st * 1024 + (ob ^ (((ob >> 9) & 1) << 5)); }
__host__ __device__ __forceinline__ void stage_rc(int b, int& R, int& C) { const int st = b / 1024, sb = b % 1024, swz = sb ^ (((sb >> 9) & 1) << 5); R = (st >> 1) * 16 + swz / 64; C = (st & 1) * 32 + (swz % 64) / 2; }
__host__ __device__ __forceinline__ int perm32(int rho) { const int n = rho >> 4, i = rho & 15; return 8 * (i >> 2) + 4 * n + (i & 3); }

struct Unit { const char* A; const char* B; int r0, c0, aux; };

template <class Epi, class Sched, bool ALIGN_EPI>
__device__ __forceinline__ void gemm_phase(LAS unsigned char* lds, const int K, const Sched& S, const Epi& E) {
    const int tid = otid(), wid = __builtin_amdgcn_readfirstlane(tid >> 6), lane = tid & 63, wr = wid >> 2, wc = wid & 3, fr = lane & 15, fq = lane >> 4;
    const int nt = K / BK;
    unsigned voffA[2], voffB[2];
#pragma unroll
    for (int i = 0; i < 2; ++i) { int R, C; stage_rc(tid * 16 + i * 8192, R, C); const int Rb = Epi::PERM ? ((R >> 5) * 64 + perm32(R & 31)) : R;
        voffA[i] = (unsigned)(R * K + C) * 2u; voffB[i] = (unsigned)(Rb * K + C) * 2u; }
    const size_t kstep = (size_t)(BK * 2);
    const size_t hstep = (size_t)HALF * K * 2;
    const size_t hstepB = Epi::PERM ? (size_t)32 * K * 2 : hstep;
    const unsigned ldsw = (unsigned)wid * 1024u;
    const int aoff = lds_byte(wr * 64 + fr, fq * 8), boff = lds_byte(wc * 32 + fr, fq * 8);
#define PG8_SA(b, h) (((b) * 2 + (h)) * HTB)
#define PG8_SB(b, h) ((4 + (b) * 2 + (h)) * HTB)
#define PG8_STAGE(bufoff, gbase, voff) do { _Pragma("unroll") for (int _i = 0; _i < 2; ++_i) \
        __builtin_amdgcn_global_load_lds((const unsigned*)((const char*)(gbase) + (voff)[_i]), (LAS unsigned*)(lds + (bufoff) + ldsw + _i * 8192), 16, 0, 0); } while (0)
#define PG8_LDA(dst, b, h) do { _Pragma("unroll") for (int m = 0; m < 4; ++m) _Pragma("unroll") for (int k = 0; k < 2; ++k) dst[m][k] = *(const LAS bf16x8*)(lds + PG8_SA(b, h) + aoff + m * 2048 + k * 1024); } while (0)
#define PG8_LDB(dst, b, h) do { _Pragma("unroll") for (int n = 0; n < 2; ++n) _Pragma("unroll") for (int k = 0; k < 2; ++k) dst[n][k] = *(const LAS bf16x8*)(lds + PG8_SB(b, h) + boff + n * 2048 + k * 1024); } while (0)
#define PG8_MMA(ai, bj, At, Bt) do { __builtin_amdgcn_s_setprio(1); _Pragma("unroll") for (int m = 0; m < 4; ++m) _Pragma("unroll") for (int n = 0; n < 2; ++n) _Pragma("unroll") for (int k = 0; k < 2; ++k) \
        acc[ai][bj][m][n] = __builtin_amdgcn_mfma_f32_16x16x32_bf16(Bt[n][k], At[m][k], acc[ai][bj][m][n], 0, 0, 0); __builtin_amdgcn_s_setprio(0); } while (0)
#define PG8_WAIT_V(n) asm volatile("s_waitcnt vmcnt(" #n ")" ::: "memory")
#define PG8_WAIT_L(n) asm volatile("s_waitcnt lgkmcnt(" #n ")" ::: "memory")
#define PG8_BAR __builtin_amdgcn_s_barrier()
#define PG8_SCHED __builtin_amdgcn_sched_barrier(0)
    Unit cur, nxt; int ui = 0;
    if (!S.next(0, cur)) return;
    f32x4 acc[2][2][4][2];
#pragma unroll
    for (int a = 0; a < 2; ++a)
#pragma unroll
        for (int b = 0; b < 2; ++b)
#pragma unroll
            for (int m = 0; m < 4; ++m)
#pragma unroll
                for (int n = 0; n < 2; ++n) acc[a][b][m][n] = (f32x4){0.f, 0.f, 0.f, 0.f};
    bf16x8 At[4][2], B0[2][2], B1[2][2];
    const char* cA = cur.A; const char* cB = cur.B;
    PG8_STAGE(PG8_SB(0, 0), cB, voffB); PG8_STAGE(PG8_SB(0, 1), cB + hstepB, voffB); PG8_STAGE(PG8_SA(0, 0), cA, voffA); PG8_STAGE(PG8_SA(0, 1), cA + hstep, voffA);
    if (wr == 1) PG8_BAR;
    PG8_WAIT_V(2); PG8_BAR;
    PG8_STAGE(PG8_SB(1, 0), cB + kstep, voffB); PG8_STAGE(PG8_SA(1, 0), cA + kstep, voffA); PG8_STAGE(PG8_SB(1, 1), cB + hstepB + kstep, voffB);
    PG8_WAIT_V(6); PG8_BAR;
    for (;;) {
        const bool has_next = S.next(ui + 1, nxt);
        const char* nA = has_next ? nxt.A : cA; const char* nB = has_next ? nxt.B : cB;
        for (int t = 0; t < nt; t += 2) {
            const bool last = (t == nt - 2);
            const char* a1 = cA + (size_t)(t + 1) * kstep;
            const char* a2 = last ? nA : cA + (size_t)(t + 2) * kstep; const char* b2 = last ? nB : cB + (size_t)(t + 2) * kstep;
            const char* a3 = a2 + kstep; const char* b3 = b2 + kstep;
            PG8_LDB(B0, 0, 0); PG8_LDB(B1, 0, 1); PG8_SCHED; PG8_LDA(At, 0, 0); PG8_STAGE(PG8_SA(1, 1), a1 + hstep, voffA);
            PG8_WAIT_V(8); PG8_WAIT_L(0); PG8_BAR; PG8_MMA(0, 0, At, B0); PG8_MMA(0, 1, At, B1); PG8_BAR; PG8_SCHED;
            PG8_LDA(At, 0, 1); PG8_STAGE(PG8_SB(0, 0), b2, voffB); PG8_STAGE(PG8_SB(0, 1), b2 + hstepB, voffB); PG8_STAGE(PG8_SA(0, 0), a2, voffA);
            PG8_WAIT_V(8); PG8_WAIT_L(0); PG8_BAR; PG8_MMA(1, 0, At, B0); PG8_MMA(1, 1, At, B1); PG8_BAR; PG8_SCHED;
            PG8_LDB(B0, 1, 0); PG8_LDB(B1, 1, 1); PG8_SCHED; PG8_LDA(At, 1, 0); PG8_STAGE(PG8_SA(0, 1), a2 + hstep, voffA);
            PG8_WAIT_V(8); PG8_WAIT_L(0); PG8_BAR; PG8_MMA(0, 0, At, B0); PG8_MMA(0, 1, At, B1); PG8_BAR; PG8_SCHED;
            PG8_LDA(At, 1, 1); PG8_STAGE(PG8_SB(1, 0), b3, voffB); PG8_STAGE(PG8_SB(1, 1), b3 + hstepB, voffB); PG8_STAGE(PG8_SA(1, 0), a3, voffA);
            PG8_WAIT_V(8); PG8_WAIT_L(0); PG8_BAR; PG8_MMA(1, 0, At, B0); PG8_MMA(1, 1, At, B1); PG8_BAR; PG8_SCHED;
        }
        if constexpr (ALIGN_EPI) { if (wr == 0) PG8_BAR; }
        bool zero = true;
        if constexpr (!Epi::AFTER_DRAIN) zero = E(acc, cur, wr, wc, fr, fq);
        if (!has_next) break;
        if (zero) {
#pragma unroll
            for (int a = 0; a < 2; ++a)
#pragma unroll
                for (int b = 0; b < 2; ++b)
#pragma unroll
                    for (int m = 0; m < 4; ++m)
#pragma unroll
                        for (int n = 0; n < 2; ++n) acc[a][b][m][n] = (f32x4){0.f, 0.f, 0.f, 0.f};
        }
        cur = nxt; cA = nA; cB = nB; ++ui;
        if constexpr (ALIGN_EPI) { if (wr == 1) PG8_BAR; }
    }
    PG8_WAIT_V(0);
    if constexpr (!ALIGN_EPI) { if (wr == 0) PG8_BAR; }
    PG8_BAR;
    if constexpr (Epi::AFTER_DRAIN) E.fused(acc, cur, wr, wc, fr, fq, lds, wid, lane);
#undef PG8_SA
#undef PG8_SB
#undef PG8_STAGE
#undef PG8_LDA
#undef PG8_LDB
#undef PG8_MMA
#undef PG8_WAIT_V
#undef PG8_WAIT_L
#undef PG8_BAR
#undef PG8_SCHED
}

struct EpiBf16 {
    static constexpr bool PERM = true, AFTER_DRAIN = false;
    bf16_t* O; int ldc; size_t split_stride; int split; const float* rowss; float* lnp;
    __device__ __forceinline__ bool operator()(f32x4 (&acc)[2][2][4][2], const Unit& u, int wr, int wc, int fr, int fq) const {
        const int row0 = u.r0 + wr * 64 + fr, pn = u.c0 >> 8;
        const bool paired = pn < 8, vtile = (pn >> 2) == 2, gtile = (pn >> 2) == 4 || (pn >> 2) == 6;
        const int slot = paired ? 0 : (pn < 12 ? 1 : (pn >> 2));
        bf16_t* base = O + (size_t)slot * split_stride;
        const int col0 = paired ? (pn * 128 + wc * 32 + 8 * fq) : ((pn & 3) * 256 + wc * 64 + 8 * fq);
#pragma unroll
        for (int ai = 0; ai < 2; ++ai)
#pragma unroll
            for (int m = 0; m < 4; ++m) { bf16_t* rowp = base + (size_t)(row0 + ai * HALF + m * 16) * ldc + col0;
                float rs = 1.0f; if (rowss) { const f32x4 q = *(const f32x4*)(rowss + (size_t)(row0 + ai * HALF + m * 16) * 4); rs = __builtin_amdgcn_rsqf((((q.x + q.y) + q.z) + q.w) * (1.0f / D) + EPS); }
                if (paired) {
                    const f32x4 u0 = acc[ai][0][m][0] * rs, u1 = acc[ai][0][m][1] * rs, g0 = acc[ai][1][m][0] * rs, g1 = acc[ai][1][m][1] * rs;
                    u32x4 w; w.x = cvt_pk_bf16(u0[0] * silu(g0[0]), u0[1] * silu(g0[1])); w.y = cvt_pk_bf16(u0[2] * silu(g0[2]), u0[3] * silu(g0[3]));
                    w.z = cvt_pk_bf16(u1[0] * silu(g1[0]), u1[1] * silu(g1[1])); w.w = cvt_pk_bf16(u1[2] * silu(g1[2]), u1[3] * silu(g1[3]));
                    *(u32x4*)rowp = w;
                } else {
                    float ls = 0.f, lq = 0.f;
#pragma unroll
                    for (int bj = 0; bj < 2; ++bj) { f32x4 v0 = acc[ai][bj][m][0] * rs, v1 = acc[ai][bj][m][1] * rs;
                        if (gtile) { v0 = (f32x4){silu(v0[0]), silu(v0[1]), silu(v0[2]), silu(v0[3])}; v1 = (f32x4){silu(v1[0]), silu(v1[1]), silu(v1[2]), silu(v1[3])}; }
                        if (vtile) { ls += ((v0[0] + v0[1]) + (v0[2] + v0[3])) + ((v1[0] + v1[1]) + (v1[2] + v1[3]));
                            lq += ((v0[0] * v0[0] + v0[1] * v0[1]) + (v0[2] * v0[2] + v0[3] * v0[3])) + ((v1[0] * v1[0] + v1[1] * v1[1]) + (v1[2] * v1[2] + v1[3] * v1[3])); }
                        u32x4 w; w.x = cvt_pk_bf16(v0[0], v0[1]); w.y = cvt_pk_bf16(v0[2], v0[3]); w.z = cvt_pk_bf16(v1[0], v1[1]); w.w = cvt_pk_bf16(v1[2], v1[3]);
                        *(u32x4*)(rowp + bj * 32) = w; }
                    if (vtile) {
                        ls += __shfl_xor(ls, 16); ls += __shfl_xor(ls, 32); lq += __shfl_xor(lq, 16); lq += __shfl_xor(lq, 32);
                        if (fq == 0) *(f32x2*)(lnp + ((size_t)(row0 + ai * HALF + m * 16) * 16 + (pn & 3) * 4 + wc) * 2) = (f32x2){ls, lq}; } } }
        return true;
    }
};
struct EpiKV {
    static constexpr bool PERM = true, AFTER_DRAIN = false;
    bf16_t* KM; bf16_t* VT;
    __device__ __forceinline__ bool operator()(f32x4 (&acc)[2][2][4][2], const Unit& u, int wr, int wc, int fr, int fq) const {
        const int l = u.aux >> 1, isv = u.aux & 1; const int ldc = isv ? MROWS : D;
        bf16_t* base = (isv ? VT : KM) + (size_t)l * MROWS * D;
        const int row0 = u.r0 + wr * 64 + fr, col0 = u.c0 + wc * 64 + 8 * fq;
#pragma unroll
        for (int ai = 0; ai < 2; ++ai)
#pragma unroll
            for (int m = 0; m < 4; ++m) { bf16_t* rowp = base + (size_t)(row0 + ai * HALF + m * 16) * ldc + col0;
#pragma unroll
                for (int bj = 0; bj < 2; ++bj) { const f32x4 v0 = acc[ai][bj][m][0], v1 = acc[ai][bj][m][1];
                    u32x4 w; w.x = cvt_pk_bf16(v0[0], v0[1]); w.y = cvt_pk_bf16(v0[2], v0[3]); w.z = cvt_pk_bf16(v1[0], v1[1]); w.w = cvt_pk_bf16(v1[2], v1[3]);
                    *(u32x4*)(rowp + bj * 32) = w; } }
        return true;
    }
};
struct EpiF32 {
    static constexpr bool PERM = false, AFTER_DRAIN = false;
    float* C;
    __device__ __forceinline__ bool operator()(f32x4 (&acc)[2][2][4][2], const Unit& u, int wr, int wc, int fr, int fq) const {
        const int row0 = u.r0 + wr * 64 + fr, col0 = u.c0 + wc * 32 + 4 * fq;
#pragma unroll
        for (int ai = 0; ai < 2; ++ai)
#pragma unroll
            for (int m = 0; m < 4; ++m) { float* rowp = C + (size_t)(row0 + ai * HALF + m * 16) * D + col0;
#pragma unroll
                for (int bj = 0; bj < 2; ++bj)
#pragma unroll
                    for (int n = 0; n < 2; ++n) *(f32x4*)(rowp + bj * HALF + n * 16) = acc[ai][bj][m][n]; }
        return true;
    }
};

struct EpiOutNorm {
    static constexpr bool PERM = false, AFTER_DRAIN = true;
    const float* xsrc; float* xdst; bf16_t* H; const float* gpost; const float* gpre; float* slot1; float* slot2; unsigned* cnt; unsigned want;
    __device__ __forceinline__ bool operator()(f32x4 (&acc)[2][2][4][2], const Unit& u, int wr, int wc, int fr, int fq) const { return true; }
    __device__ __forceinline__ void fused(f32x4 (&acc)[2][2][4][2], const Unit& u, int wr, int wc, int fr, int fq, LAS unsigned char* lds, int wid, int lane) const {
        const int row0 = u.r0 + wr * 64 + fr, col0 = u.c0 + wc * 32 + 4 * fq, pn = u.c0 >> 8, tid = wid * 64 + lane;
        LAS float* P = (LAS float*)lds;
#pragma unroll
        for (int ai = 0; ai < 2; ++ai)
#pragma unroll
            for (int m = 0; m < 4; ++m) { float sq = 0.f;
#pragma unroll
                for (int bj = 0; bj < 2; ++bj)
#pragma unroll
                    for (int n = 0; n < 2; ++n) { const f32x4 v = acc[ai][bj][m][n]; sq += (v[0] * v[0] + v[1] * v[1]) + (v[2] * v[2] + v[3] * v[3]); }
                sq += __shfl_xor(sq, 16); sq += __shfl_xor(sq, 32);
                if (fq == 0) P[(ai * HALF + wr * 64 + m * 16 + fr) * 4 + wc] = sq; }
        asm volatile("s_waitcnt lgkmcnt(0)" ::: "memory"); __builtin_amdgcn_s_barrier(); asm volatile("" ::: "memory");
        if (tid < 256) { const f32x4 q = *(const LAS f32x4*)(P + tid * 4); __hip_atomic_store(slot1 + (size_t)(u.r0 + tid) * 4 + pn, ((q.x + q.y) + q.z) + q.w, __ATOMIC_RELAXED, __HIP_MEMORY_SCOPE_AGENT); }
        asm volatile("s_waitcnt vmcnt(0) lgkmcnt(0)" ::: "memory"); __builtin_amdgcn_s_barrier(); asm volatile("" ::: "memory");
        unsigned* pc = cnt + 64 * (u.r0 >> 8);
        if (wid == 0) {
            if (lane == 0) __hip_atomic_fetch_add(pc, 1u, __ATOMIC_RELAXED, __HIP_MEMORY_SCOPE_AGENT);
            unsigned sp = 0;
            while ((unsigned)__builtin_amdgcn_readfirstlane(__hip_atomic_load(pc, __ATOMIC_RELAXED, __HIP_MEMORY_SCOPE_AGENT)) < want) { __builtin_amdgcn_s_sleep(1); if (++sp > (1u << 22)) break; }
            __builtin_amdgcn_fence(__ATOMIC_ACQUIRE, "agent");
            asm volatile("s_waitcnt vmcnt(0)" ::: "memory"); }
        asm volatile("" ::: "memory"); __builtin_amdgcn_s_barrier(); asm volatile("" ::: "memory");
        f32x4 gp[2][2], gq[2][2];
#pragma unroll
        for (int bj = 0; bj < 2; ++bj)
#pragma unroll
            for (int n = 0; n < 2; ++n) { gp[bj][n] = *(const f32x4*)(gpost + col0 + bj * HALF + n * 16); gq[bj][n] = H ? *(const f32x4*)(gpre + col0 + bj * HALF + n * 16) : (f32x4){0.f, 0.f, 0.f, 0.f}; }
#pragma unroll
        for (int ai = 0; ai < 2; ++ai)
#pragma unroll
            for (int m = 0; m < 4; ++m) { const int row = row0 + ai * HALF + m * 16; const size_t off = (size_t)row * D + col0;
                const float t0 = __hip_atomic_load(slot1 + (size_t)row * 4 + 0, __ATOMIC_RELAXED, __HIP_MEMORY_SCOPE_AGENT), t1 = __hip_atomic_load(slot1 + (size_t)row * 4 + 1, __ATOMIC_RELAXED, __HIP_MEMORY_SCOPE_AGENT),
                            t2 = __hip_atomic_load(slot1 + (size_t)row * 4 + 2, __ATOMIC_RELAXED, __HIP_MEMORY_SCOPE_AGENT), t3 = __hip_atomic_load(slot1 + (size_t)row * 4 + 3, __ATOMIC_RELAXED, __HIP_MEMORY_SCOPE_AGENT);
                const float r1 = __builtin_amdgcn_rsqf((((t0 + t1) + t2) + t3) * (1.0f / D) + EPS);
                float s2 = 0.f;
#pragma unroll
                for (int bj = 0; bj < 2; ++bj)
#pragma unroll
                    for (int n = 0; n < 2; ++n) { const f32x4 xv = *(const f32x4*)(xsrc + off + bj * HALF + n * 16);
                        const f32x4 xn = xv + acc[ai][bj][m][n] * r1 * gp[bj][n];
                        *(f32x4*)(xdst + off + bj * HALF + n * 16) = xn;
                        s2 += (xn[0] * xn[0] + xn[1] * xn[1]) + (xn[2] * xn[2] + xn[3] * xn[3]);
                        if (H) { const f32x4 a = xn * gq[bj][n]; u32x2 w; w.x = cvt_pk_bf16(a[0], a[1]); w.y = cvt_pk_bf16(a[2], a[3]); *(u32x2*)(H + off + bj * HALF + n * 16) = w; } }
                s2 += __shfl_xor(s2, 16); s2 += __shfl_xor(s2, 32);
                if (fq == 0) P[(ai * HALF + wr * 64 + m * 16 + fr) * 4 + wc] = s2;
                asm volatile("" ::: "memory"); }
        asm volatile("s_waitcnt lgkmcnt(0)" ::: "memory"); __builtin_amdgcn_s_barrier(); asm volatile("" ::: "memory");
        if (H && tid < 256) { const f32x4 q = *(const LAS f32x4*)(P + tid * 4); slot2[(size_t)(u.r0 + tid) * 4 + pn] = ((q.x + q.y) + q.z) + q.w; }
    }
};
struct EpiMerge {
    static constexpr bool PERM = true, AFTER_DRAIN = false;
    const bf16_t* ML;
    bf16_t* O;
    __device__ __forceinline__ bool operator()(f32x4 (&acc)[2][2][4][2], const Unit& u, int wr, int wc, int fr, int fq) const {
        const int sub = u.aux;
        const int row0 = u.r0 + wr * 64 + fr, col0 = u.c0 + wc * 64 + 8 * fq;
        const bf16_t* l0 = ML + (size_t)sub * TC * D;
#pragma unroll
        for (int ai = 0; ai < 2; ++ai)
#pragma unroll
            for (int m = 0; m < 4; ++m) { const size_t off = (size_t)(row0 + ai * HALF + m * 16) * D + col0;
#pragma unroll
                for (int bj = 0; bj < 2; ++bj) {
                    const u32x4 a = *(const u32x4*)(l0 + off + bj * 32);
                    float la[8] = {bflo(a.x), bfhi(a.x), bflo(a.y), bfhi(a.y), bflo(a.z), bfhi(a.z), bflo(a.w), bfhi(a.w)};
                    float f[8];
                    if (sub < 2) {
                        const u32x4 b = *(const u32x4*)(l0 + (size_t)TC * D + off + bj * 32);
                        float lb[8] = {bflo(b.x), bfhi(b.x), bflo(b.y), bfhi(b.y), bflo(b.z), bfhi(b.z), bflo(b.w), bfhi(b.w)};
#pragma unroll
                        for (int j = 0; j < 8; ++j) { const float ea = fexp(-fminf(fmaxf(la[j], -60.f), 60.f)), eb = fexp(-fminf(fmaxf(lb[j], -60.f), 60.f)); f[j] = (1.0f + eb) * frcp(1.0f + ea); }
                    } else {
#pragma unroll
                        for (int j = 0; j < 8; ++j) f[j] = frcp(1.0f + fexp(-fminf(fmaxf(la[j], -60.f), 60.f)));
                    }
                    f32x4 v0 = acc[ai][bj][m][0], v1 = acc[ai][bj][m][1];
                    v0[0] *= f[0]; v0[1] *= f[1]; v0[2] *= f[2]; v0[3] *= f[3]; v1[0] *= f[4]; v1[1] *= f[5]; v1[2] *= f[6]; v1[3] *= f[7];
                    if (sub < 2) { acc[ai][bj][m][0] = v0; acc[ai][bj][m][1] = v1; }
                    else { u32x4 w; w.x = cvt_pk_bf16(v0[0], v0[1]); w.y = cvt_pk_bf16(v0[2], v0[3]); w.z = cvt_pk_bf16(v1[0], v1[1]); w.w = cvt_pk_bf16(v1[2], v1[3]);
                        *(u32x4*)(O + off + bj * 32) = w; }
                } }
        return sub == 2;
    }
};

struct SchedGrid {
    const char* A; const char* B; int nM, nN, nwg, G, c; size_t tstep;
    __device__ __forceinline__ bool next(int i, Unit& u) const {
        const long L = (long)i * G + c; if (L >= nwg) return false;
        int wgid = (int)L; { const int q = nwg / NXCD, r = nwg % NXCD, xcd = wgid % NXCD, off = wgid / NXCD; wgid = (xcd < r ? xcd * (q + 1) : r * (q + 1) + (xcd - r) * q) + off; }
        const int nig = WGM * nN, gid = wgid / nig, fm = gid * WGM, gsz = (nM - fm) < WGM ? (nM - fm) : WGM;
        const int pm = fm + ((wgid % nig) % gsz), pn = (wgid % nig) / gsz;
        u.A = A + (size_t)pm * tstep; u.B = B + (size_t)pn * tstep; u.r0 = pm * BM; u.c0 = pn * BM; u.aux = 0; return true;
    }
};
struct SchedKV {
    const char* MEMN; const char* WKV; int G, c;
    __device__ __forceinline__ bool next(int i, Unit& u) const {
        const int id = i * G + c; if (id >= 256) return false;
        const size_t tstep = (size_t)BM * D * 2;
        const int l = id >> 6, r = id & 63; const char* w = WKV + (size_t)l * 2048 * D * 2;
        if (r < 32) { const int pm = r >> 2, pn = r & 3; u.A = MEMN + pm * tstep; u.B = w + pn * tstep; u.r0 = pm * BM; u.c0 = pn * BM; u.aux = l << 1; }
        else { const int rr = r - 32, pm = rr >> 3, pn = rr & 7; u.A = w + (size_t)(4 + pm) * tstep; u.B = MEMN + pn * tstep; u.r0 = pm * BM; u.c0 = pn * BM; u.aux = (l << 1) | 1; }
        return true;
    }
};
struct SchedMerge {
    const char* Z; const char* WP; int G, c;
    __device__ __forceinline__ bool next(int i, Unit& u) const {
        const int tile = (i / 3) * G + c, sub = i % 3; if (tile >= (TC / BM) * 4) return false;
        const size_t tstep = (size_t)BM * D * 2;
        const int pm = tile >> 2, pn = tile & 3; const int slot = sub == 0 ? 0 : (sub == 1 ? 4 : 6);
        u.A = Z + (size_t)slot * ZSLOT + pm * tstep; u.B = WP + (size_t)sub * D * D * 2 + pn * tstep; u.r0 = pm * BM; u.c0 = pn * BM; u.aux = sub; return true;
    }
};
}

struct Params { const float* in[22]; float* out; unsigned char* ws; int ph_lo, ph_hi; };
typedef const __attribute__((address_space(4))) Params* KP;
enum { I_X = 0, I_MEM, I_MEMG, I_PREG, I_POSTG, I_WIN, I_LNG, I_LNB, I_WS, I_BS, I_CONVW, I_CONVB, I_WR, I_BR, I_WI, I_BI, I_LAM, I_WKV, I_WPA, I_WPB, I_WPC, I_WOUT };

__device__ __forceinline__ void transpose_item(const float* W, int ldw, bf16_t* WT, int ldt, int nblk, LAS float* scr, int item, int lane, bool remap = false) {
    const int kb = item / nblk, nb = item % nblk, k0 = 64 * kb, n0 = 32 * nb;
    int dn0 = n0;
    if (remap) { if (n0 < 1024) dn0 = ((n0 >> 7) * 8 + ((n0 >> 5) & 3) * 2) * 32; else if (n0 < 2048) dn0 = n0 + 1024; else if (n0 < 3072) { const int ch = n0 - 2048; dn0 = ((ch >> 7) * 8 + ((ch >> 5) & 3) * 2 + 1) * 32; } }
#pragma unroll 8
    for (int i = 0; i < 32; ++i) { const int kk = 2 * i + (lane >> 5); scr[kk * 33 + (lane & 31)] = W[(size_t)(k0 + kk) * ldw + n0 + (lane & 31)]; }
    asm volatile("s_waitcnt lgkmcnt(0)" ::: "memory");
    const int c = lane & 7;
#pragma unroll
    for (int j = 0; j < 4; ++j) { const int n = (lane >> 3) + 8 * j; const LAS float* s = scr + (8 * c) * 33 + n;
        u32x4 o; o.x = cvt_pk_bf16(s[0 * 33], s[1 * 33]); o.y = cvt_pk_bf16(s[2 * 33], s[3 * 33]); o.z = cvt_pk_bf16(s[4 * 33], s[5 * 33]); o.w = cvt_pk_bf16(s[6 * 33], s[7 * 33]);
        *(u32x4*)(WT + (size_t)(dn0 + n) * ldt + k0 + 8 * c) = o; }
    asm volatile("s_waitcnt lgkmcnt(0)" ::: "memory");
}
__device__ __forceinline__ void rms_row_to_bf16(const float* xrow, const float* g, bf16_t* orow, int lane) {
    const f32x4* xr = (const f32x4*)xrow + lane; const f32x4* gr = (const f32x4*)g + lane;
    f32x4 v[4]; float s = 0.f;
#pragma unroll
    for (int j = 0; j < 4; ++j) { v[j] = xr[64 * j]; s += (v[j].x * v[j].x + v[j].y * v[j].y) + (v[j].z * v[j].z + v[j].w * v[j].w); }
    const float r = __builtin_amdgcn_rsqf(wave_sum(s) * (1.0f / D) + EPS);
    u32x2* o8 = (u32x2*)orow + lane;
#pragma unroll
    for (int j = 0; j < 4; ++j) { const f32x4 gv = gr[64 * j]; u32x2 w; w.x = cvt_pk_bf16(v[j].x * r * gv.x, v[j].y * r * gv.y); w.y = cvt_pk_bf16(v[j].z * r * gv.z, v[j].w * r * gv.w); o8[64 * j] = w; }
}
__device__ __forceinline__ void row_to_aprime(const float* xrow, const float* g, bf16_t* orow, float* ss, int lane) {
    const f32x4* xr = (const f32x4*)xrow + lane; const f32x4* gr = (const f32x4*)g + lane;
    f32x4 v[4]; float s = 0.f;
#pragma unroll
    for (int j = 0; j < 4; ++j) { v[j] = xr[64 * j]; s += (v[j].x * v[j].x + v[j].y * v[j].y) + (v[j].z * v[j].z + v[j].w * v[j].w); }
    s = wave_sum(s);
    u32x2* o8 = (u32x2*)orow + lane;
#pragma unroll
    for (int j = 0; j < 4; ++j) { const f32x4 gv = gr[64 * j]; u32x2 w; w.x = cvt_pk_bf16(v[j].x * gv.x, v[j].y * gv.y); w.y = cvt_pk_bf16(v[j].z * gv.z, v[j].w * gv.w); o8[64 * j] = w; }
    if (lane == 0) *(f32x4*)ss = (f32x4){s, 0.f, 0.f, 0.f};
}
__device__ __forceinline__ void phase_prologue(KP p, LAS unsigned char* lds) {
    const int tid = otid(), lane = tid & 63, wave = tid >> 6;
    const int gw = obid() * 8 + wave, NGW = ogrid() * 8;
    LAS float* scr = (LAS float*)(lds + wave * 16384);
    unsigned char* ws = ows(p->ws);
    constexpr int PER_L = 5120 + 1024 + 4 * 512 + 128;
    for (int it = gw; it < DEPTH * PER_L; it += NGW) {
        const int l = it / PER_L; int r = it % PER_L;
        if (r < 5120) { transpose_item(asglobal(p->in[I_WIN]) + (size_t)l * D * INW, INW, (bf16_t*)(ws + WS_WIN) + (size_t)l * INW * D, D, INW / 32, scr, r, lane, true); continue; } r -= 5120;
        if (r < 1024) { transpose_item(asglobal(p->in[I_WKV]) + (size_t)l * D * 2048, 2048, (bf16_t*)(ws + WS_WKV) + (size_t)l * 2048 * D, D, 64, scr, r, lane); continue; } r -= 1024;
        if (r < 1536) { const int b = r / 512; transpose_item(asglobal(p->in[I_WPA + b]) + (size_t)l * D * D, D, (bf16_t*)(ws + WS_WP) + (size_t)(l * 3 + b) * D * D, D, 32, scr, r % 512, lane); continue; } r -= 1536;
        if (r < 512) { transpose_item(asglobal(p->in[I_WOUT]) + (size_t)l * D * D, D, (bf16_t*)(ws + WS_WOUT) + (size_t)l * D * D, D, 32, scr, r, lane); continue; } r -= 512;
        { const int ri = r >> 6, h = (r >> 3) & 7, sub = r & 7;
          transpose_item(asglobal(p->in[ri ? I_WI : I_WR]) + (size_t)(l * 8 + h) * 128 * 128, 128, (bf16_t*)(ws + WS_WLRU) + ((size_t)(l * 8 + h) * 256 + ri * 128) * 128, 128, 4, scr, sub, lane); }
    }
    { const float* W = asglobal(p->in[I_WS]); bf16_t* O = (bf16_t*)(ws + WS_WG);
      for (int i4 = obid() * NTHR + tid; i4 < DEPTH * 8 * 128 * 128 / 4; i4 += ogrid() * NTHR) {
          const int e = i4 * 4, j = e & 127, i = (e >> 7) & 127; f32x4 v = *(const f32x4*)(W + e);
          if (i < 64 && j >= 64) v = (f32x4){0.f, 0.f, 0.f, 0.f};
          u32x2 w; w.x = cvt_pk_bf16(v.x, v.y); w.y = cvt_pk_bf16(v.z, v.w); *(u32x2*)(O + e) = w; } }
    for (int m = gw; m < MROWS; m += NGW) rms_row_to_bf16(asglobal(p->in[I_MEM]) + (size_t)m * D, asglobal(p->in[I_MEMG]), (bf16_t*)(ws + WS_MEMN) + (size_t)m * D, lane);
    for (int m = gw; m < TC; m += NGW) row_to_aprime(asglobal(p->in[I_X]) + (size_t)m * D, asglobal(p->in[I_PREG]), (bf16_t*)(ws + WS_H) + (size_t)m * D, (float*)(ws + WS_SS2) + (size_t)m * 4, lane);
}

__device__ __forceinline__ int crow(int reg, int h) { return (reg & 3) + 8 * (reg >> 2) + 4 * h; }
constexpr int LR_XB = 0, LR_XA = 17408, LR_UA = 34816, LR_UU = 67584, LR_SEG = 100352, LR_CAR = 104448, LR_CW = 106496, LR_END = 109568;
template <int PASS>
__device__ __forceinline__ void lru_item(KP p, LAS unsigned char* lds, int l, int item, unsigned pass_tag) {
    const int tid = otid(), lane = tid & 63, wave = tid >> 6, l31 = lane & 31, hh = lane >> 5;
    const int e8 = item & 7, head = (item >> 3) & 7, bl = item >> 6;
    unsigned char* ws = ows(p->ws);
    bf16_t* zxb = (bf16_t*)(ws + WS_Z + 3 * ZSLOT); bf16_t* zgb = (bf16_t*)(ws + WS_Z + 4 * ZSLOT); bf16_t* zgo = zgb; unsigned* lau = (unsigned*)(ws + WS_LAU);
    float* agg = (float*)(ws + WS_AGG);
    const int rowbase = bl * SEQ + e8 * 512;
    const int tb = __builtin_amdgcn_readfirstlane(wave & 1), dblk = __builtin_amdgcn_readfirstlane(wave >> 1);
    bf16x8 wr_f[8], wi_f[8];
    { const bf16_t* w = (const bf16_t*)(ws + WS_WLRU) + ((size_t)(l * 8 + head) * 256 + dblk * 32 + l31) * 128 + 8 * hh;
#pragma unroll
      for (int s = 0; s < 8; ++s) { wr_f[s] = *(const bf16x8*)(w + 16 * s); wi_f[s] = *(const bf16x8*)(w + 128 * 128 + 16 * s); } }
    const int dl = dblk * 32 + l31, dg = l * D + head * 128 + dl;
    const float br = asglobal(p->in[I_BR])[dg], bi = asglobal(p->in[I_BI])[dg];
    float c8; { const float lam = asglobal(p->in[I_LAM])[dg]; const float nl = -lam; const float sp = nl > 20.f ? nl : log1pf(fexp(nl)); c8 = 8.0f * sp; }
    const float wser = (c8 < 0.3f) ? 1.0f : 0.0f;
    const unsigned lauoff = (unsigned)((4 * hh) * D + head * 128 + dblk * 32 + l31) * 4u;
    LAS float* CW = (LAS float*)(lds + LR_CW);
    for (int i = tid; i < 640; i += NTHR) { const int k = i >> 7, c = i & 127; CW[i] = (k < 4) ? asglobal(p->in[I_CONVW])[(size_t)(l * 4 + k) * D + head * 128 + c] : asglobal(p->in[I_CONVB])[l * D + head * 128 + c]; }
    LAS float* CAR = (LAS float*)(lds + LR_CAR);
    if (tid < 128) {
        float A = 1.f, H = 0.f;
        if (PASS == 2) { for (int e = 0; e < e8; ++e) { const float a2 = agg[((size_t)(item - e8 + e) * 128 + tid) * 2], h2 = agg[((size_t)(item - e8 + e) * 128 + tid) * 2 + 1]; H = a2 * H + h2; } }
        CAR[tid * 2] = A; CAR[tid * 2 + 1] = H;
    }
    LAS float* UA = (LAS float*)(lds + LR_UA); LAS float* UU = (LAS float*)(lds + LR_UU); LAS float* SEG = (LAS float*)(lds + LR_SEG);
    u32x4 pre[3];
#pragma unroll
    for (int k3 = 0; k3 < 3; ++k3) { const int i = tid + k3 * NTHR, r = i >> 4, ch = i & 15; pre[k3] = (u32x4){0u, 0u, 0u, 0u};
        if (i < 67 * 16 && e8 * 512 + r - 3 >= 0) pre[k3] = *(const u32x4*)(zxb + (size_t)(rowbase + r - 3) * D + head * 128 + ch * 8); }
    for (int tile = 0; tile < 8; ++tile) {
        const int row0 = rowbase + tile * 64;
        const int spos0 = e8 * 512 + tile * 64;
#pragma unroll
        for (int k3 = 0; k3 < 3; ++k3) { const int i = tid + k3 * NTHR; if (i < 67 * 16) *(LAS u32x4*)(lds + LR_XB + (i >> 4) * 256 + (i & 15) * 16) = pre[k3]; }
        __syncthreads();
        if (tile + 1 < 8) {
#pragma unroll
            for (int k3 = 0; k3 < 3; ++k3) { const int i = tid + k3 * NTHR, r = i >> 4, ch = i & 15; pre[k3] = (u32x4){0u, 0u, 0u, 0u};
                if (i < 67 * 16) pre[k3] = *(const u32x4*)(zxb + (size_t)(row0 + 64 + r - 3) * D + head * 128 + ch * 8); } }
#pragma unroll
        for (int k2 = 0; k2 < 2; ++k2) { const int idx = tid + k2 * NTHR, t = idx >> 4, ch = idx & 15;
            float xc[8];
#pragma unroll
            for (int e = 0; e < 8; ++e) xc[e] = CW[512 + ch * 8 + e];
#pragma unroll
            for (int k = 0; k < 4; ++k) { const u32x4 v = *(const LAS u32x4*)(lds + LR_XB + (t + k) * 256 + ch * 16);
                const float x[8] = {bflo(v.x), bfhi(v.x), bflo(v.y), bfhi(v.y), bflo(v.z), bfhi(v.z), bflo(v.w), bfhi(v.w)};
#pragma unroll
                for (int e = 0; e < 8; ++e) xc[e] += x[e] * CW[k * 128 + ch * 8 + e]; }
            u32x4 w; w.x = cvt_pk_bf16(xc[0], xc[1]); w.y = cvt_pk_bf16(xc[2], xc[3]); w.z = cvt_pk_bf16(xc[4], xc[5]); w.w = cvt_pk_bf16(xc[6], xc[7]);
            *(LAS u32x4*)(lds + LR_XA + t * 272 + ch * 16) = w;
            *(LAS f32x4*)(UU + t * 128 + ch * 8) = (f32x4){xc[0], xc[1], xc[2], xc[3]}; *(LAS f32x4*)(UU + t * 128 + ch * 8 + 4) = (f32x4){xc[4], xc[5], xc[6], xc[7]}; }
        __syncthreads();
        bf16_t* gp = zgb + (size_t)(row0 + (tid >> 7) * 16) * D + head * 128 + (tid & 127); bf16_t* go = zgo + (size_t)(row0 + (tid >> 7) * 16) * D + head * 128 + (tid & 127); bf16_t gv[16];
        if (PASS == 2) {
#pragma unroll
            for (int t = 0; t < 16; ++t) gv[t] = gp[(size_t)t * D]; }
        f32x16 ar, ai;
#pragma unroll
        for (int i = 0; i < 16; ++i) { ar[i] = 0.f; ai[i] = 0.f; }
#pragma unroll
        for (int s = 0; s < 8; ++s) { const bf16x8 a = *(const LAS bf16x8*)(lds + LR_XA + (tb * 32 + l31) * 272 + (16 * s + 8 * hh) * 2);
            ar = __builtin_amdgcn_mfma_f32_32x32x16_bf16(a, wr_f[s], ar, 0, 0, 0); ai = __builtin_amdgcn_mfma_f32_32x32x16_bf16(a, wi_f[s], ai, 0, 0, 0); }
#pragma unroll
        for (int i = 0; i < 16; ++i) { const int t = tb * 32 + crow(i, hh);
            const float r = sigm(ar[i] + br), ig = sigm(ai[i] + bi);
            const float la = -c8 * r; const float a0 = fexp(la);
            const float dr = bflo(cvt_pk_bf16(one_minus_exp(la, a0, wser), 0.f));
            const float a = 1.0f - dr; const float mult = __builtin_amdgcn_sqrtf(fmaxf(dr * (2.0f - dr), 0.f));
            const float xcv = UU[t * 128 + dl];
            const unsigned pk = cvt_pk_bf16(dr, mult * ig * xcv);
            UA[t * 128 + dl] = a; UU[t * 128 + dl] = bfhi(pk);
            if (PASS == 1) *(unsigned*)((char*)lau + ((size_t)(row0 + tb * 32 + (i & 3) + 8 * (i >> 2)) * D * 4) + lauoff) = pk; }
        __syncthreads();
        { const int d = tid & 127, seg = tid >> 7; float A = 1.f, H = 0.f;
#pragma unroll
          for (int t = 0; t < 16; ++t) { const float a = UA[(seg * 16 + t) * 128 + d], uu = UU[(seg * 16 + t) * 128 + d]; H = a * H + uu; A *= a; }
          SEG[(seg * 128 + d) * 2] = A; SEG[(seg * 128 + d) * 2 + 1] = H;
          __syncthreads();
          const int cb = tile & 1; float cA = CAR[(cb * 128 + d) * 2], cH = CAR[(cb * 128 + d) * 2 + 1];
          for (int s2 = 0; s2 < seg; ++s2) { const float a2 = SEG[(s2 * 128 + d) * 2], h2 = SEG[(s2 * 128 + d) * 2 + 1]; cH = a2 * cH + h2; cA *= a2; }
          if (PASS == 2) { float h = cH;
#pragma unroll
              for (int t = 0; t < 16; ++t) { const float a = UA[(seg * 16 + t) * 128 + d], uu = UU[(seg * 16 + t) * 128 + d]; h = a * h + uu;
                  const float g = bf1(gv[t]); go[(size_t)t * D] = f2bf(h * silu(g)); } }
          if (seg == 3) { CAR[((cb ^ 1) * 128 + d) * 2] = cA * A; CAR[((cb ^ 1) * 128 + d) * 2 + 1] = A * cH + H; }
        }
    }
    __syncthreads();
    if (PASS == 1) {
        if (tid < 128) { __hip_atomic_store(agg + ((size_t)item * 128 + tid) * 2, CAR[tid * 2], __ATOMIC_RELAXED, __HIP_MEMORY_SCOPE_AGENT); __hip_atomic_store(agg + ((size_t)item * 128 + tid) * 2 + 1, CAR[tid * 2 + 1], __ATOMIC_RELAXED, __HIP_MEMORY_SCOPE_AGENT); }
        asm volatile("s_waitcnt vmcnt(0)" ::: "memory");
        __syncthreads();
        if (tid == 0) __hip_atomic_store((unsigned*)(ws + WS_LFLAG) + 16 * item, pass_tag, __ATOMIC_RELAXED, __HIP_MEMORY_SCOPE_AGENT);
    }
    __syncthreads();
}
constexpr int L2_SA = 0, L2_SH = 16384, L2_CIN = 32768;
__device__ __forceinline__ void lru_pass2(KP p, LAS unsigned char* lds, int l, int item, unsigned pass_tag, bool dry = false) {
    const int tid = otid(), dg = tid & 15, seg = tid >> 4;
    const int e8 = item & 7, head = (item >> 3) & 7, bl = item >> 6;
    unsigned char* ws = ows(p->ws);
    bf16_t* zgb = (bf16_t*)(ws + WS_Z + 4 * ZSLOT); bf16_t* zgo = dry ? (bf16_t*)(ws + WS_H) : zgb; const unsigned* lau = (const unsigned*)(ws + WS_LAU); float* agg = (float*)(ws + WS_AGG);
    const int rowbase = bl * SEQ + e8 * 512;
    LAS float* SA = (LAS float*)(lds + L2_SA); LAS float* SH = (LAS float*)(lds + L2_SH); LAS float* CIN = (LAS float*)(lds + L2_CIN);
    if (tid < 64) {
        if (tid < e8) { unsigned sp = 0; while (__hip_atomic_load((unsigned*)(ws + WS_LFLAG) + 16 * (item - e8 + tid), __ATOMIC_RELAXED, __HIP_MEMORY_SCOPE_AGENT) != pass_tag) { __builtin_amdgcn_s_sleep(1); if (++sp > (1u << 22)) break; } }
        __builtin_amdgcn_fence(__ATOMIC_ACQUIRE, "agent");
        asm volatile("s_waitcnt vmcnt(0)" ::: "memory"); }
    __syncthreads();
    float carry = 0.f;
    if (tid < 128) { for (int e = 0; e < e8; ++e) { const float a2 = __hip_atomic_load(agg + ((size_t)(item - e8 + e) * 128 + tid) * 2, __ATOMIC_RELAXED, __HIP_MEMORY_SCOPE_AGENT), h2 = __hip_atomic_load(agg + ((size_t)(item - e8 + e) * 128 + tid) * 2 + 1, __ATOMIC_RELAXED, __HIP_MEMORY_SCOPE_AGENT); carry = a2 * carry + h2; } }
    u32x4 pk[4][2], pkn[4][2], gv[4], gn[4];
    { const size_t o = (size_t)(rowbase + seg * 4) * D + head * 128 + dg * 8;
#pragma unroll
      for (int t = 0; t < 4; ++t) { pkn[t][0] = *(const u32x4*)(lau + o + (size_t)t * D); pkn[t][1] = *(const u32x4*)(lau + o + (size_t)t * D + 4); gn[t] = *(const u32x4*)(zgb + o + (size_t)t * D); } }
    for (int tile = 0; tile < 4; ++tile) {
        const size_t o = (size_t)(rowbase + tile * 128 + seg * 4) * D + head * 128 + dg * 8;
#pragma unroll
        for (int t = 0; t < 4; ++t) { pk[t][0] = pkn[t][0]; pk[t][1] = pkn[t][1]; gv[t] = gn[t]; }
        if (tile + 1 < 4) {
#pragma unroll
            for (int t = 0; t < 4; ++t) { pkn[t][0] = *(const u32x4*)(lau + o + (size_t)(128 + t) * D); pkn[t][1] = *(const u32x4*)(lau + o + (size_t)(128 + t) * D + 4); gn[t] = *(const u32x4*)(zgb + o + (size_t)(128 + t) * D); } }
        float A[8], H[8];
#pragma unroll
        for (int e = 0; e < 8; ++e) { A[e] = 1.f; H[e] = 0.f; }
#pragma unroll
        for (int t = 0; t < 4; ++t)
#pragma unroll
            for (int e = 0; e < 8; ++e) { const unsigned w = pk[t][e >> 2][e & 3]; const float a = 1.0f - bflo(w); H[e] = a * H[e] + bfhi(w); A[e] *= a; }
        *(LAS f32x4*)(SA + seg * 128 + dg * 8) = (f32x4){A[0], A[1], A[2], A[3]}; *(LAS f32x4*)(SA + seg * 128 + dg * 8 + 4) = (f32x4){A[4], A[5], A[6], A[7]};
        *(LAS f32x4*)(SH + seg * 128 + dg * 8) = (f32x4){H[0], H[1], H[2], H[3]}; *(LAS f32x4*)(SH + seg * 128 + dg * 8 + 4) = (f32x4){H[4], H[5], H[6], H[7]};
        __syncthreads();
        if (tid < 128) {
#pragma unroll 8
            for (int s2 = 0; s2 < 32; ++s2) { CIN[s2 * 128 + tid] = carry; carry = SA[s2 * 128 + tid] * carry + SH[s2 * 128 + tid]; } }
        __syncthreads();
        const f32x4 c0 = *(const LAS f32x4*)(CIN + seg * 128 + dg * 8), c1 = *(const LAS f32x4*)(CIN + seg * 128 + dg * 8 + 4);
        float h[8] = {c0[0], c0[1], c0[2], c0[3], c1[0], c1[1], c1[2], c1[3]};
#pragma unroll
        for (int t = 0; t < 4; ++t) { float y[8]; const u32x4 g = gv[t]; const float g8[8] = {bflo(g.x), bfhi(g.x), bflo(g.y), bfhi(g.y), bflo(g.z), bfhi(g.z), bflo(g.w), bfhi(g.w)};
#pragma unroll
            for (int e = 0; e < 8; ++e) { const unsigned w = pk[t][e >> 2][e & 3]; h[e] = (1.0f - bflo(w)) * h[e] + bfhi(w); y[e] = h[e] * g8[e]; }
            u32x4 w4; w4.x = cvt_pk_bf16(y[0], y[1]); w4.y = cvt_pk_bf16(y[2], y[3]); w4.z = cvt_pk_bf16(y[4], y[5]); w4.w = cvt_pk_bf16(y[6], y[7]);
            *(u32x4*)(zgo + o + (size_t)t * D) = w4; }
    }
    __syncthreads();
}
__device__ __forceinline__ void ln_stats(KP p) {
    const int tid = otid(), lane = tid & 63, wave = tid >> 6;
    unsigned char* ws = ows(p->ws);
    const bf16_t* zv = (const bf16_t*)(ws + WS_Z + 1 * ZSLOT); float* st = (float*)(ws + WS_STATS);
    const int bid = obid();
    for (int k = 0; k < 8; ++k) { const int row = bid * 64 + wave * 8 + k; if (row >= TC) break;
        const u32x4* r = (const u32x4*)(zv + (size_t)row * D) + lane; const u32x4 a = r[0], b = r[64];
        float x[16] = {bflo(a.x), bfhi(a.x), bflo(a.y), bfhi(a.y), bflo(a.z), bfhi(a.z), bflo(a.w), bfhi(a.w), bflo(b.x), bfhi(b.x), bflo(b.y), bfhi(b.y), bflo(b.z), bfhi(b.z), bflo(b.w), bfhi(b.w)};
        float s = 0.f;
#pragma unroll
        for (int i = 0; i < 16; ++i) s += x[i];
        const float mean = wave_sum(s) * (1.0f / D); float q = 0.f;
#pragma unroll
        for (int i = 0; i < 16; ++i) { const float d = x[i] - mean; q += d * d; }
        const float rstd = __builtin_amdgcn_rsqf(wave_sum(q) * (1.0f / D) + EPS);
        if (lane == 0) { st[row * 2] = mean; st[row * 2 + 1] = rstd; } }
}

constexpr int GM_LN = 36864;
constexpr int GM_SV = 40960;
__device__ __forceinline__ void gmlp_items(KP p, LAS unsigned char* lds, int l, int c, int G, bool dry = false) {
    const int tid = otid(), lane = tid & 63, wave = tid >> 6, l31 = lane & 31, hh = lane >> 5;
    unsigned char* ws = ows(p->ws);
    const int nitems = (TC / 128) * 8;
    if (c >= nitems) return;
    const int g = c & 7;
    bf16_t* zu = (bf16_t*)(ws + WS_Z); bf16_t* zuo = dry ? (bf16_t*)(ws + WS_H) : zu; const bf16_t* zv = (const bf16_t*)(ws + WS_Z + 1 * ZSLOT); const bf16_t* zga = (const bf16_t*)(ws + WS_Z + 2 * ZSLOT);
    const float* lnp = (const float*)(ws + WS_LNP);
    LAS float* LN = (LAS float*)(lds + GM_LN); LAS float* SV = (LAS float*)(lds + GM_SV);
    if (tid < 256) LN[tid] = (tid < 128) ? asglobal(p->in[I_LNG])[l * D + g * 128 + tid] : asglobal(p->in[I_LNB])[l * D + g * 128 + tid - 128];
    const int cb = wave & 3, ib0 = (wave >> 2) * 2;
    bf16x8 wf[2][8];
    { const bf16_t* wg = (const bf16_t*)(ws + WS_WG) + (size_t)(l * 8 + g) * 128 * 128;
#pragma unroll
      for (int q = 0; q < 2; ++q)
#pragma unroll
        for (int s = 0; s < 8; ++s) wf[q][s] = *(const bf16x8*)(wg + (size_t)((ib0 + q) * 32 + l31) * 128 + 16 * s + 8 * hh); }
    const int c8 = tid & 15, jt = tid >> 4;
    const float* bsp = asglobal(p->in[I_BS]) + (size_t)(l * 8 + g) * 128;
    u32x4 vq[4]; f32x2 pq[4];
    { const int row0 = (c >> 3) * 128;
#pragma unroll
      for (int k = 0; k < 4; ++k) { vq[k] = *(const u32x4*)(zv + (size_t)(row0 + jt + 32 * k) * D + g * 128 + c8 * 8); pq[k] = *(const f32x2*)(lnp + (size_t)(row0 + jt + 32 * k) * 32 + 2 * c8); } }
    __syncthreads();
    for (int item = c; item < nitems; item += G) {
        const int row0 = (item >> 3) * 128;
#pragma unroll
        for (int k = 0; k < 4; ++k) { const int j = jt + 32 * k; float ssum = pq[k].x, qsum = pq[k].y;
#pragma unroll
            for (int o = 1; o < 16; o <<= 1) { ssum += __shfl_xor(ssum, o); qsum += __shfl_xor(qsum, o); }
            const float mean = ssum * (1.0f / D), rstd = __builtin_amdgcn_rsqf(fmaxf(qsum * (1.0f / D) - mean * mean, 0.f) + EPS);
            const u32x4 v = vq[k];
            const float x[8] = {bflo(v.x), bfhi(v.x), bflo(v.y), bfhi(v.y), bflo(v.z), bfhi(v.z), bflo(v.w), bfhi(v.w)};
            const int colb = ((((j >> 3) ^ c8) & 15) * 8 + (j & 7)) * 2;
#pragma unroll
            for (int e = 0; e < 8; ++e) { const float y = (x[e] - mean) * rstd * LN[c8 * 8 + e] + LN[128 + c8 * 8 + e]; *(LAS bf16_t*)(lds + (c8 * 8 + e) * 272 + colb) = f2bf(y); } }
        __syncthreads();
        if (item + G < nitems) { const int rown = ((item + G) >> 3) * 128;
#pragma unroll
            for (int k = 0; k < 4; ++k) { vq[k] = *(const u32x4*)(zv + (size_t)(rown + jt + 32 * k) * D + g * 128 + c8 * 8); pq[k] = *(const f32x2*)(lnp + (size_t)(rown + jt + 32 * k) * 32 + 2 * c8); } }
        u32x4 uq[4]; float bq[4];
#pragma unroll
        for (int k = 0; k < 4; ++k) { const size_t off = (size_t)(row0 + jt + 32 * k) * D + g * 128 + c8 * 8; uq[k] = *(const u32x4*)(zu + off); bq[k] = bsp[jt + 32 * k]; }
        f32x16 acc[2];
#pragma unroll
        for (int q = 0; q < 2; ++q)
#pragma unroll
            for (int i = 0; i < 16; ++i) acc[q][i] = 0.f;
#pragma unroll
        for (int s = 0; s < 8; ++s) { const int ch = cb * 32 + l31; const bf16x8 a = *(const LAS bf16x8*)(lds + ch * 272 + ((((2 * s + hh) ^ (ch >> 3)) & 15) * 16));
#pragma unroll
            for (int q = 0; q < 2; ++q) acc[q] = __builtin_amdgcn_mfma_f32_32x32x16_bf16(a, wf[q][s], acc[q], 0, 0, 0); }
#pragma unroll
        for (int q = 0; q < 2; ++q)
#pragma unroll
            for (int rg = 0; rg < 4; ++rg) *(LAS f32x4*)(SV + ((ib0 + q) * 32 + l31) * 132 + cb * 32 + 8 * rg + 4 * hh) = (f32x4){acc[q][4 * rg], acc[q][4 * rg + 1], acc[q][4 * rg + 2], acc[q][4 * rg + 3]};
        __syncthreads();
#pragma unroll
        for (int k = 0; k < 4; ++k) { const int i = jt + 32 * k; const size_t off = (size_t)(row0 + i) * D + g * 128 + c8 * 8;
            const f32x4 s0 = *(const LAS f32x4*)(SV + i * 132 + c8 * 8), s1 = *(const LAS f32x4*)(SV + i * 132 + c8 * 8 + 4);
            const float sv[8] = {s0[0], s0[1], s0[2], s0[3], s1[0], s1[1], s1[2], s1[3]};
            const u32x4 uu = uq[k];
            const float u8[8] = {bflo(uu.x), bfhi(uu.x), bflo(uu.y), bfhi(uu.y), bflo(uu.z), bfhi(uu.z), bflo(uu.w), bfhi(uu.w)};
            float y[8];
#pragma unroll
            for (int e = 0; e < 8; ++e) y[e] = u8[e] * (sv[e] + bq[k]);
            u32x4 w; w.x = cvt_pk_bf16(y[0], y[1]); w.y = cvt_pk_bf16(y[2], y[3]); w.z = cvt_pk_bf16(y[4], y[5]); w.w = cvt_pk_bf16(y[6], y[7]);
            *(u32x4*)(zuo + off) = w; }
    }
    __syncthreads();
}

constexpr int AT_STRIDE = 528;
__device__ __forceinline__ void attn_item(KP p, LAS unsigned char* lds, int l, int chunk, int item, bool dry = false) {
    const int tid = otid(), lane = tid & 63, wave = tid >> 6, l31 = lane & 31, hh = lane >> 5;
    const int tile = item & 15, hd = (item >> 4) & 3, bl = item >> 6, bg = chunk * BPC + bl;
    unsigned char* ws = ows(p->ws);
    const bf16_t* zq = (const bf16_t*)(ws + WS_Z + 5 * ZSLOT); bf16_t* zgc = (bf16_t*)(ws + WS_Z + 6 * ZSLOT); bf16_t* zgco = dry ? (bf16_t*)(ws + WS_H) : zgc;
    const bf16_t* KM = (const bf16_t*)(ws + WS_KM) + (size_t)l * MROWS * D + (size_t)bg * MEML * D + hd * 256;
    const bf16_t* VT = (const bf16_t*)(ws + WS_VT) + (size_t)l * D * MROWS + (size_t)hd * 256 * MROWS + bg * MEML;
    const int trow = bl * SEQ + tile * 256 + wave * 32 + l31;
    const bf16_t* qp = zq + (size_t)trow * D + hd * 256 + 8 * hh;
    const unsigned koff = (unsigned)((tid >> 5) * D + (tid & 31) * 8) * 2u, voff = (unsigned)((tid >> 5) * MROWS + (tid & 31) * 8) * 2u;
    const unsigned loff = (unsigned)((tid >> 5) * AT_STRIDE + (tid & 31) * 16);
#pragma unroll
    for (int k = 0; k < 16; ++k) *(LAS u32x4*)(lds + loff + k * 16 * AT_STRIDE) = *(const u32x4*)((const char*)KM + (size_t)k * 16 * D * 2 + koff);
    __syncthreads();
    const float k2 = 0.0625f * 1.44269504089f;
    bf16x8 pf[8][2];
    u32x4 vpre[8];
    float mA = 0.f, sumA = 0.f, alphaA = 1.f, sum = 0.f;
#pragma unroll
    for (int half = 0; half < 2; ++half) {
        f32x16 sc[4];
#pragma unroll
        for (int mb = 0; mb < 4; ++mb)
#pragma unroll
            for (int i = 0; i < 16; ++i) sc[mb][i] = 0.f;
        bf16x8 qc[4], qn[4];
#pragma unroll
        for (int s4 = 0; s4 < 4; ++s4) qc[s4] = *(const bf16x8*)(qp + 16 * s4);
#pragma unroll 1
        for (int sg = 0; sg < 4; ++sg) {
            if (sg < 3) {
#pragma unroll
                for (int s4 = 0; s4 < 4; ++s4) qn[s4] = *(const bf16x8*)(qp + 64 * (sg + 1) + 16 * s4); }
#pragma unroll
            for (int s4 = 0; s4 < 4; ++s4)
#pragma unroll
                for (int mb = 0; mb < 4; ++mb) { const bf16x8 a = *(const LAS bf16x8*)(lds + (half * 128 + mb * 32 + l31) * AT_STRIDE + (64 * sg + 16 * s4 + 8 * hh) * 2);
                    sc[mb] = __builtin_amdgcn_mfma_f32_32x32x16_bf16(a, qc[s4], sc[mb], 0, 0, 0); }
#pragma unroll
            for (int s4 = 0; s4 < 4; ++s4) qc[s4] = qn[s4];
        }
        if (half == 1) {
            __builtin_amdgcn_sched_barrier(0);
#pragma unroll
            for (int k = 0; k < 8; ++k) vpre[k] = *(const u32x4*)((const char*)VT + (size_t)k * 16 * MROWS * 2 + voff); }
        float mh = -3.0e38f;
#pragma unroll
        for (int mb = 0; mb < 4; ++mb)
#pragma unroll
            for (int i = 0; i < 16; ++i) mh = fmaxf(mh, sc[mb][i]);
        mh = fmaxf(mh, __shfl_xor(mh, 32));
        float mref;
        if (half == 0) { mA = mh; mref = mh; } else { mref = fmaxf(mA, mh); alphaA = __builtin_amdgcn_exp2f((mA - mref) * k2); }
        float sh = 0.f;
#pragma unroll
        for (int mb = 0; mb < 4; ++mb) {
#pragma unroll
            for (int i = 0; i < 16; ++i) { const float e = __builtin_amdgcn_exp2f((sc[mb][i] - mref) * k2); sc[mb][i] = e; sh += e; }
#pragma unroll
            for (int s2 = 0; s2 < 2; ++s2) { u32x4 w;
                w.x = cvt_pk_bf16(sc[mb][8 * s2 + 0], sc[mb][8 * s2 + 1]); w.y = cvt_pk_bf16(sc[mb][8 * s2 + 2], sc[mb][8 * s2 + 3]);
                w.z = cvt_pk_bf16(sc[mb][8 * s2 + 4], sc[mb][8 * s2 + 5]); w.w = cvt_pk_bf16(sc[mb][8 * s2 + 6], sc[mb][8 * s2 + 7]);
                pf[half * 4 + mb][s2] = __builtin_bit_cast(bf16x8, w); } }
        sh += __shfl_xor(sh, 32);
        if (half == 0) sumA = sh; else sum = sumA * alphaA + sh;
    }
    const float inv = frcp(sum);
    __syncthreads();
#pragma unroll
    for (int k = 0; k < 8; ++k) *(LAS u32x4*)(lds + loff + k * 16 * AT_STRIDE) = vpre[k];
#pragma unroll
    for (int k = 8; k < 16; ++k) *(LAS u32x4*)(lds + loff + k * 16 * AT_STRIDE) = *(const u32x4*)((const char*)VT + (size_t)k * 16 * MROWS * 2 + voff);
    u32x2 gcr[4][4];
    { const size_t off0 = (size_t)trow * D + hd * 256 + 4 * hh;
#pragma unroll
      for (int b4 = 0; b4 < 4; ++b4)
#pragma unroll
        for (int rg = 0; rg < 4; ++rg) gcr[b4][rg] = *(const u32x2*)(zgc + off0 + b4 * 32 + 8 * rg); }
    __syncthreads();
#pragma unroll
    for (int db = 0; db < 8; ++db) { f32x16 o; u32x2 gc[4];
#pragma unroll
        for (int rg = 0; rg < 4; ++rg) gc[rg] = gcr[db & 3][rg];
        if (db < 4) { const size_t off1 = (size_t)trow * D + hd * 256 + (db + 4) * 32 + 4 * hh;
#pragma unroll
            for (int rg = 0; rg < 4; ++rg) gcr[db & 3][rg] = *(const u32x2*)(zgc + off1 + 8 * rg); }
#pragma unroll
        for (int i = 0; i < 16; ++i) o[i] = 0.f;
#pragma unroll
        for (int mb = 0; mb < 8; ++mb) {
            if (mb == 4) {
#pragma unroll
                for (int i = 0; i < 16; ++i) o[i] *= alphaA; }
#pragma unroll
            for (int s2 = 0; s2 < 2; ++s2) { const LAS unsigned char* vp = lds + (db * 32 + l31) * AT_STRIDE + (mb * 32 + 16 * s2 + 4 * hh) * 2;
                const s16x4 lo = *(const LAS s16x4*)vp, hi = *(const LAS s16x4*)(vp + 16);
                const bf16x8 a = __builtin_shufflevector(lo, hi, 0, 1, 2, 3, 4, 5, 6, 7);
                o = __builtin_amdgcn_mfma_f32_32x32x16_bf16(a, pf[mb][s2], o, 0, 0, 0); } }
#pragma unroll
        for (int rg = 0; rg < 4; ++rg) { const size_t off = (size_t)trow * D + hd * 256 + db * 32 + 8 * rg + 4 * hh;
            const float g4[4] = {bflo(gc[rg].x), bfhi(gc[rg].x), bflo(gc[rg].y), bfhi(gc[rg].y)};
            float y[4];
#pragma unroll
            for (int j = 0; j < 4; ++j) y[j] = o[4 * rg + j] * inv * g4[j];
            u32x2 w; w.x = cvt_pk_bf16(y[0], y[1]); w.y = cvt_pk_bf16(y[2], y[3]); *(u32x2*)(zgco + off) = w; } }
    __syncthreads();
}

__device__ __forceinline__ void row_phase(KP p, int l, int chunk, bool dry = false) {
    const int tid = otid(), lane = tid & 63, wave = tid >> 6;
    const int gw = obid() * 8 + wave, NGW = ogrid() * 8;
    unsigned char* ws = ows(p->ws);
    const float* outf = (const float*)(ws + WS_Z);
    const float* xsrc = (l == 0) ? asglobal(p->in[I_X]) : asglobal(p->out);
    const float* gpost = asglobal(p->in[I_POSTG]) + l * D; const float* gpre = asglobal(p->in[I_PREG]) + (l + 1 < DEPTH ? l + 1 : 0) * D;
    bf16_t* H = dry ? (bf16_t*)(ws + WS_Z + 4 * ZSLOT) : (bf16_t*)(ws + WS_H);
    float* xout = dry ? (float*)(ws + WS_Z + 2 * ZSLOT) - (size_t)chunk * TC * D : asglobal(p->out);
    for (int r = gw; r < TC; r += NGW) {
        const size_t grow = (size_t)chunk * TC + r;
        const f32x4* orow = (const f32x4*)(outf + (size_t)r * D) + lane; const f32x4* xr = (const f32x4*)(xsrc + grow * D) + lane;
        f32x4 o[4], x[4]; float s = 0.f;
#pragma unroll
        for (int j = 0; j < 4; ++j) { o[j] = orow[64 * j]; x[j] = xr[64 * j]; s += (o[j].x * o[j].x + o[j].y * o[j].y) + (o[j].z * o[j].z + o[j].w * o[j].w); }
        const float r1 = __builtin_amdgcn_rsqf(wave_sum(s) * (1.0f / D) + EPS); float s2 = 0.f;
        f32x4* xo = (f32x4*)(xout + grow * D) + lane;
#pragma unroll
        for (int j = 0; j < 4; ++j) { const f32x4 gv = ((const f32x4*)gpost)[lane + 64 * j]; x[j] = x[j] + o[j] * r1 * gv; xo[64 * j] = x[j];
            s2 += (x[j].x * x[j].x + x[j].y * x[j].y) + (x[j].z * x[j].z + x[j].w * x[j].w); }
        if (l + 1 < DEPTH) {
            const float r2 = __builtin_amdgcn_rsqf(wave_sum(s2) * (1.0f / D) + EPS); u32x2* h8 = (u32x2*)(H + (size_t)r * D) + lane;
#pragma unroll
            for (int j = 0; j < 4; ++j) { const f32x4 gv = ((const f32x4*)gpre)[lane + 64 * j]; u32x2 w; w.x = cvt_pk_bf16(x[j].x * r2 * gv.x, x[j].y * r2 * gv.y); w.y = cvt_pk_bf16(x[j].z * r2 * gv.z, x[j].w * r2 * gv.w); h8[64 * j] = w; }
        } else if (chunk + 1 < NCH) {
            rms_row_to_bf16(asglobal(p->in[I_X]) + ((size_t)(chunk + 1) * TC + r) * D, asglobal(p->in[I_PREG]), H + (size_t)r * D, lane);
        }
    }
}

#define XB_TMO      128
#define XB_XCNT(j)  (256  + 64 * (j))
#define XB_XSUB(j)  (1280 + 64 * (j))
#define XB_XGEN(j)  (2304 + 64 * (j))
#define XB_TOP      3328
#define XB_TOPGEN   3392
#define XCD_BAR_WORDS 3456
#define XB_SPIN_CAP (1u << 22)
__device__ __forceinline__ unsigned xb_ld(unsigned* p)              { return __hip_atomic_load(p, __ATOMIC_RELAXED, __HIP_MEMORY_SCOPE_AGENT); }
__device__ __forceinline__ unsigned xb_add(unsigned* p, unsigned v) { return __hip_atomic_fetch_add(p, v, __ATOMIC_RELAXED, __HIP_MEMORY_SCOPE_AGENT); }
__device__ __forceinline__ unsigned xb_xcc_id() { return (unsigned)__builtin_amdgcn_s_getreg((3 << 11) | 20) & 0xFu; }
#define XB_SPIN(cond, bar) do { unsigned _sp = 0; while (cond) { __builtin_amdgcn_s_sleep(1); \
    if ((++_sp & 255u) == 0u) { if (xb_ld(&(bar)[XB_TMO])) break; if (_sp > XB_SPIN_CAP) { atomicAdd(&(bar)[XB_TMO], 1u); break; } } } } while (0)
struct XcdBarrier { unsigned* bar; unsigned x; volatile LAS unsigned* st; };
__device__ __forceinline__ XcdBarrier xcd_barrier_post(unsigned* bar, volatile LAS unsigned* st) {
    XcdBarrier b; b.bar = bar; b.x = xb_xcc_id(); b.st = st;
    if (threadIdx.x == 0) (void)xb_add(&bar[XB_XCNT(b.x)], 1u);
    return b;
}
__device__ __forceinline__ void xcd_barrier_complete(unsigned* bar, unsigned x, unsigned& nloc, unsigned& nx) {
    const unsigned G = gridDim.x * gridDim.y * gridDim.z;
    unsigned sum, cnt, mine, sp = 0u;
    for (;;) {
        sum = 0u; cnt = 0u; mine = 0u;
#pragma unroll
        for (unsigned j = 0; j < 16; ++j) { const unsigned c = xb_ld(&bar[XB_XCNT(j)]); sum += c; cnt += (c > 0u) ? 1u : 0u; mine = (j == x) ? c : mine; }
        if (sum == G) break;
        __builtin_amdgcn_s_sleep(1);
        if ((++sp & 255u) == 0u) { if (xb_ld(&bar[XB_TMO])) break; if (sp > XB_SPIN_CAP) { atomicAdd(&bar[XB_TMO], 1u); break; } }
    }
    nloc = mine > 0u ? mine : 1u; nx = cnt > 0u ? cnt : 1u;
}
__device__ __forceinline__ void xcd_barrier(const XcdBarrier& b) {
    asm volatile("s_waitcnt vmcnt(0)" ::: "memory");
    __syncthreads();
    if (threadIdx.x == 0) {
        unsigned* bar = (unsigned*)ows((unsigned char*)b.bar);
        __builtin_amdgcn_s_waitcnt(0);
        unsigned nloc = b.st[0], nx = b.st[1];
        if (nloc == 0u) { xcd_barrier_complete(bar, b.x, nloc, nx); b.st[0] = nloc; b.st[1] = nx; }
        const unsigned old = xb_add(&bar[XB_XSUB(b.x)], 1u);
        const unsigned gen = old / nloc;
        if (old + 1u == (gen + 1u) * nloc) {
            __builtin_amdgcn_fence(__ATOMIC_RELEASE, "agent");
            asm volatile("s_waitcnt vmcnt(0)" ::: "memory");
            const unsigned og = xb_add(&bar[XB_TOP], 1u);
            const unsigned tg = og / nx;
            if (og + 1u == (tg + 1u) * nx) xb_add(&bar[XB_TOPGEN], 1u);
            else XB_SPIN(xb_ld(&bar[XB_TOPGEN]) == tg, bar);
            __builtin_amdgcn_fence(__ATOMIC_ACQUIRE, "agent");
            xb_add(&bar[XB_XGEN(b.x)], 1u);
            asm volatile("s_waitcnt vmcnt(0)" ::: "memory");
        } else {
            XB_SPIN(xb_ld(&bar[XB_XGEN(b.x)]) == gen, bar);
            __builtin_amdgcn_fence(__ATOMIC_ACQUIRE, "agent");
            asm volatile("s_waitcnt vmcnt(0)" ::: "memory");
        }
    }
    __syncthreads();
}

constexpr int N_PHASES = 2 + NCH * DEPTH * 4;
__global__ void __launch_bounds__(NTHR, 2) mk_fwd(Params pk) {
    extern __shared__ __attribute__((aligned(16))) unsigned char lds_raw[];
    LAS unsigned char* lds = (LAS unsigned char*)lds_raw;
    unsigned char* ws = pk.ws;
    int G = gridDim.x, c = blockIdx.x;
    volatile LAS unsigned* bst = (volatile LAS unsigned*)(lds + LDS_BYTES - 64);
    if (threadIdx.x < 2) bst[threadIdx.x] = 0u;
    __syncthreads();
    XcdBarrier bar; bar.bar = (unsigned*)(ws + WS_BAR); bar.x = 0; bar.st = bst;
    if (pk.ph_hi - pk.ph_lo > 1) bar = xcd_barrier_post((unsigned*)(ws + WS_BAR), bst);
    const int ph_hi = pk.ph_hi;
    for (int ph = pk.ph_lo; ph < ph_hi; ++ph) {
        KP p = (KP)__builtin_amdgcn_kernarg_segment_ptr(); asm volatile("" : "+s"(p));
        ws = ows(ws); asm volatile("" : "+s"(G), "+s"(c));
        if (ph == 0) { if constexpr ((PH_MASK & 1) != 0) phase_prologue(p, lds); }
        else if (ph == 1) { if constexpr ((PH_MASK & 2) != 0) {
            pg8::SchedKV S{(const char*)(ws + WS_MEMN), (const char*)(ws + WS_WKV), G, c};
            pg8::EpiKV E{(bf16_t*)(ws + WS_KM), (bf16_t*)(ws + WS_VT)};
            pg8::gemm_phase<pg8::EpiKV, pg8::SchedKV, true>(lds, D, S, E); }
        } else {
            const int s = (ph - 2) / 4, k = (ph - 2) % 4, chunk = s / DEPTH, l = s % DEPTH;
            for (int rep = 0; rep < (((DBL >> k) & 1) ? 2 : 1); ++rep) {
            if (rep) xcd_barrier(bar);
            if (k == 0) { if constexpr ((PH_MASK & 4) != 0) {
                pg8::SchedGrid S{(const char*)(ws + WS_H), (const char*)(ws + WS_WIN) + (size_t)l * INW * D * 2, TC / 256, INW / 256, (TC / 256) * (INW / 256), G, c, (size_t)256 * D * 2};
                pg8::EpiBf16 E{(bf16_t*)(ws + WS_Z), D, (size_t)TC * D, 1, (const float*)(ws + WS_SS2), (float*)(ws + WS_LNP)};
                pg8::gemm_phase<pg8::EpiBf16, pg8::SchedGrid, true>(lds, D, S, E); }
            } else if (k == 1) {
                if constexpr ((DRYM & 1) != 0) for (int it = c; it < 256; it += G) lru_item<1>(p, lds, l, it, (unsigned)(s + 1));
                if constexpr ((PH_MASK & 8) != 0) for (int it = c; it < 256; it += G) lru_item<1>(p, lds, l, it, (unsigned)(s + 1));
                if constexpr ((DRYM & 2) != 0) gmlp_items(p, lds, l, c, G, true);
                if constexpr ((PH_MASK & 32) != 0) gmlp_items(p, lds, l, c, G);
                if constexpr ((DRYM & 4) != 0) for (int it = c; it < 256; it += G) attn_item(p, lds, l, chunk, it, true);
                if constexpr ((PH_MASK & 64) != 0) for (int it = c; it < 256; it += G) attn_item(p, lds, l, chunk, it);
                if constexpr ((DRYM & 8) != 0) for (int it = c; it < 256; it += G) lru_pass2(p, lds, l, it, (unsigned)(s + 1), true);
                if constexpr ((PH_MASK & 16) != 0) for (int it = c; it < 256; it += G) lru_pass2(p, lds, l, it, (unsigned)(s + 1));
            } else if (k == 2) { if constexpr ((PH_MASK & 128) != 0) {
                pg8::SchedMerge S{(const char*)(ws + WS_Z), (const char*)(ws + WS_WP) + (size_t)l * 3 * D * D * 2, G, c};
                pg8::EpiMerge E{(const bf16_t*)(ws + WS_Z + 7 * ZSLOT), (bf16_t*)(ws + WS_Z + 5 * ZSLOT)};
                pg8::gemm_phase<pg8::EpiMerge, pg8::SchedMerge, true>(lds, D, S, E); }
            } else { if constexpr ((PH_MASK & 256) != 0) {
                const bool lastl = (l + 1 == DEPTH);
                pg8::SchedGrid S{(const char*)(ws + WS_Z + 5 * ZSLOT), (const char*)(ws + WS_WOUT) + (size_t)l * D * D * 2, TC / 256, 4, (TC / 256) * 4, G, c, (size_t)256 * D * 2};
                pg8::EpiOutNorm E{(l == 0 ? asglobal(p->in[I_X]) : asglobal(p->out)) + (size_t)chunk * TC * D, asglobal(p->out) + (size_t)chunk * TC * D, lastl ? (bf16_t*)nullptr : (bf16_t*)(ws + WS_H),
                                  asglobal(p->in[I_POSTG]) + l * D, asglobal(p->in[I_PREG]) + (lastl ? 0 : l + 1) * D, (float*)(ws + WS_SS1), (float*)(ws + WS_SS2),
                                  (unsigned*)(ws + WS_PCNT), 4u * (unsigned)(s + 1)};
                pg8::gemm_phase<pg8::EpiOutNorm, pg8::SchedGrid, true>(lds, D, S, E);
                if (lastl && chunk + 1 < NCH) {
                    const int wave = otid() >> 6, lane = otid() & 63;
                    for (int m = c * 8 + wave; m < TC; m += G * 8) row_to_aprime(asglobal(p->in[I_X]) + ((size_t)(chunk + 1) * TC + m) * D, asglobal(p->in[I_PREG]), (bf16_t*)(ws + WS_H) + (size_t)m * D, (float*)(ws + WS_SS2) + (size_t)m * 4, lane);
                } } }
            }
        }
        if (ph + 1 < ph_hi) { if (ph_hi == -12345) cg::this_grid().sync();
                              xcd_barrier(bar); }
    }
}

extern "C" void kernel_launch(void* const* d_in, const int* in_sizes, int n_in, void* d_out, int out_size, void* d_ws, size_t ws_size, hipStream_t stream) {
    static int grid = 0;
    if (grid == 0) {
        if (n_in != 22 || out_size != NT * D || ws_size < WS_END) { fprintf(stderr, "kernel_launch: unexpected problem (n_in %d, out %d, ws %zu < %zu)\n", n_in, out_size, ws_size, (size_t)WS_END); grid = -1; return; }
        if (hipFuncSetAttribute((const void*)mk_fwd, hipFuncAttributeMaxDynamicSharedMemorySize, LDS_BYTES) != hipSuccess) { fprintf(stderr, "kernel_launch: hipFuncSetAttribute failed\n"); grid = -1; return; }
        int dev = 0, cus = 0, per_cu = 0;
        (void)hipGetDevice(&dev); (void)hipDeviceGetAttribute(&cus, hipDeviceAttributeMultiprocessorCount, dev);
        (void)hipOccupancyMaxActiveBlocksPerMultiprocessor(&per_cu, (const void*)mk_fwd, NTHR, LDS_BYTES);
        (void)hipGetLastError();
        grid = cus > 0 ? cus : 256;
        if (per_cu < 1) fprintf(stderr, "kernel_launch: occupancy query says %d blocks per CU\n", per_cu);
    }
    if (grid < 0) return;
    Params p{};
    for (int i = 0; i < 22; ++i) p.in[i] = (const float*)d_in[i];
    p.out = (float*)d_out; p.ws = (unsigned char*)d_ws;
#if MK_MULTI
    for (int ph = 0; ph < N_PHASES; ++ph) { p.ph_lo = ph; p.ph_hi = ph + 1; hipLaunchKernelGGL(mk_fwd, dim3(grid), dim3(NTHR), LDS_BYTES, stream, p); }
#else
    p.ph_lo = 0; p.ph_hi = N_PHASES;
    (void)hipMemsetAsync((char*)d_ws + WS_BAR, 0, WS_ZERO_END - WS_BAR, stream);
    void* args[] = {&p};
    hipError_t e = hipLaunchCooperativeKernel((const void*)mk_fwd, dim3(grid), dim3(NTHR), args, LDS_BYTES, stream);
    if (e != hipSuccess) fprintf(stderr, "cooperative launch failed: %s (grid %d)\n", hipGetErrorString(e), grid);
#endif
}
```

```cpp
#include <hip/hip_runtime.h>
#include <hip/hip_cooperative_groups.h>
#include <cstdio>
#include <cstdint>
namespace cg = cooperative_groups;

#ifndef MK_MULTI
#define MK_MULTI 0
#endif

#ifndef DBL
#define DBL 0
#endif
#ifndef DRYM
#define DRYM 0
#endif
#ifndef PH_MASK
#define PH_MASK 0x3FF
#endif
#define LAS __attribute__((address_space(3)))
typedef unsigned short bf16_t;
typedef short bf16x8 __attribute__((ext_vector_type(8)));
typedef short s16x4 __attribute__((ext_vector_type(4)));
typedef float f32x4 __attribute__((ext_vector_type(4)));
typedef float f32x2 __attribute__((ext_vector_type(2)));
typedef float f32x16 __attribute__((ext_vector_type(16)));
typedef unsigned u32x4 __attribute__((ext_vector_type(4)));
typedef unsigned u32x2 __attribute__((ext_vector_type(2)));

constexpr int D = 1024, NB = 8, SEQ = 4096, DEPTH = 4, NT = NB * SEQ;
constexpr int NCH = 2, TC = NT / NCH, BPC = NB / NCH;
constexpr int INW = 10240, MEML = 256, MROWS = NB * MEML;
constexpr float EPS = 1e-6f;
constexpr int NTHR = 512;

constexpr size_t MiB = 1u << 20;
constexpr size_t WS_STATS = 0;
constexpr size_t WS_AGG = 256 * 1024;
constexpr size_t WS_BAR = 512 * 1024;
constexpr size_t WS_SS1 = 1 * MiB;
constexpr size_t WS_SS2 = WS_SS1 + 512 * 1024;
constexpr size_t WS_PCNT = 2 * MiB;
constexpr size_t WS_LFLAG = WS_PCNT + 16384;
constexpr size_t WS_ZERO_END = WS_LFLAG + 16384;
constexpr size_t WS_WIN = 3 * MiB;
constexpr size_t WS_WP = 83 * MiB;
constexpr size_t WS_WOUT = 107 * MiB;
constexpr size_t WS_WLRU = 115 * MiB;
constexpr size_t WS_WG = 117 * MiB;
constexpr size_t WS_KM = 118 * MiB;
constexpr size_t WS_VT = 134 * MiB;
constexpr size_t WS_H = 150 * MiB;
constexpr size_t WS_Z = 182 * MiB;
constexpr size_t ZSLOT = (size_t)TC * D * 2;
constexpr size_t WS_WKV = WS_Z;
constexpr size_t WS_MEMN = WS_Z + 16 * MiB;
constexpr size_t WS_LAU = WS_Z + 10 * ZSLOT;
constexpr size_t WS_LNP = WS_LAU + 2 * ZSLOT;
constexpr size_t WS_END = WS_LNP + (size_t)TC * 128;

constexpr int LDS_BYTES = 147456;

typedef __bf16 bf16x2_t __attribute__((ext_vector_type(2)));
__device__ __forceinline__ unsigned cvt_pk_bf16(float lo, float hi) { const f32x2 v = {lo, hi}; return __builtin_bit_cast(unsigned, __builtin_convertvector(v, bf16x2_t)); }
__device__ __forceinline__ float bflo(unsigned w) { return __uint_as_float(w << 16); }
__device__ __forceinline__ float bfhi(unsigned w) { return __uint_as_float(w & 0xffff0000u); }
__device__ __forceinline__ float bf1(bf16_t b) { return __uint_as_float(((unsigned)b) << 16); }
__device__ __forceinline__ bf16_t f2bf(float f) { return (bf16_t)(cvt_pk_bf16(f, 0.f) & 0xffffu); }
__device__ __forceinline__ float wave_sum(float v) {
#pragma unroll
    for (int o = 1; o < 64; o <<= 1) v += __shfl_xor(v, o);
    return v;
}
__device__ __forceinline__ int otid() { int t = threadIdx.x; asm volatile("" : "+v"(t)); return t; }
#define GAS __attribute__((address_space(1)))
template <class T> __device__ __forceinline__ T* asglobal(T* p) { return (T*)(GAS T*)p; }
__device__ __forceinline__ unsigned char* ows(unsigned char* w) { GAS unsigned char* g = (GAS unsigned char*)w; asm volatile("" : "+s"(g)); return (unsigned char*)g; }
__device__ __forceinline__ int obid() { int t = blockIdx.x; asm volatile("" : "+s"(t)); return t; }
__device__ __forceinline__ int ogrid() { int t = gridDim.x; asm volatile("" : "+s"(t)); return t; }
__device__ __forceinline__ float frcp(float x) { return __builtin_amdgcn_rcpf(x); }
__device__ __forceinline__ float fexp(float x) { return __builtin_amdgcn_exp2f(x * 1.44269504089f); }
__device__ __forceinline__ float sigm(float x) { return frcp(1.0f + fexp(-x)); }
__device__ __forceinline__ float silu(float x) { return x * frcp(1.0f + fexp(-x)); }
__device__ __forceinline__ float one_minus_exp(float x, float e, float w) {
    float q = 1.0f + x * (1.0f / 7.0f); q = 1.0f + x * (1.0f / 6.0f) * q; q = 1.0f + x * 0.2f * q; q = 1.0f + x * 0.25f * q; q = 1.0f + x * (1.0f / 3.0f) * q; q = 1.0f + x * 0.5f * q;
    const float d = 1.0f - e;
    return d + w * (-x * q - d);
}

namespace pg8 {
constexpr int BM = 256, BK = 64, HALF = 128, HTB = HALF * BK * 2, STAGE_BYTES = 8 * HTB, NXCD = 8, WGM = 8;
__host__ __device__ __forceinline__ int lds_byte(int r, int c) { const int st = (r >> 4) * 2 + (c >> 5), rr = r & 15, cc = c & 31, ob = rr * 64 + cc * 2; return st * 1024 + (ob ^ (((ob >> 9) & 1) << 5)); }
__host__ __device__ __forceinline__ void stage_rc(int b, int& R, int& C) { const int st = b / 1024, sb = b % 1024, swz = sb ^ (((sb >> 9) & 1) << 5); R = (st >> 1) * 16 + swz / 64; C = (st & 1) * 32 + (swz % 64) / 2; }
__host__ __device__ __forceinline__ int perm32(int rho) { const int n = rho >> 4, i = rho & 15; return 8 * (i >> 2) + 4 * n + (i & 3); }

struct Unit { const char* A; const char* B; int r0, c0, aux; };

template <class Epi, class Sched, bool ALIGN_EPI>
__device__ __forceinline__ void gemm_phase(LAS unsigned char* lds, const int K, const Sched& S, const Epi& E) {
    const int tid = otid(), wid = __builtin_amdgcn_readfirstlane(tid >> 6), lane = tid & 63, wr = wid >> 2, wc = wid & 3, fr = lane & 15, fq = lane >> 4;
    const int nt = K / BK;
    unsigned voffA[2], voffB[2];
#pragma unroll
    for (int i = 0; i < 2; ++i) { int R, C; stage_rc(tid * 16 + i * 8192, R, C); const int Rb = Epi::PERM ? ((R >> 5) * 64 + perm32(R & 31)) : R;
        voffA[i] = (unsigned)(R * K + C) * 2u; voffB[i] = (unsigned)(Rb * K + C) * 2u; }
    const size_t kstep = (size_t)(BK * 2);
    const size_t hstep = (size_t)HALF * K * 2;
    const size_t hstepB = Epi::PERM ? (size_t)32 * K * 2 : hstep;
    const unsigned ldsw = (unsigned)wid * 1024u;
    const int aoff = lds_byte(wr * 64 + fr, fq * 8), boff = lds_byte(wc * 32 + fr, fq * 8);
#define PG8_SA(b, h) (((b) * 2 + (h)) * HTB)
#define PG8_SB(b, h) ((4 + (b) * 2 + (h)) * HTB)
#define PG8_STAGE(bufoff, gbase, voff) do { _Pragma("unroll") for (int _i = 0; _i < 2; ++_i) \
        __builtin_amdgcn_global_load_lds((const unsigned*)((const char*)(gbase) + (voff)[_i]), (LAS unsigned*)(lds + (bufoff) + ldsw + _i * 8192), 16, 0, 0); } while (0)
#define PG8_LDA(dst, b, h) do { _Pragma("unroll") for (int m = 0; m < 4; ++m) _Pragma("unroll") for (int k = 0; k < 2; ++k) dst[m][k] = *(const LAS bf16x8*)(lds + PG8_SA(b, h) + aoff + m * 2048 + k * 1024); } while (0)
#define PG8_LDB(dst, b, h) do { _Pragma("unroll") for (int n = 0; n < 2; ++n) _Pragma("unroll") for (int k = 0; k < 2; ++k) dst[n][k] = *(const LAS bf16x8*)(lds + PG8_SB(b, h) + boff + n * 2048 + k * 1024); } while (0)
#define PG8_MMA(ai, bj, At, Bt) do { __builtin_amdgcn_s_setprio(1); _Pragma("unroll") for (int m = 0; m < 4; ++m) _Pragma("unroll") for (int n = 0; n < 2; ++n) _Pragma("unroll") for (int k = 0; k < 2; ++k) \
        acc[ai][bj][m][n] = __builtin_amdgcn_mfma_f32_16x16x32_bf16(Bt[n][k], At[m][k], acc[ai][bj][m][n], 0, 0, 0); __builtin_amdgcn_s_setprio(0); } while (0)
#define PG8_WAIT_V(n) asm volatile("s_waitcnt vmcnt(" #n ")" ::: "memory")
#define PG8_WAIT_L(n) asm volatile("s_waitcnt lgkmcnt(" #n ")" ::: "memory")
#define PG8_BAR __builtin_amdgcn_s_barrier()
#define PG8_SCHED __builtin_amdgcn_sched_barrier(0)
    Unit cur, nxt; int ui = 0;
    if (!S.next(0, cur)) return;
    f32x4 acc[2][2][4][2];
#pragma unroll
    for (int a = 0; a < 2; ++a)
#pragma unroll
        for (int b = 0; b < 2; ++b)
#pragma unroll
            for (int m = 0; m < 4; ++m)
#pragma unroll
                for (int n = 0; n < 2; ++n) acc[a][b][m][n] = (f32x4){0.f, 0.f, 0.f, 0.f};
    bf16x8 At[4][2], B0[2][2], B1[2][2];
    const char* cA = cur.A; const char* cB = cur.B;
    PG8_STAGE(PG8_SB(0, 0), cB, voffB); PG8_STAGE(PG8_SB(0, 1), cB + hstepB, voffB); PG8_STAGE(PG8_SA(0, 0), cA, voffA); PG8_STAGE(PG8_SA(0, 1), cA + hstep, voffA);
    if (wr == 1) PG8_BAR;
    PG8_WAIT_V(2); PG8_BAR;
    PG8_STAGE(PG8_SB(1, 0), cB + kstep, voffB); PG8_STAGE(PG8_SA(1, 0), cA + kstep, voffA); PG8_STAGE(PG8_SB(1, 1), cB + hstepB + kstep, voffB);
    PG8_WAIT_V(6); PG8_BAR;
    for (;;) {
        const bool has_next = S.next(ui + 1, nxt);
        const char* nA = has_next ? nxt.A : cA; const char* nB = has_next ? nxt.B : cB;
        for (int t = 0; t < nt; t += 2) {
            const bool last = (t == nt - 2);
            const char* a1 = cA + (size_t)(t + 1) * kstep;
            const char* a2 = last ? nA : cA + (size_t)(t + 2) * kstep; const char* b2 = last ? nB : cB + (size_t)(t + 2) * kstep;
            const char* a3 = a2 + kstep; const char* b3 = b2 + kstep;
            PG8_LDB(B0, 0, 0); PG8_LDB(B1, 0, 1); PG8_SCHED; PG8_LDA(At, 0, 0); PG8_STAGE(PG8_SA(1, 1), a1 + hstep, voffA);
            PG8_WAIT_V(8); PG8_WAIT_L(0); PG8_BAR; PG8_MMA(0, 0, At, B0); PG8_MMA(0, 1, At, B1); PG8_BAR; PG8_SCHED;
            PG8_LDA(At, 0, 1); PG8_STAGE(PG8_SB(0, 0), b2, voffB); PG8_STAGE(PG8_SB(0, 1), b2 + hstepB, voffB); PG8_STAGE(PG8_SA(0, 0), a2, voffA);
            PG8_WAIT_V(8); PG8_WAIT_L(0); PG8_BAR; PG8_MMA(1, 0, At, B0); PG8_MMA(1, 1, At, B1); PG8_BAR; PG8_SCHED;
            PG8_LDB(B0, 1, 0); PG8_LDB(B1, 1, 1); PG8_SCHED; PG8_LDA(At, 1, 0); PG8_STAGE(PG8_SA(0, 1), a2 + hstep, voffA);
            PG8_WAIT_V(8); PG8_WAIT_L(0); PG8_BAR; PG8_MMA(0, 0, At, B0); PG8_MMA(0, 1, At, B1); PG8_BAR; PG8_SCHED;
            PG8_LDA(At, 1, 1); PG8_STAGE(PG8_SB(1, 0), b3, voffB); PG8_STAGE(PG8_SB(1, 1), b3 + hstepB, voffB); PG8_STAGE(PG8_SA(1, 0), a3, voffA);
            PG8_WAIT_V(8); PG8_WAIT_L(0); PG8_BAR; PG8_MMA(1, 0, At, B0); PG8_MMA(1, 1, At, B1); PG8_BAR; PG8_SCHED;
        }
        if constexpr (ALIGN_EPI) { if (wr == 0) PG8_BAR; }
        bool zero = true;
        if constexpr (!Epi::AFTER_DRAIN) zero = E(acc, cur, wr, wc, fr, fq);
        if (!has_next) break;
        if (zero) {
#pragma unroll
            for (int a = 0; a < 2; ++a)
#pragma unroll
                for (int b = 0; b < 2; ++b)
#pragma unroll
                    for (int m = 0; m < 4; ++m)
#pragma unroll
                        for (int n = 0; n < 2; ++n) acc[a][b][m][n] = (f32x4){0.f, 0.f, 0.f, 0.f};
        }
        cur = nxt; cA = nA; cB = nB; ++ui;
        if constexpr (ALIGN_EPI) { if (wr == 1) PG8_BAR; }
    }
    PG8_WAIT_V(0);
    if constexpr (!ALIGN_EPI) { if (wr == 0) PG8_BAR; }
    PG8_BAR;
    if constexpr (Epi::AFTER_DRAIN) E.fused(acc, cur, wr, wc, fr, fq, lds, wid, lane);
#undef PG8_SA
#undef PG8_SB
#undef PG8_STAGE
#undef PG8_LDA
#undef PG8_LDB
#undef PG8_MMA
#undef PG8_WAIT_V
#undef PG8_WAIT_L
#undef PG8_BAR
#undef PG8_SCHED
}

struct EpiBf16 {
    static constexpr bool PERM = true, AFTER_DRAIN = false;
    bf16_t* O; int ldc; size_t split_stride; int split; const float* rowss; float* lnp;
    __device__ __forceinline__ bool operator()(f32x4 (&acc)[2][2][4][2], const Unit& u, int wr, int wc, int fr, int fq) const {
        const int row0 = u.r0 + wr * 64 + fr, pn = u.c0 >> 8;
        const bool paired = pn < 8, vtile = (pn >> 2) == 2;
        const int slot = paired ? 0 : (pn < 12 ? 1 : (pn >> 2));
        bf16_t* base = O + (size_t)slot * split_stride;
        const int col0 = paired ? (pn * 128 + wc * 32 + 8 * fq) : ((pn & 3) * 256 + wc * 64 + 8 * fq);
#pragma unroll
        for (int ai = 0; ai < 2; ++ai)
#pragma unroll
            for (int m = 0; m < 4; ++m) { bf16_t* rowp = base + (size_t)(row0 + ai * HALF + m * 16) * ldc + col0;
                float rs = 1.0f; if (rowss) { const f32x4 q = *(const f32x4*)(rowss + (size_t)(row0 + ai * HALF + m * 16) * 4); rs = __builtin_amdgcn_rsqf((((q.x + q.y) + q.z) + q.w) * (1.0f / D) + EPS); }
                if (paired) {
                    const f32x4 u0 = acc[ai][0][m][0] * rs, u1 = acc[ai][0][m][1] * rs, g0 = acc[ai][1][m][0] * rs, g1 = acc[ai][1][m][1] * rs;
                    u32x4 w; w.x = cvt_pk_bf16(u0[0] * silu(g0[0]), u0[1] * silu(g0[1])); w.y = cvt_pk_bf16(u0[2] * silu(g0[2]), u0[3] * silu(g0[3]));
                    w.z = cvt_pk_bf16(u1[0] * silu(g1[0]), u1[1] * silu(g1[1])); w.w = cvt_pk_bf16(u1[2] * silu(g1[2]), u1[3] * silu(g1[3]));
                    *(u32x4*)rowp = w;
                } else {
                    float ls = 0.f, lq = 0.f;
#pragma unroll
                    for (int bj = 0; bj < 2; ++bj) { const f32x4 v0 = acc[ai][bj][m][0] * rs, v1 = acc[ai][bj][m][1] * rs;
                        if (vtile) { ls += ((v0[0] + v0[1]) + (v0[2] + v0[3])) + ((v1[0] + v1[1]) + (v1[2] + v1[3]));
                            lq += ((v0[0] * v0[0] + v0[1] * v0[1]) + (v0[2] * v0[2] + v0[3] * v0[3])) + ((v1[0] * v1[0] + v1[1] * v1[1]) + (v1[2] * v1[2] + v1[3] * v1[3])); }
                        u32x4 w; w.x = cvt_pk_bf16(v0[0], v0[1]); w.y = cvt_pk_bf16(v0[2], v0[3]); w.z = cvt_pk_bf16(v1[0], v1[1]); w.w = cvt_pk_bf16(v1[2], v1[3]);
                        *(u32x4*)(rowp + bj * 32) = w; }
                    if (vtile) {
                        ls += __shfl_xor(ls, 16); ls += __shfl_xor(ls, 32); lq += __shfl_xor(lq, 16); lq += __shfl_xor(lq, 32);
                        if (fq == 0) *(f32x2*)(lnp + ((size_t)(row0 + ai * HALF + m * 16) * 16 + (pn & 3) * 4 + wc) * 2) = (f32x2){ls, lq}; } } }
        return true;
    }
};
struct EpiKV {
    static constexpr bool PERM = true, AFTER_DRAIN = false;
    bf16_t* KM; bf16_t* VT;
    __device__ __forceinline__ bool operator()(f32x4 (&acc)[2][2][4][2], const Unit& u, int wr, int wc, int fr, int fq) const {
        const int l = u.aux >> 1, isv = u.aux & 1; const int ldc = isv ? MROWS : D;
        bf16_t* base = (isv ? VT : KM) + (size_t)l * MROWS * D;
        const int row0 = u.r0 + wr * 64 + fr, col0 = u.c0 + wc * 64 + 8 * fq;
#pragma unroll
        for (int ai = 0; ai < 2; ++ai)
#pragma unroll
            for (int m = 0; m < 4; ++m) { bf16_t* rowp = base + (size_t)(row0 + ai * HALF + m * 16) * ldc + col0;
#pragma unroll
                for (int bj = 0; bj < 2; ++bj) { const f32x4 v0 = acc[ai][bj][m][0], v1 = acc[ai][bj][m][1];
                    u32x4 w; w.x = cvt_pk_bf16(v0[0], v0[1]); w.y = cvt_pk_bf16(v0[2], v0[3]); w.z = cvt_pk_bf16(v1[0], v1[1]); w.w = cvt_pk_bf16(v1[2], v1[3]);
                    *(u32x4*)(rowp + bj * 32) = w; } }
        return true;
    }
};
struct EpiF32 {
    static constexpr bool PERM = false, AFTER_DRAIN = false;
    float* C;
    __device__ __forceinline__ bool operator()(f32x4 (&acc)[2][2][4][2], const Unit& u, int wr, int wc, int fr, int fq) const {
        const int row0 = u.r0 + wr * 64 + fr, col0 = u.c0 + wc * 32 + 4 * fq;
#pragma unroll
        for (int ai = 0; ai < 2; ++ai)
#pragma unroll
            for (int m = 0; m < 4; ++m) { float* rowp = C + (size_t)(row0 + ai * HALF + m * 16) * D + col0;
#pragma unroll
                for (int bj = 0; bj < 2; ++bj)
#pragma unroll
                    for (int n = 0; n < 2; ++n) *(f32x4*)(rowp + bj * HALF + n * 16) = acc[ai][bj][m][n]; }
        return true;
    }
};

struct EpiOutNorm {
    static constexpr bool PERM = false, AFTER_DRAIN = true;
    const float* xsrc; float* xdst; bf16_t* H; const float* gpost; const float* gpre; float* slot1; float* slot2; unsigned* cnt; unsigned want;
    __device__ __forceinline__ bool operator()(f32x4 (&acc)[2][2][4][2], const Unit& u, int wr, int wc, int fr, int fq) const { return true; }
    __device__ __forceinline__ void fused(f32x4 (&acc)[2][2][4][2], const Unit& u, int wr, int wc, int fr, int fq, LAS unsigned char* lds, int wid, int lane) const {
        const int row0 = u.r0 + wr * 64 + fr, col0 = u.c0 + wc * 32 + 4 * fq, pn = u.c0 >> 8, tid = wid * 64 + lane;
        LAS float* P = (LAS float*)lds;
#pragma unroll
        for (int ai = 0; ai < 2; ++ai)
#pragma unroll
            for (int m = 0; m < 4; ++m) { float sq = 0.f;
#pragma unroll
                for (int bj = 0; bj < 2; ++bj)
#pragma unroll
                    for (int n = 0; n < 2; ++n) { const f32x4 v = acc[ai][bj][m][n]; sq += (v[0] * v[0] + v[1] * v[1]) + (v[2] * v[2] + v[3] * v[3]); }
                sq += __shfl_xor(sq, 16); sq += __shfl_xor(sq, 32);
                if (fq == 0) P[(ai * HALF + wr * 64 + m * 16 + fr) * 4 + wc] = sq; }
        asm volatile("s_waitcnt lgkmcnt(0)" ::: "memory"); __builtin_amdgcn_s_barrier(); asm volatile("" ::: "memory");
        if (tid < 256) { const f32x4 q = *(const LAS f32x4*)(P + tid * 4); __hip_atomic_store(slot1 + (size_t)(u.r0 + tid) * 4 + pn, ((q.x + q.y) + q.z) + q.w, __ATOMIC_RELAXED, __HIP_MEMORY_SCOPE_AGENT); }
        asm volatile("s_waitcnt vmcnt(0) lgkmcnt(0)" ::: "memory"); __builtin_amdgcn_s_barrier(); asm volatile("" ::: "memory");
        unsigned* pc = cnt + 64 * (u.r0 >> 8);
        if (wid == 0) {
            if (lane == 0) __hip_atomic_fetch_add(pc, 1u, __ATOMIC_RELAXED, __HIP_MEMORY_SCOPE_AGENT);
            unsigned sp = 0;
            while ((unsigned)__builtin_amdgcn_readfirstlane(__hip_atomic_load(pc, __ATOMIC_RELAXED, __HIP_MEMORY_SCOPE_AGENT)) < want) { __builtin_amdgcn_s_sleep(1); if (++sp > (1u << 22)) break; }
            __builtin_amdgcn_fence(__ATOMIC_ACQUIRE, "agent");
            asm volatile("s_waitcnt vmcnt(0)" ::: "memory"); }
        asm volatile("" ::: "memory"); __builtin_amdgcn_s_barrier(); asm volatile("" ::: "memory");
        f32x4 gp[2][2], gq[2][2];
#pragma unroll
        for (int bj = 0; bj < 2; ++bj)
#pragma unroll
            for (int n = 0; n < 2; ++n) { gp[bj][n] = *(const f32x4*)(gpost + col0 + bj * HALF + n * 16); gq[bj][n] = H ? *(const f32x4*)(gpre + col0 + bj * HALF + n * 16) : (f32x4){0.f, 0.f, 0.f, 0.f}; }
#pragma unroll
        for (int ai = 0; ai < 2; ++ai)
#pragma unroll
            for (int m = 0; m < 4; ++m) { const int row = row0 + ai * HALF + m * 16; const size_t off = (size_t)row * D + col0;
                const float t0 = __hip_atomic_load(slot1 + (size_t)row * 4 + 0, __ATOMIC_RELAXED, __HIP_MEMORY_SCOPE_AGENT), t1 = __hip_atomic_load(slot1 + (size_t)row * 4 + 1, __ATOMIC_RELAXED, __HIP_MEMORY_SCOPE_AGENT),
                            t2 = __hip_atomic_load(slot1 + (size_t)row * 4 + 2, __ATOMIC_RELAXED, __HIP_MEMORY_SCOPE_AGENT), t3 = __hip_atomic_load(slot1 + (size_t)row * 4 + 3, __ATOMIC_RELAXED, __HIP_MEMORY_SCOPE_AGENT);
                const float r1 = __builtin_amdgcn_rsqf((((t0 + t1) + t2) + t3) * (1.0f / D) + EPS);
                float s2 = 0.f;
#pragma unroll
                for (int bj = 0; bj < 2; ++bj)
#pragma unroll
                    for (int n = 0; n < 2; ++n) { const f32x4 xv = *(const f32x4*)(xsrc + off + bj * HALF + n * 16);
                        const f32x4 xn = xv + acc[ai][bj][m][n] * r1 * gp[bj][n];
                        *(f32x4*)(xdst + off + bj * HALF + n * 16) = xn;
                        s2 += (xn[0] * xn[0] + xn[1] * xn[1]) + (xn[2] * xn[2] + xn[3] * xn[3]);
                        if (H) { const f32x4 a = xn * gq[bj][n]; u32x2 w; w.x = cvt_pk_bf16(a[0], a[1]); w.y = cvt_pk_bf16(a[2], a[3]); *(u32x2*)(H + off + bj * HALF + n * 16) = w; } }
                s2 += __shfl_xor(s2, 16); s2 += __shfl_xor(s2, 32);
                if (fq == 0) P[(ai * HALF + wr * 64 + m * 16 + fr) * 4 + wc] = s2;
                asm volatile("" ::: "memory"); }
        asm volatile("s_waitcnt lgkmcnt(0)" ::: "memory"); __builtin_amdgcn_s_barrier(); asm volatile("" ::: "memory");
        if (H && tid < 256) { const f32x4 q = *(const LAS f32x4*)(P + tid * 4); slot2[(size_t)(u.r0 + tid) * 4 + pn] = ((q.x + q.y) + q.z) + q.w; }
    }
};
struct EpiMerge {
    static constexpr bool PERM = true, AFTER_DRAIN = false;
    const bf16_t* ML;
    bf16_t* O;
    __device__ __forceinline__ bool operator()(f32x4 (&acc)[2][2][4][2], const Unit& u, int wr, int wc, int fr, int fq) const {
        const int sub = u.aux;
        const int row0 = u.r0 + wr * 64 + fr, col0 = u.c0 + wc * 64 + 8 * fq;
        const bf16_t* l0 = ML + (size_t)sub * TC * D;
#pragma unroll
        for (int ai = 0; ai < 2; ++ai)
#pragma unroll
            for (int m = 0; m < 4; ++m) { const size_t off = (size_t)(row0 + ai * HALF + m * 16) * D + col0;
#pragma unroll
                for (int bj = 0; bj < 2; ++bj) {
                    const u32x4 a = *(const u32x4*)(l0 + off + bj * 32);
                    float la[8] = {bflo(a.x), bfhi(a.x), bflo(a.y), bfhi(a.y), bflo(a.z), bfhi(a.z), bflo(a.w), bfhi(a.w)};
                    float f[8];
                    if (sub < 2) {
                        const u32x4 b = *(const u32x4*)(l0 + (size_t)TC * D + off + bj * 32);
                        float lb[8] = {bflo(b.x), bfhi(b.x), bflo(b.y), bfhi(b.y), bflo(b.z), bfhi(b.z), bflo(b.w), bfhi(b.w)};
#pragma unroll
                        for (int j = 0; j < 8; ++j) { const float ea = fexp(-fminf(fmaxf(la[j], -60.f), 60.f)), eb = fexp(-fminf(fmaxf(lb[j], -60.f), 60.f)); f[j] = (1.0f + eb) * frcp(1.0f + ea); }
                    } else {
#pragma unroll
                        for (int j = 0; j < 8; ++j) f[j] = frcp(1.0f + fexp(-fminf(fmaxf(la[j], -60.f), 60.f)));
                    }
                    f32x4 v0 = acc[ai][bj][m][0], v1 = acc[ai][bj][m][1];
                    v0[0] *= f[0]; v0[1] *= f[1]; v0[2] *= f[2]; v0[3] *= f[3]; v1[0] *= f[4]; v1[1] *= f[5]; v1[2] *= f[6]; v1[3] *= f[7];
                    if (sub < 2) { acc[ai][bj][m][0] = v0; acc[ai][bj][m][1] = v1; }
                    else { u32x4 w; w.x = cvt_pk_bf16(v0[0], v0[1]); w.y = cvt_pk_bf16(v0[2], v0[3]); w.z = cvt_pk_bf16(v1[0], v1[1]); w.w = cvt_pk_bf16(v1[2], v1[3]);
                        *(u32x4*)(O + off + bj * 32) = w; }
                } }
        return sub == 2;
    }
};

struct SchedGrid {
    const char* A; const char* B; int nM, nN, nwg, G, c; size_t tstep;
    __device__ __forceinline__ bool next(int i, Unit& u) const {
        const long L = (long)i * G + c; if (L >= nwg) return false;
        int wgid = (int)L; { const int q = nwg / NXCD, r = nwg % NXCD, xcd = wgid % NXCD, off = wgid / NXCD; wgid = (xcd < r ? xcd * (q + 1) : r * (q + 1) + (xcd - r) * q) + off; }
        const int nig = WGM * nN, gid = wgid / nig, fm = gid * WGM, gsz = (nM - fm) < WGM ? (nM - fm) : WGM;
        const int pm = fm + ((wgid % nig) % gsz), pn = (wgid % nig) / gsz;
        u.A = A + (size_t)pm * tstep; u.B = B + (size_t)pn * tstep; u.r0 = pm * BM; u.c0 = pn * BM; u.aux = 0; return true;
    }
};
struct SchedKV {
    const char* MEMN; const char* WKV; int G, c;
    __device__ __forceinline__ bool next(int i, Unit& u) const {
        const int id = i * G + c; if (id >= 256) return false;
        const size_t tstep = (size_t)BM * D * 2;
        const int l = id >> 6, r = id & 63; const char* w = WKV + (size_t)l * 2048 * D * 2;
        if (r < 32) { const int pm = r >> 2, pn = r & 3; u.A = MEMN + pm * tstep; u.B = w + pn * tstep; u.r0 = pm * BM; u.c0 = pn * BM; u.aux = l << 1; }
        else { const int rr = r - 32, pm = rr >> 3, pn = rr & 7; u.A = w + (size_t)(4 + pm) * tstep; u.B = MEMN + pn * tstep; u.r0 = pm * BM; u.c0 = pn * BM; u.aux = (l << 1) | 1; }
        return true;
    }
};
struct SchedMerge {
    const char* Z; const char* WP; int G, c;
    __device__ __forceinline__ bool next(int i, Unit& u) const {
        const int tile = (i / 3) * G + c, sub = i % 3; if (tile >= (TC / BM) * 4) return false;
        const size_t tstep = (size_t)BM * D * 2;
        const int pm = tile >> 2, pn = tile & 3; const int slot = sub == 0 ? 0 : (sub == 1 ? 4 : 6);
        u.A = Z + (size_t)slot * ZSLOT + pm * tstep; u.B = WP + (size_t)sub * D * D * 2 + pn * tstep; u.r0 = pm * BM; u.c0 = pn * BM; u.aux = sub; return true;
    }
};
}

struct Params { const float* in[22]; float* out; unsigned char* ws; int ph_lo, ph_hi; };
typedef const __attribute__((address_space(4))) Params* KP;
enum { I_X = 0, I_MEM, I_MEMG, I_PREG, I_POSTG, I_WIN, I_LNG, I_LNB, I_WS, I_BS, I_CONVW, I_CONVB, I_WR, I_BR, I_WI, I_BI, I_LAM, I_WKV, I_WPA, I_WPB, I_WPC, I_WOUT };

__device__ __forceinline__ void transpose_item(const float* W, int ldw, bf16_t* WT, int ldt, int nblk, LAS float* scr, int item, int lane, bool remap = false) {
    const int kb = item / nblk, nb = item % nblk, k0 = 64 * kb, n0 = 32 * nb;
    int dn0 = n0;
    if (remap) { if (n0 < 1024) dn0 = ((n0 >> 7) * 8 + ((n0 >> 5) & 3) * 2) * 32; else if (n0 < 2048) dn0 = n0 + 1024; else if (n0 < 3072) { const int ch = n0 - 2048; dn0 = ((ch >> 7) * 8 + ((ch >> 5) & 3) * 2 + 1) * 32; } }
#pragma unroll 8
    for (int i = 0; i < 32; ++i) { const int kk = 2 * i + (lane >> 5); scr[kk * 33 + (lane & 31)] = W[(size_t)(k0 + kk) * ldw + n0 + (lane & 31)]; }
    asm volatile("s_waitcnt lgkmcnt(0)" ::: "memory");
    const int c = lane & 7;
#pragma unroll
    for (int j = 0; j < 4; ++j) { const int n = (lane >> 3) + 8 * j; const LAS float* s = scr + (8 * c) * 33 + n;
        u32x4 o; o.x = cvt_pk_bf16(s[0 * 33], s[1 * 33]); o.y = cvt_pk_bf16(s[2 * 33], s[3 * 33]); o.z = cvt_pk_bf16(s[4 * 33], s[5 * 33]); o.w = cvt_pk_bf16(s[6 * 33], s[7 * 33]);
        *(u32x4*)(WT + (size_t)(dn0 + n) * ldt + k0 + 8 * c) = o; }
    asm volatile("s_waitcnt lgkmcnt(0)" ::: "memory");
}
__device__ __forceinline__ void rms_row_to_bf16(const float* xrow, const float* g, bf16_t* orow, int lane) {
    const f32x4* xr = (const f32x4*)xrow + lane; const f32x4* gr = (const f32x4*)g + lane;
    f32x4 v[4]; float s = 0.f;
#pragma unroll
    for (int j = 0; j < 4; ++j) { v[j] = xr[64 * j]; s += (v[j].x * v[j].x + v[j].y * v[j].y) + (v[j].z * v[j].z + v[j].w * v[j].w); }
    const float r = __builtin_amdgcn_rsqf(wave_sum(s) * (1.0f / D) + EPS);
    u32x2* o8 = (u32x2*)orow + lane;
#pragma unroll
    for (int j = 0; j < 4; ++j) { const f32x4 gv = gr[64 * j]; u32x2 w; w.x = cvt_pk_bf16(v[j].x * r * gv.x, v[j].y * r * gv.y); w.y = cvt_pk_bf16(v[j].z * r * gv.z, v[j].w * r * gv.w); o8[64 * j] = w; }
}
__device__ __forceinline__ void row_to_aprime(const float* xrow, const float* g, bf16_t* orow, float* ss, int lane) {
    const f32x4* xr = (const f32x4*)xrow + lane; const f32x4* gr = (const f32x4*)g + lane;
    f32x4 v[4]; float s = 0.f;
#pragma unroll
    for (int j = 0; j < 4; ++j) { v[j] = xr[64 * j]; s += (v[j].x * v[j].x + v[j].y * v[j].y) + (v[j].z * v[j].z + v[j].w * v[j].w); }
    s = wave_sum(s);
    u32x2* o8 = (u32x2*)orow + lane;
#pragma unroll
    for (int j = 0; j < 4; ++j) { const f32x4 gv = gr[64 * j]; u32x2 w; w.x = cvt_pk_bf16(v[j].x * gv.x, v[j].y * gv.y); w.y = cvt_pk_bf16(v[j].z * gv.z, v[j].w * gv.w); o8[64 * j] = w; }
    if (lane == 0) *(f32x4*)ss = (f32x4){s, 0.f, 0.f, 0.f};
}
__device__ __forceinline__ void phase_prologue(KP p, LAS unsigned char* lds) {
    const int tid = otid(), lane = tid & 63, wave = tid >> 6;
    const int gw = obid() * 8 + wave, NGW = ogrid() * 8;
    LAS float* scr = (LAS float*)(lds + wave * 16384);
    unsigned char* ws = ows(p->ws);
    constexpr int PER_L = 5120 + 1024 + 4 * 512 + 128;
    for (int it = gw; it < DEPTH * PER_L; it += NGW) {
        const int l = it / PER_L; int r = it % PER_L;
        if (r < 5120) { transpose_item(asglobal(p->in[I_WIN]) + (size_t)l * D * INW, INW, (bf16_t*)(ws + WS_WIN) + (size_t)l * INW * D, D, INW / 32, scr, r, lane, true); continue; } r -= 5120;
        if (r < 1024) { transpose_item(asglobal(p->in[I_WKV]) + (size_t)l * D * 2048, 2048, (bf16_t*)(ws + WS_WKV) + (size_t)l * 2048 * D, D, 64, scr, r, lane); continue; } r -= 1024;
        if (r < 1536) { const int b = r / 512; transpose_item(asglobal(p->in[I_WPA + b]) + (size_t)l * D * D, D, (bf16_t*)(ws + WS_WP) + (size_t)(l * 3 + b) * D * D, D, 32, scr, r % 512, lane); continue; } r -= 1536;
        if (r < 512) { transpose_item(asglobal(p->in[I_WOUT]) + (size_t)l * D * D, D, (bf16_t*)(ws + WS_WOUT) + (size_t)l * D * D, D, 32, scr, r, lane); continue; } r -= 512;
        { const int ri = r >> 6, h = (r >> 3) & 7, sub = r & 7;
          transpose_item(asglobal(p->in[ri ? I_WI : I_WR]) + (size_t)(l * 8 + h) * 128 * 128, 128, (bf16_t*)(ws + WS_WLRU) + ((size_t)(l * 8 + h) * 256 + ri * 128) * 128, 128, 4, scr, sub, lane); }
    }
    { const float* W = asglobal(p->in[I_WS]); bf16_t* O = (bf16_t*)(ws + WS_WG);
      for (int i4 = obid() * NTHR + tid; i4 < DEPTH * 8 * 128 * 128 / 4; i4 += ogrid() * NTHR) {
          const int e = i4 * 4, j = e & 127, i = (e >> 7) & 127; f32x4 v = *(const f32x4*)(W + e);
          if (i < 64 && j >= 64) v = (f32x4){0.f, 0.f, 0.f, 0.f};
          u32x2 w; w.x = cvt_pk_bf16(v.x, v.y); w.y = cvt_pk_bf16(v.z, v.w); *(u32x2*)(O + e) = w; } }
    for (int m = gw; m < MROWS; m += NGW) rms_row_to_bf16(asglobal(p->in[I_MEM]) + (size_t)m * D, asglobal(p->in[I_MEMG]), (bf16_t*)(ws + WS_MEMN) + (size_t)m * D, lane);
    for (int m = gw; m < TC; m += NGW) row_to_aprime(asglobal(p->in[I_X]) + (size_t)m * D, asglobal(p->in[I_PREG]), (bf16_t*)(ws + WS_H) + (size_t)m * D, (float*)(ws + WS_SS2) + (size_t)m * 4, lane);
}

__device__ __forceinline__ int crow(int reg, int h) { return (reg & 3) + 8 * (reg >> 2) + 4 * h; }
constexpr int LR_XB = 0, LR_XA = 17408, LR_UA = 34816, LR_UU = 67584, LR_SEG = 100352, LR_CAR = 104448, LR_CW = 106496, LR_END = 109568;
template <int PASS>
__device__ __forceinline__ void lru_item(KP p, LAS unsigned char* lds, int l, int item, unsigned pass_tag) {
    const int tid = otid(), lane = tid & 63, wave = tid >> 6, l31 = lane & 31, hh = lane >> 5;
    const int e8 = item & 7, head = (item >> 3) & 7, bl = item >> 6;
    unsigned char* ws = ows(p->ws);
    bf16_t* zxb = (bf16_t*)(ws + WS_Z + 3 * ZSLOT); bf16_t* zgb = (bf16_t*)(ws + WS_Z + 4 * ZSLOT); bf16_t* zgo = zgb; unsigned* lau = (unsigned*)(ws + WS_LAU);
    float* agg = (float*)(ws + WS_AGG);
    const int rowbase = bl * SEQ + e8 * 512;
    const int tb = __builtin_amdgcn_readfirstlane(wave & 1), dblk = __builtin_amdgcn_readfirstlane(wave >> 1);
    bf16x8 wr_f[8], wi_f[8];
    { const bf16_t* w = (const bf16_t*)(ws + WS_WLRU) + ((size_t)(l * 8 + head) * 256 + dblk * 32 + l31) * 128 + 8 * hh;
#pragma unroll
      for (int s = 0; s < 8; ++s) { wr_f[s] = *(const bf16x8*)(w + 16 * s); wi_f[s] = *(const bf16x8*)(w + 128 * 128 + 16 * s); } }
    const int dl = dblk * 32 + l31, dg = l * D + head * 128 + dl;
    const float br = asglobal(p->in[I_BR])[dg], bi = asglobal(p->in[I_BI])[dg];
    float c8; { const float lam = asglobal(p->in[I_LAM])[dg]; const float nl = -lam; const float sp = nl > 20.f ? nl : log1pf(fexp(nl)); c8 = 8.0f * sp; }
    const float wser = (c8 < 0.3f) ? 1.0f : 0.0f;
    const unsigned lauoff = (unsigned)((4 * hh) * D + head * 128 + dblk * 32 + l31) * 4u;
    LAS float* CW = (LAS float*)(lds + LR_CW);
    for (int i = tid; i < 640; i += NTHR) { const int k = i >> 7, c = i & 127; CW[i] = (k < 4) ? asglobal(p->in[I_CONVW])[(size_t)(l * 4 + k) * D + head * 128 + c] : asglobal(p->in[I_CONVB])[l * D + head * 128 + c]; }
    LAS float* CAR = (LAS float*)(lds + LR_CAR);
    if (tid < 128) {
        float A = 1.f, H = 0.f;
        if (PASS == 2) { for (int e = 0; e < e8; ++e) { const float a2 = agg[((size_t)(item - e8 + e) * 128 + tid) * 2], h2 = agg[((size_t)(item - e8 + e) * 128 + tid) * 2 + 1]; H = a2 * H + h2; } }
        CAR[tid * 2] = A; CAR[tid * 2 + 1] = H;
    }
    LAS float* UA = (LAS float*)(lds + LR_UA); LAS float* UU = (LAS float*)(lds + LR_UU); LAS float* SEG = (LAS float*)(lds + LR_SEG);
    u32x4 pre[3];
#pragma unroll
    for (int k3 = 0; k3 < 3; ++k3) { const int i = tid + k3 * NTHR, r = i >> 4, ch = i & 15; pre[k3] = (u32x4){0u, 0u, 0u, 0u};
        if (i < 67 * 16 && e8 * 512 + r - 3 >= 0) pre[k3] = *(const u32x4*)(zxb + (size_t)(rowbase + r - 3) * D + head * 128 + ch * 8); }
    for (int tile = 0; tile < 8; ++tile) {
        const int row0 = rowbase + tile * 64;
        const int spos0 = e8 * 512 + tile * 64;
#pragma unroll
        for (int k3 = 0; k3 < 3; ++k3) { const int i = tid + k3 * NTHR; if (i < 67 * 16) *(LAS u32x4*)(lds + LR_XB + (i >> 4) * 256 + (i & 15) * 16) = pre[k3]; }
        __syncthreads();
        if (tile + 1 < 8) {
#pragma unroll
            for (int k3 = 0; k3 < 3; ++k3) { const int i = tid + k3 * NTHR, r = i >> 4, ch = i & 15; pre[k3] = (u32x4){0u, 0u, 0u, 0u};
                if (i < 67 * 16) pre[k3] = *(const u32x4*)(zxb + (size_t)(row0 + 64 + r - 3) * D + head * 128 + ch * 8); } }
#pragma unroll
        for (int k2 = 0; k2 < 2; ++k2) { const int idx = tid + k2 * NTHR, t = idx >> 4, ch = idx & 15;
            float xc[8];
#pragma unroll
            for (int e = 0; e < 8; ++e) xc[e] = CW[512 + ch * 8 + e];
#pragma unroll
            for (int k = 0; k < 4; ++k) { const u32x4 v = *(const LAS u32x4*)(lds + LR_XB + (t + k) * 256 + ch * 16);
                const float x[8] = {bflo(v.x), bfhi(v.x), bflo(v.y), bfhi(v.y), bflo(v.z), bfhi(v.z), bflo(v.w), bfhi(v.w)};
#pragma unroll
                for (int e = 0; e < 8; ++e) xc[e] += x[e] * CW[k * 128 + ch * 8 + e]; }
            u32x4 w; w.x = cvt_pk_bf16(xc[0], xc[1]); w.y = cvt_pk_bf16(xc[2], xc[3]); w.z = cvt_pk_bf16(xc[4], xc[5]); w.w = cvt_pk_bf16(xc[6], xc[7]);
            *(LAS u32x4*)(lds + LR_XA + t * 272 + ch * 16) = w;
            *(LAS f32x4*)(UU + t * 128 + ch * 8) = (f32x4){xc[0], xc[1], xc[2], xc[3]}; *(LAS f32x4*)(UU + t * 128 + ch * 8 + 4) = (f32x4){xc[4], xc[5], xc[6], xc[7]}; }
        __syncthreads();
        bf16_t* gp = zgb + (size_t)(row0 + (tid >> 7) * 16) * D + head * 128 + (tid & 127); bf16_t* go = zgo + (size_t)(row0 + (tid >> 7) * 16) * D + head * 128 + (tid & 127); bf16_t gv[16];
        if (PASS == 2) {
#pragma unroll
            for (int t = 0; t < 16; ++t) gv[t] = gp[(size_t)t * D]; }
        f32x16 ar, ai;
#pragma unroll
        for (int i = 0; i < 16; ++i) { ar[i] = 0.f; ai[i] = 0.f; }
#pragma unroll
        for (int s = 0; s < 8; ++s) { const bf16x8 a = *(const LAS bf16x8*)(lds + LR_XA + (tb * 32 + l31) * 272 + (16 * s + 8 * hh) * 2);
            ar = __builtin_amdgcn_mfma_f32_32x32x16_bf16(a, wr_f[s], ar, 0, 0, 0); ai = __builtin_amdgcn_mfma_f32_32x32x16_bf16(a, wi_f[s], ai, 0, 0, 0); }
#pragma unroll
        for (int i = 0; i < 16; ++i) { const int t = tb * 32 + crow(i, hh);
            const float r = sigm(ar[i] + br), ig = sigm(ai[i] + bi);
            const float la = -c8 * r; const float a0 = fexp(la);
            const float dr = bflo(cvt_pk_bf16(one_minus_exp(la, a0, wser), 0.f));
            const float a = 1.0f - dr; const float mult = __builtin_amdgcn_sqrtf(fmaxf(dr * (2.0f - dr), 0.f));
            const float xcv = UU[t * 128 + dl];
            const unsigned pk = cvt_pk_bf16(dr, mult * ig * xcv);
            UA[t * 128 + dl] = a; UU[t * 128 + dl] = bfhi(pk);
            if (PASS == 1) *(unsigned*)((char*)lau + ((size_t)(row0 + tb * 32 + (i & 3) + 8 * (i >> 2)) * D * 4) + lauoff) = pk; }
        __syncthreads();
        { const int d = tid & 127, seg = tid >> 7; float A = 1.f, H = 0.f;
#pragma unroll
          for (int t = 0; t < 16; ++t) { const float a = UA[(seg * 16 + t) * 128 + d], uu = UU[(seg * 16 + t) * 128 + d]; H = a * H + uu; A *= a; }
          SEG[(seg * 128 + d) * 2] = A; SEG[(seg * 128 + d) * 2 + 1] = H;
          __syncthreads();
          const int cb = tile & 1; float cA = CAR[(cb * 128 + d) * 2], cH = CAR[(cb * 128 + d) * 2 + 1];
          for (int s2 = 0; s2 < seg; ++s2) { const float a2 = SEG[(s2 * 128 + d) * 2], h2 = SEG[(s2 * 128 + d) * 2 + 1]; cH = a2 * cH + h2; cA *= a2; }
          if (PASS == 2) { float h = cH;
#pragma unroll
              for (int t = 0; t < 16; ++t) { const float a = UA[(seg * 16 + t) * 128 + d], uu = UU[(seg * 16 + t) * 128 + d]; h = a * h + uu;
                  const float g = bf1(gv[t]); go[(size_t)t * D] = f2bf(h * silu(g)); } }
          if (seg == 3) { CAR[((cb ^ 1) * 128 + d) * 2] = cA * A; CAR[((cb ^ 1) * 128 + d) * 2 + 1] = A * cH + H; }
        }
    }
    __syncthreads();
    if (PASS == 1) {
        if (tid < 128) { __hip_atomic_store(agg + ((size_t)item * 128 + tid) * 2, CAR[tid * 2], __ATOMIC_RELAXED, __HIP_MEMORY_SCOPE_AGENT); __hip_atomic_store(agg + ((size_t)item * 128 + tid) * 2 + 1, CAR[tid * 2 + 1], __ATOMIC_RELAXED, __HIP_MEMORY_SCOPE_AGENT); }
        asm volatile("s_waitcnt vmcnt(0)" ::: "memory");
        __syncthreads();
        if (tid == 0) __hip_atomic_store((unsigned*)(ws + WS_LFLAG) + 16 * item, pass_tag, __ATOMIC_RELAXED, __HIP_MEMORY_SCOPE_AGENT);
    }
    __syncthreads();
}
constexpr int L2_SA = 0, L2_SH = 16384, L2_CIN = 32768;
__device__ __forceinline__ void lru_pass2(KP p, LAS unsigned char* lds, int l, int item, unsigned pass_tag, bool dry = false) {
    const int tid = otid(), dg = tid & 15, seg = tid >> 4;
    const int e8 = item & 7, head = (item >> 3) & 7, bl = item >> 6;
    unsigned char* ws = ows(p->ws);
    bf16_t* zgb = (bf16_t*)(ws + WS_Z + 4 * ZSLOT); bf16_t* zgo = dry ? (bf16_t*)(ws + WS_H) : zgb; const unsigned* lau = (const unsigned*)(ws + WS_LAU); float* agg = (float*)(ws + WS_AGG);
    const int rowbase = bl * SEQ + e8 * 512;
    LAS float* SA = (LAS float*)(lds + L2_SA); LAS float* SH = (LAS float*)(lds + L2_SH); LAS float* CIN = (LAS float*)(lds + L2_CIN);
    if (tid < 64) {
        if (tid < e8) { unsigned sp = 0; while (__hip_atomic_load((unsigned*)(ws + WS_LFLAG) + 16 * (item - e8 + tid), __ATOMIC_RELAXED, __HIP_MEMORY_SCOPE_AGENT) != pass_tag) { __builtin_amdgcn_s_sleep(1); if (++sp > (1u << 22)) break; } }
        __builtin_amdgcn_fence(__ATOMIC_ACQUIRE, "agent");
        asm volatile("s_waitcnt vmcnt(0)" ::: "memory"); }
    __syncthreads();
    float carry = 0.f;
    if (tid < 128) { for (int e = 0; e < e8; ++e) { const float a2 = __hip_atomic_load(agg + ((size_t)(item - e8 + e) * 128 + tid) * 2, __ATOMIC_RELAXED, __HIP_MEMORY_SCOPE_AGENT), h2 = __hip_atomic_load(agg + ((size_t)(item - e8 + e) * 128 + tid) * 2 + 1, __ATOMIC_RELAXED, __HIP_MEMORY_SCOPE_AGENT); carry = a2 * carry + h2; } }
    u32x4 pk[4][2], pkn[4][2], gv[4], gn[4];
    { const size_t o = (size_t)(rowbase + seg * 4) * D + head * 128 + dg * 8;
#pragma unroll
      for (int t = 0; t < 4; ++t) { pkn[t][0] = *(const u32x4*)(lau + o + (size_t)t * D); pkn[t][1] = *(const u32x4*)(lau + o + (size_t)t * D + 4); gn[t] = *(const u32x4*)(zgb + o + (size_t)t * D); } }
    for (int tile = 0; tile < 4; ++tile) {
        const size_t o = (size_t)(rowbase + tile * 128 + seg * 4) * D + head * 128 + dg * 8;
#pragma unroll
        for (int t = 0; t < 4; ++t) { pk[t][0] = pkn[t][0]; pk[t][1] = pkn[t][1]; gv[t] = gn[t]; }
        if (tile + 1 < 4) {
#pragma unroll
            for (int t = 0; t < 4; ++t) { pkn[t][0] = *(const u32x4*)(lau + o + (size_t)(128 + t) * D); pkn[t][1] = *(const u32x4*)(lau + o + (size_t)(128 + t) * D + 4); gn[t] = *(const u32x4*)(zgb + o + (size_t)(128 + t) * D); } }
        float A[8], H[8];
#pragma unroll
        for (int e = 0; e < 8; ++e) { A[e] = 1.f; H[e] = 0.f; }
#pragma unroll
        for (int t = 0; t < 4; ++t)
#pragma unroll
            for (int e = 0; e < 8; ++e) { const unsigned w = pk[t][e >> 2][e & 3]; const float a = 1.0f - bflo(w); H[e] = a * H[e] + bfhi(w); A[e] *= a; }
        *(LAS f32x4*)(SA + seg * 128 + dg * 8) = (f32x4){A[0], A[1], A[2], A[3]}; *(LAS f32x4*)(SA + seg * 128 + dg * 8 + 4) = (f32x4){A[4], A[5], A[6], A[7]};
        *(LAS f32x4*)(SH + seg * 128 + dg * 8) = (f32x4){H[0], H[1], H[2], H[3]}; *(LAS f32x4*)(SH + seg * 128 + dg * 8 + 4) = (f32x4){H[4], H[5], H[6], H[7]};
        __syncthreads();
        if (tid < 128) {
#pragma unroll 8
            for (int s2 = 0; s2 < 32; ++s2) { CIN[s2 * 128 + tid] = carry; carry = SA[s2 * 128 + tid] * carry + SH[s2 * 128 + tid]; } }
        __syncthreads();
        const f32x4 c0 = *(const LAS f32x4*)(CIN + seg * 128 + dg * 8), c1 = *(const LAS f32x4*)(CIN + seg * 128 + dg * 8 + 4);
        float h[8] = {c0[0], c0[1], c0[2], c0[3], c1[0], c1[1], c1[2], c1[3]};
#pragma unroll
        for (int t = 0; t < 4; ++t) { float y[8]; const u32x4 g = gv[t]; const float g8[8] = {bflo(g.x), bfhi(g.x), bflo(g.y), bfhi(g.y), bflo(g.z), bfhi(g.z), bflo(g.w), bfhi(g.w)};
#pragma unroll
            for (int e = 0; e < 8; ++e) { const unsigned w = pk[t][e >> 2][e & 3]; h[e] = (1.0f - bflo(w)) * h[e] + bfhi(w); y[e] = h[e] * silu(g8[e]); }
            u32x4 w4; w4.x = cvt_pk_bf16(y[0], y[1]); w4.y = cvt_pk_bf16(y[2], y[3]); w4.z = cvt_pk_bf16(y[4], y[5]); w4.w = cvt_pk_bf16(y[6], y[7]);
            *(u32x4*)(zgo + o + (size_t)t * D) = w4; }
    }
    __syncthreads();
}
__device__ __forceinline__ void ln_stats(KP p) {
    const int tid = otid(), lane = tid & 63, wave = tid >> 6;
    unsigned char* ws = ows(p->ws);
    const bf16_t* zv = (const bf16_t*)(ws + WS_Z + 1 * ZSLOT); float* st = (float*)(ws + WS_STATS);
    const int bid = obid();
    for (int k = 0; k < 8; ++k) { const int row = bid * 64 + wave * 8 + k; if (row >= TC) break;
        const u32x4* r = (const u32x4*)(zv + (size_t)row * D) + lane; const u32x4 a = r[0], b = r[64];
        float x[16] = {bflo(a.x), bfhi(a.x), bflo(a.y), bfhi(a.y), bflo(a.z), bfhi(a.z), bflo(a.w), bfhi(a.w), bflo(b.x), bfhi(b.x), bflo(b.y), bfhi(b.y), bflo(b.z), bfhi(b.z), bflo(b.w), bfhi(b.w)};
        float s = 0.f;
#pragma unroll
        for (int i = 0; i < 16; ++i) s += x[i];
        const float mean = wave_sum(s) * (1.0f / D); float q = 0.f;
#pragma unroll
        for (int i = 0; i < 16; ++i) { const float d = x[i] - mean; q += d * d; }
        const float rstd = __builtin_amdgcn_rsqf(wave_sum(q) * (1.0f / D) + EPS);
        if (lane == 0) { st[row * 2] = mean; st[row * 2 + 1] = rstd; } }
}

constexpr int GM_LN = 36864;
constexpr int GM_SV = 40960;
__device__ __forceinline__ void gmlp_items(KP p, LAS unsigned char* lds, int l, int c, int G, bool dry = false) {
    const int tid = otid(), lane = tid & 63, wave = tid >> 6, l31 = lane & 31, hh = lane >> 5;
    unsigned char* ws = ows(p->ws);
    const int nitems = (TC / 128) * 8;
    if (c >= nitems) return;
    const int g = c & 7;
    bf16_t* zu = (bf16_t*)(ws + WS_Z); bf16_t* zuo = dry ? (bf16_t*)(ws + WS_H) : zu; const bf16_t* zv = (const bf16_t*)(ws + WS_Z + 1 * ZSLOT); const bf16_t* zga = (const bf16_t*)(ws + WS_Z + 2 * ZSLOT);
    const float* lnp = (const float*)(ws + WS_LNP);
    LAS float* LN = (LAS float*)(lds + GM_LN); LAS float* SV = (LAS float*)(lds + GM_SV);
    if (tid < 256) LN[tid] = (tid < 128) ? asglobal(p->in[I_LNG])[l * D + g * 128 + tid] : asglobal(p->in[I_LNB])[l * D + g * 128 + tid - 128];
    const int cb = wave & 3, ib0 = (wave >> 2) * 2;
    bf16x8 wf[2][8];
    { const bf16_t* wg = (const bf16_t*)(ws + WS_WG) + (size_t)(l * 8 + g) * 128 * 128;
#pragma unroll
      for (int q = 0; q < 2; ++q)
#pragma unroll
        for (int s = 0; s < 8; ++s) wf[q][s] = *(const bf16x8*)(wg + (size_t)((ib0 + q) * 32 + l31) * 128 + 16 * s + 8 * hh); }
    const int c8 = tid & 15, jt = tid >> 4;
    const float* bsp = asglobal(p->in[I_BS]) + (size_t)(l * 8 + g) * 128;
    u32x4 vq[4]; f32x2 pq[4];
    { const int row0 = (c >> 3) * 128;
#pragma unroll
      for (int k = 0; k < 4; ++k) { vq[k] = *(const u32x4*)(zv + (size_t)(row0 + jt + 32 * k) * D + g * 128 + c8 * 8); pq[k] = *(const f32x2*)(lnp + (size_t)(row0 + jt + 32 * k) * 32 + 2 * c8); } }
    __syncthreads();
    for (int item = c; item < nitems; item += G) {
        const int row0 = (item >> 3) * 128;
#pragma unroll
        for (int k = 0; k < 4; ++k) { const int j = jt + 32 * k; float ssum = pq[k].x, qsum = pq[k].y;
#pragma unroll
            for (int o = 1; o < 16; o <<= 1) { ssum += __shfl_xor(ssum, o); qsum += __shfl_xor(qsum, o); }
            const float mean = ssum * (1.0f / D), rstd = __builtin_amdgcn_rsqf(fmaxf(qsum * (1.0f / D) - mean * mean, 0.f) + EPS);
            const u32x4 v = vq[k];
            const float x[8] = {bflo(v.x), bfhi(v.x), bflo(v.y), bfhi(v.y), bflo(v.z), bfhi(v.z), bflo(v.w), bfhi(v.w)};
            const int colb = ((((j >> 3) ^ c8) & 15) * 8 + (j & 7)) * 2;
#pragma unroll
            for (int e = 0; e < 8; ++e) { const float y = (x[e] - mean) * rstd * LN[c8 * 8 + e] + LN[128 + c8 * 8 + e]; *(LAS bf16_t*)(lds + (c8 * 8 + e) * 272 + colb) = f2bf(y); } }
        __syncthreads();
        if (item + G < nitems) { const int rown = ((item + G) >> 3) * 128;
#pragma unroll
            for (int k = 0; k < 4; ++k) { vq[k] = *(const u32x4*)(zv + (size_t)(rown + jt + 32 * k) * D + g * 128 + c8 * 8); pq[k] = *(const f32x2*)(lnp + (size_t)(rown + jt + 32 * k) * 32 + 2 * c8); } }
        u32x4 uq[4]; float bq[4];
#pragma unroll
        for (int k = 0; k < 4; ++k) { const size_t off = (size_t)(row0 + jt + 32 * k) * D + g * 128 + c8 * 8; uq[k] = *(const u32x4*)(zu + off); bq[k] = bsp[jt + 32 * k]; }
        f32x16 acc[2];
#pragma unroll
        for (int q = 0; q < 2; ++q)
#pragma unroll
            for (int i = 0; i < 16; ++i) acc[q][i] = 0.f;
#pragma unroll
        for (int s = 0; s < 8; ++s) { const int ch = cb * 32 + l31; const bf16x8 a = *(const LAS bf16x8*)(lds + ch * 272 + ((((2 * s + hh) ^ (ch >> 3)) & 15) * 16));
#pragma unroll
            for (int q = 0; q < 2; ++q) acc[q] = __builtin_amdgcn_mfma_f32_32x32x16_bf16(a, wf[q][s], acc[q], 0, 0, 0); }
#pragma unroll
        for (int q = 0; q < 2; ++q)
#pragma unroll
            for (int rg = 0; rg < 4; ++rg) *(LAS f32x4*)(SV + ((ib0 + q) * 32 + l31) * 132 + cb * 32 + 8 * rg + 4 * hh) = (f32x4){acc[q][4 * rg], acc[q][4 * rg + 1], acc[q][4 * rg + 2], acc[q][4 * rg + 3]};
        __syncthreads();
#pragma unroll
        for (int k = 0; k < 4; ++k) { const int i = jt + 32 * k; const size_t off = (size_t)(row0 + i) * D + g * 128 + c8 * 8;
            const f32x4 s0 = *(const LAS f32x4*)(SV + i * 132 + c8 * 8), s1 = *(const LAS f32x4*)(SV + i * 132 + c8 * 8 + 4);
            const float sv[8] = {s0[0], s0[1], s0[2], s0[3], s1[0], s1[1], s1[2], s1[3]};
            const u32x4 uu = uq[k];
            const float u8[8] = {bflo(uu.x), bfhi(uu.x), bflo(uu.y), bfhi(uu.y), bflo(uu.z), bfhi(uu.z), bflo(uu.w), bfhi(uu.w)};
            float y[8];
#pragma unroll
            for (int e = 0; e < 8; ++e) y[e] = u8[e] * (sv[e] + bq[k]);
            u32x4 w; w.x = cvt_pk_bf16(y[0], y[1]); w.y = cvt_pk_bf16(y[2], y[3]); w.z = cvt_pk_bf16(y[4], y[5]); w.w = cvt_pk_bf16(y[6], y[7]);
            *(u32x4*)(zuo + off) = w; }
    }
    __syncthreads();
}

constexpr int AT_STRIDE = 528;
__device__ __forceinline__ void attn_item(KP p, LAS unsigned char* lds, int l, int chunk, int item, bool dry = false) {
    const int tid = otid(), lane = tid & 63, wave = tid >> 6, l31 = lane & 31, hh = lane >> 5;
    const int tile = item & 15, hd = (item >> 4) & 3, bl = item >> 6, bg = chunk * BPC + bl;
    unsigned char* ws = ows(p->ws);
    const bf16_t* zq = (const bf16_t*)(ws + WS_Z + 5 * ZSLOT); bf16_t* zgc = (bf16_t*)(ws + WS_Z + 6 * ZSLOT); bf16_t* zgco = dry ? (bf16_t*)(ws + WS_H) : zgc;
    const bf16_t* KM = (const bf16_t*)(ws + WS_KM) + (size_t)l * MROWS * D + (size_t)bg * MEML * D + hd * 256;
    const bf16_t* VT = (const bf16_t*)(ws + WS_VT) + (size_t)l * D * MROWS + (size_t)hd * 256 * MROWS + bg * MEML;
    const int trow = bl * SEQ + tile * 256 + wave * 32 + l31;
    const bf16_t* qp = zq + (size_t)trow * D + hd * 256 + 8 * hh;
    const unsigned koff = (unsigned)((tid >> 5) * D + (tid & 31) * 8) * 2u, voff = (unsigned)((tid >> 5) * MROWS + (tid & 31) * 8) * 2u;
    const unsigned loff = (unsigned)((tid >> 5) * AT_STRIDE + (tid & 31) * 16);
#pragma unroll
    for (int k = 0; k < 16; ++k) *(LAS u32x4*)(lds + loff + k * 16 * AT_STRIDE) = *(const u32x4*)((const char*)KM + (size_t)k * 16 * D * 2 + koff);
    __syncthreads();
    const float k2 = 0.0625f * 1.44269504089f;
    bf16x8 pf[8][2];
    u32x4 vpre[8];
    float mA = 0.f, sumA = 0.f, alphaA = 1.f, sum = 0.f;
#pragma unroll
    for (int half = 0; half < 2; ++half) {
        f32x16 sc[4];
#pragma unroll
        for (int mb = 0; mb < 4; ++mb)
#pragma unroll
            for (int i = 0; i < 16; ++i) sc[mb][i] = 0.f;
        bf16x8 qc[4], qn[4];
#pragma unroll
        for (int s4 = 0; s4 < 4; ++s4) qc[s4] = *(const bf16x8*)(qp + 16 * s4);
#pragma unroll 1
        for (int sg = 0; sg < 4; ++sg) {
            if (sg < 3) {
#pragma unroll
                for (int s4 = 0; s4 < 4; ++s4) qn[s4] = *(const bf16x8*)(qp + 64 * (sg + 1) + 16 * s4); }
#pragma unroll
            for (int s4 = 0; s4 < 4; ++s4)
#pragma unroll
                for (int mb = 0; mb < 4; ++mb) { const bf16x8 a = *(const LAS bf16x8*)(lds + (half * 128 + mb * 32 + l31) * AT_STRIDE + (64 * sg + 16 * s4 + 8 * hh) * 2);
                    sc[mb] = __builtin_amdgcn_mfma_f32_32x32x16_bf16(a, qc[s4], sc[mb], 0, 0, 0); }
#pragma unroll
            for (int s4 = 0; s4 < 4; ++s4) qc[s4] = qn[s4];
        }
        if (half == 1) {
            __builtin_amdgcn_sched_barrier(0);
#pragma unroll
            for (int k = 0; k < 8; ++k) vpre[k] = *(const u32x4*)((const char*)VT + (size_t)k * 16 * MROWS * 2 + voff); }
        float mh = -3.0e38f;
#pragma unroll
        for (int mb = 0; mb < 4; ++mb)
#pragma unroll
            for (int i = 0; i < 16; ++i) mh = fmaxf(mh, sc[mb][i]);
        mh = fmaxf(mh, __shfl_xor(mh, 32));
        float mref;
        if (half == 0) { mA = mh; mref = mh; } else { mref = fmaxf(mA, mh); alphaA = __builtin_amdgcn_exp2f((mA - mref) * k2); }
        float sh = 0.f;
#pragma unroll
        for (int mb = 0; mb < 4; ++mb) {
#pragma unroll
            for (int i = 0; i < 16; ++i) { const float e = __builtin_amdgcn_exp2f((sc[mb][i] - mref) * k2); sc[mb][i] = e; sh += e; }
#pragma unroll
            for (int s2 = 0; s2 < 2; ++s2) { u32x4 w;
                w.x = cvt_pk_bf16(sc[mb][8 * s2 + 0], sc[mb][8 * s2 + 1]); w.y = cvt_pk_bf16(sc[mb][8 * s2 + 2], sc[mb][8 * s2 + 3]);
                w.z = cvt_pk_bf16(sc[mb][8 * s2 + 4], sc[mb][8 * s2 + 5]); w.w = cvt_pk_bf16(sc[mb][8 * s2 + 6], sc[mb][8 * s2 + 7]);
                pf[half * 4 + mb][s2] = __builtin_bit_cast(bf16x8, w); } }
        sh += __shfl_xor(sh, 32);
        if (half == 0) sumA = sh; else sum = sumA * alphaA + sh;
    }
    const float inv = frcp(sum);
    __syncthreads();
#pragma unroll
    for (int k = 0; k < 8; ++k) *(LAS u32x4*)(lds + loff + k * 16 * AT_STRIDE) = vpre[k];
#pragma unroll
    for (int k = 8; k < 16; ++k) *(LAS u32x4*)(lds + loff + k * 16 * AT_STRIDE) = *(const u32x4*)((const char*)VT + (size_t)k * 16 * MROWS * 2 + voff);
    u32x4 gcr[4][2];
    { const size_t off0 = (size_t)trow * D + hd * 256 + 8 * hh;
#pragma unroll
      for (int b4 = 0; b4 < 4; ++b4)
#pragma unroll
        for (int k = 0; k < 2; ++k) gcr[b4][k] = *(const u32x4*)(zgc + off0 + b4 * 32 + 16 * k); }
    __syncthreads();
#pragma unroll
    for (int db = 0; db < 8; ++db) { f32x16 o; u32x4 gc[2];
#pragma unroll
        for (int k = 0; k < 2; ++k) gc[k] = gcr[db & 3][k];
        if (db < 4) { const size_t off1 = (size_t)trow * D + hd * 256 + (db + 4) * 32 + 8 * hh;
#pragma unroll
            for (int k = 0; k < 2; ++k) gcr[db & 3][k] = *(const u32x4*)(zgc + off1 + 16 * k); }
#pragma unroll
        for (int i = 0; i < 16; ++i) o[i] = 0.f;
#pragma unroll
        for (int mb = 0; mb < 8; ++mb) {
            if (mb == 4) {
#pragma unroll
                for (int i = 0; i < 16; ++i) o[i] *= alphaA; }
#pragma unroll
            for (int s2 = 0; s2 < 2; ++s2) { const LAS unsigned char* vp = lds + (db * 32 + l31) * AT_STRIDE + (mb * 32 + 16 * s2 + 4 * hh) * 2;
                const s16x4 lo = *(const LAS s16x4*)vp, hi = *(const LAS s16x4*)(vp + 16);
                const bf16x8 a = __builtin_shufflevector(lo, hi, 0, 1, 2, 3, 4, 5, 6, 7);
                o = __builtin_amdgcn_mfma_f32_32x32x16_bf16(a, pf[mb][s2], o, 0, 0, 0); } }
#pragma unroll
        for (int k = 0; k < 2; ++k) { float v8[8];
#pragma unroll
            for (int j = 0; j < 4; ++j) { typedef unsigned u2v __attribute__((ext_vector_type(2)));
                const u2v sw = __builtin_amdgcn_permlane32_swap(__float_as_uint(o[8 * k + j]), __float_as_uint(o[8 * k + 4 + j]), false, false);
                v8[j] = __uint_as_float(sw[0]); v8[4 + j] = __uint_as_float(sw[1]); }
            const u32x4 g = gc[k]; const float g8[8] = {bflo(g.x), bfhi(g.x), bflo(g.y), bfhi(g.y), bflo(g.z), bfhi(g.z), bflo(g.w), bfhi(g.w)};
            float y[8];
#pragma unroll
            for (int e = 0; e < 8; ++e) y[e] = v8[e] * inv * silu(g8[e]);
            u32x4 w; w.x = cvt_pk_bf16(y[0], y[1]); w.y = cvt_pk_bf16(y[2], y[3]); w.z = cvt_pk_bf16(y[4], y[5]); w.w = cvt_pk_bf16(y[6], y[7]);
            *(u32x4*)(zgco + (size_t)trow * D + hd * 256 + db * 32 + 16 * k + 8 * hh) = w; } }
    __syncthreads();
}

__device__ __forceinline__ void row_phase(KP p, int l, int chunk, bool dry = false) {
    const int tid = otid(), lane = tid & 63, wave = tid >> 6;
    const int gw = obid() * 8 + wave, NGW = ogrid() * 8;
    unsigned char* ws = ows(p->ws);
    const float* outf = (const float*)(ws + WS_Z);
    const float* xsrc = (l == 0) ? asglobal(p->in[I_X]) : asglobal(p->out);
    const float* gpost = asglobal(p->in[I_POSTG]) + l * D; const float* gpre = asglobal(p->in[I_PREG]) + (l + 1 < DEPTH ? l + 1 : 0) * D;
    bf16_t* H = dry ? (bf16_t*)(ws + WS_Z + 4 * ZSLOT) : (bf16_t*)(ws + WS_H);
    float* xout = dry ? (float*)(ws + WS_Z + 2 * ZSLOT) - (size_t)chunk * TC * D : asglobal(p->out);
    for (int r = gw; r < TC; r += NGW) {
        const size_t grow = (size_t)chunk * TC + r;
        const f32x4* orow = (const f32x4*)(outf + (size_t)r * D) + lane; const f32x4* xr = (const f32x4*)(xsrc + grow * D) + lane;
        f32x4 o[4], x[4]; float s = 0.f;
#pragma unroll
        for (int j = 0; j < 4; ++j) { o[j] = orow[64 * j]; x[j] = xr[64 * j]; s += (o[j].x * o[j].x + o[j].y * o[j].y) + (o[j].z * o[j].z + o[j].w * o[j].w); }
        const float r1 = __builtin_amdgcn_rsqf(wave_sum(s) * (1.0f / D) + EPS); float s2 = 0.f;
        f32x4* xo = (f32x4*)(xout + grow * D) + lane;
#pragma unroll
        for (int j = 0; j < 4; ++j) { const f32x4 gv = ((const f32x4*)gpost)[lane + 64 * j]; x[j] = x[j] + o[j] * r1 * gv; xo[64 * j] = x[j];
            s2 += (x[j].x * x[j].x + x[j].y * x[j].y) + (x[j].z * x[j].z + x[j].w * x[j].w); }
        if (l + 1 < DEPTH) {
            const float r2 = __builtin_amdgcn_rsqf(wave_sum(s2) * (1.0f / D) + EPS); u32x2* h8 = (u32x2*)(H + (size_t)r * D) + lane;
#pragma unroll
            for (int j = 0; j < 4; ++j) { const f32x4 gv = ((const f32x4*)gpre)[lane + 64 * j]; u32x2 w; w.x = cvt_pk_bf16(x[j].x * r2 * gv.x, x[j].y * r2 * gv.y); w.y = cvt_pk_bf16(x[j].z * r2 * gv.z, x[j].w * r2 * gv.w); h8[64 * j] = w; }
        } else if (chunk + 1 < NCH) {
            rms_row_to_bf16(asglobal(p->in[I_X]) + ((size_t)(chunk + 1) * TC + r) * D, asglobal(p->in[I_PREG]), H + (size_t)r * D, lane);
        }
    }
}

#define XB_TMO      128
#define XB_XCNT(j)  (256  + 64 * (j))
#define XB_XSUB(j)  (1280 + 64 * (j))
#define XB_XGEN(j)  (2304 + 64 * (j))
#define XB_TOP      3328
#define XB_TOPGEN   3392
#define XCD_BAR_WORDS 3456
#define XB_SPIN_CAP (1u << 22)
__device__ __forceinline__ unsigned xb_ld(unsigned* p)              { return __hip_atomic_load(p, __ATOMIC_RELAXED, __HIP_MEMORY_SCOPE_AGENT); }
__device__ __forceinline__ unsigned xb_add(unsigned* p, unsigned v) { return __hip_atomic_fetch_add(p, v, __ATOMIC_RELAXED, __HIP_MEMORY_SCOPE_AGENT); }
__device__ __forceinline__ unsigned xb_xcc_id() { return (unsigned)__builtin_amdgcn_s_getreg((3 << 11) | 20) & 0xFu; }
#define XB_SPIN(cond, bar) do { unsigned _sp = 0; while (cond) { __builtin_amdgcn_s_sleep(1); \
    if ((++_sp & 255u) == 0u) { if (xb_ld(&(bar)[XB_TMO])) break; if (_sp > XB_SPIN_CAP) { atomicAdd(&(bar)[XB_TMO], 1u); break; } } } } while (0)
struct XcdBarrier { unsigned* bar; unsigned x; volatile LAS unsigned* st; };
__device__ __forceinline__ XcdBarrier xcd_barrier_post(unsigned* bar, volatile LAS unsigned* st) {
    XcdBarrier b; b.bar = bar; b.x = xb_xcc_id(); b.st = st;
    if (threadIdx.x == 0) (void)xb_add(&bar[XB_XCNT(b.x)], 1u);
    return b;
}
__device__ __forceinline__ void xcd_barrier_complete(unsigned* bar, unsigned x, unsigned& nloc, unsigned& nx) {
    const unsigned G = gridDim.x * gridDim.y * gridDim.z;
    unsigned sum, cnt, mine, sp = 0u;
    for (;;) {
        sum = 0u; cnt = 0u; mine = 0u;
#pragma unroll
        for (unsigned j = 0; j < 16; ++j) { const unsigned c = xb_ld(&bar[XB_XCNT(j)]); sum += c; cnt += (c > 0u) ? 1u : 0u; mine = (j == x) ? c : mine; }
        if (sum == G) break;
        __builtin_amdgcn_s_sleep(1);
        if ((++sp & 255u) == 0u) { if (xb_ld(&bar[XB_TMO])) break; if (sp > XB_SPIN_CAP) { atomicAdd(&bar[XB_TMO], 1u); break; } }
    }
    nloc = mine > 0u ? mine : 1u; nx = cnt > 0u ? cnt : 1u;
}
__device__ __forceinline__ void xcd_barrier(const XcdBarrier& b) {
    asm volatile("s_waitcnt vmcnt(0)" ::: "memory");
    __syncthreads();
    if (threadIdx.x == 0) {
        unsigned* bar = (unsigned*)ows((unsigned char*)b.bar);
        __builtin_amdgcn_s_waitcnt(0);
        unsigned nloc = b.st[0], nx = b.st[1];
        if (nloc == 0u) { xcd_barrier_complete(bar, b.x, nloc, nx); b.st[0] = nloc; b.st[1] = nx; }
        const unsigned old = xb_add(&bar[XB_XSUB(b.x)], 1u);
        const unsigned gen = old / nloc;
        if (old + 1u == (gen + 1u) * nloc) {
            __builtin_amdgcn_fence(__ATOMIC_RELEASE, "agent");
            asm volatile("s_waitcnt vmcnt(0)" ::: "memory");
            const unsigned og = xb_add(&bar[XB_TOP], 1u);
            const unsigned tg = og / nx;
            if (og + 1u == (tg + 1u) * nx) xb_add(&bar[XB_TOPGEN], 1u);
            else XB_SPIN(xb_ld(&bar[XB_TOPGEN]) == tg, bar);
            __builtin_amdgcn_fence(__ATOMIC_ACQUIRE, "agent");
            xb_add(&bar[XB_XGEN(b.x)], 1u);
            asm volatile("s_waitcnt vmcnt(0)" ::: "memory");
        } else {
            XB_SPIN(xb_ld(&bar[XB_XGEN(b.x)]) == gen, bar);
            __builtin_amdgcn_fence(__ATOMIC_ACQUIRE, "agent");
            asm volatile("s_waitcnt vmcnt(0)" ::: "memory");
        }
    }
    __syncthreads();
}

constexpr int N_PHASES = 2 + NCH * DEPTH * 4;
__global__ void __launch_bounds__(NTHR, 2) mk_fwd(Params pk) {
    extern __shared__ __attribute__((aligned(16))) unsigned char lds_raw[];
    LAS unsigned char* lds = (LAS unsigned char*)lds_raw;
    unsigned char* ws = pk.ws;
    int G = gridDim.x, c = blockIdx.x;
    volatile LAS unsigned* bst = (volatile LAS unsigned*)(lds + LDS_BYTES - 64);
    if (threadIdx.x < 2) bst[threadIdx.x] = 0u;
    __syncthreads();
    XcdBarrier bar; bar.bar = (unsigned*)(ws + WS_BAR); bar.x = 0; bar.st = bst;
    if (pk.ph_hi - pk.ph_lo > 1) bar = xcd_barrier_post((unsigned*)(ws + WS_BAR), bst);
    const int ph_hi = pk.ph_hi;
    for (int ph = pk.ph_lo; ph < ph_hi; ++ph) {
        KP p = (KP)__builtin_amdgcn_kernarg_segment_ptr(); asm volatile("" : "+s"(p));
        ws = ows(ws); asm volatile("" : "+s"(G), "+s"(c));
        if (ph == 0) { if constexpr ((PH_MASK & 1) != 0) phase_prologue(p, lds); }
        else if (ph == 1) { if constexpr ((PH_MASK & 2) != 0) {
            pg8::SchedKV S{(const char*)(ws + WS_MEMN), (const char*)(ws + WS_WKV), G, c};
            pg8::EpiKV E{(bf16_t*)(ws + WS_KM), (bf16_t*)(ws + WS_VT)};
            pg8::gemm_phase<pg8::EpiKV, pg8::SchedKV, true>(lds, D, S, E); }
        } else {
            const int s = (ph - 2) / 4, k = (ph - 2) % 4, chunk = s / DEPTH, l = s % DEPTH;
            for (int rep = 0; rep < (((DBL >> k) & 1) ? 2 : 1); ++rep) {
            if (rep) xcd_barrier(bar);
            if (k == 0) { if constexpr ((PH_MASK & 4) != 0) {
                pg8::SchedGrid S{(const char*)(ws + WS_H), (const char*)(ws + WS_WIN) + (size_t)l * INW * D * 2, TC / 256, INW / 256, (TC / 256) * (INW / 256), G, c, (size_t)256 * D * 2};
                pg8::EpiBf16 E{(bf16_t*)(ws + WS_Z), D, (size_t)TC * D, 1, (const float*)(ws + WS_SS2), (float*)(ws + WS_LNP)};
                pg8::gemm_phase<pg8::EpiBf16, pg8::SchedGrid, true>(lds, D, S, E); }
            } else if (k == 1) {
                if constexpr ((DRYM & 1) != 0) for (int it = c; it < 256; it += G) lru_item<1>(p, lds, l, it, (unsigned)(s + 1));
                if constexpr ((PH_MASK & 8) != 0) for (int it = c; it < 256; it += G) lru_item<1>(p, lds, l, it, (unsigned)(s + 1));
                if constexpr ((DRYM & 2) != 0) gmlp_items(p, lds, l, c, G, true);
                if constexpr ((PH_MASK & 32) != 0) gmlp_items(p, lds, l, c, G);
                if constexpr ((DRYM & 4) != 0) for (int it = c; it < 256; it += G) attn_item(p, lds, l, chunk, it, true);
                if constexpr ((PH_MASK & 64) != 0) for (int it = c; it < 256; it += G) attn_item(p, lds, l, chunk, it);
                if constexpr ((DRYM & 8) != 0) for (int it = c; it < 256; it += G) lru_pass2(p, lds, l, it, (unsigned)(s + 1), true);
                if constexpr ((PH_MASK & 16) != 0) for (int it = c; it < 256; it += G) lru_pass2(p, lds, l, it, (unsigned)(s + 1));
            } else if (k == 2) { if constexpr ((PH_MASK & 128) != 0) {
                pg8::SchedMerge S{(const char*)(ws + WS_Z), (const char*)(ws + WS_WP) + (size_t)l * 3 * D * D * 2, G, c};
                pg8::EpiMerge E{(const bf16_t*)(ws + WS_Z + 7 * ZSLOT), (bf16_t*)(ws + WS_Z + 5 * ZSLOT)};
                pg8::gemm_phase<pg8::EpiMerge, pg8::SchedMerge, true>(lds, D, S, E); }
            } else { if constexpr ((PH_MASK & 256) != 0) {
                const bool lastl = (l + 1 == DEPTH);
                pg8::SchedGrid S{(const char*)(ws + WS_Z + 5 * ZSLOT), (const char*)(ws + WS_WOUT) + (size_t)l * D * D * 2, TC / 256, 4, (TC / 256) * 4, G, c, (size_t)256 * D * 2};
                pg8::EpiOutNorm E{(l == 0 ? asglobal(p->in[I_X]) : asglobal(p->out)) + (size_t)chunk * TC * D, asglobal(p->out) + (size_t)chunk * TC * D, lastl ? (bf16_t*)nullptr : (bf16_t*)(ws + WS_H),
                                  asglobal(p->in[I_POSTG]) + l * D, asglobal(p->in[I_PREG]) + (lastl ? 0 : l + 1) * D, (float*)(ws + WS_SS1), (float*)(ws + WS_SS2),
                                  (unsigned*)(ws + WS_PCNT), 4u * (unsigned)(s + 1)};
                pg8::gemm_phase<pg8::EpiOutNorm, pg8::SchedGrid, true>(lds, D, S, E);
                if (lastl && chunk + 1 < NCH) {
                    const int wave = otid() >> 6, lane = otid() & 63;
                    for (int m = c * 8 + wave; m < TC; m += G * 8) row_to_aprime(asglobal(p->in[I_X]) + ((size_t)(chunk + 1) * TC + m) * D, asglobal(p->in[I_PREG]), (bf16_t*)(ws + WS_H) + (size_t)m * D, (float*)(ws + WS_SS2) + (size_t)m * 4, lane);
                } } }
            }
        }
        if (ph + 1 < ph_hi) { if (ph_hi == -12345) cg::this_grid().sync();
                              xcd_barrier(bar); }
    }
}

extern "C" void kernel_launch(void* const* d_in, const int* in_sizes, int n_in, void* d_out, int out_size, void* d_ws, size_t ws_size, hipStream_t stream) {
    static int grid = 0;
    if (grid == 0) {
        if (n_in != 22 || out_size != NT * D || ws_size < WS_END) { fprintf(stderr, "kernel_launch: unexpected problem (n_in %d, out %d, ws %zu < %zu)\n", n_in, out_size, ws_size, (size_t)WS_END); grid = -1; return; }
        if (hipFuncSetAttribute((const void*)mk_fwd, hipFuncAttributeMaxDynamicSharedMemorySize, LDS_BYTES) != hipSuccess) { fprintf(stderr, "kernel_launch: hipFuncSetAttribute failed\n"); grid = -1; return; }
        int dev = 0, cus = 0, per_cu = 0;
        (void)hipGetDevice(&dev); (void)hipDeviceGetAttribute(&cus, hipDeviceAttributeMultiprocessorCount, dev);
        (void)hipOccupancyMaxActiveBlocksPerMultiprocessor(&per_cu, (const void*)mk_fwd, NTHR, LDS_BYTES);
        (void)hipGetLastError();
        grid = cus > 0 ? cus : 256;
        if (per_cu < 1) fprintf(stderr, "kernel_launch: occupancy query says %d blocks per CU\n", per_cu);
    }
    if (grid < 0) return;
    Params p{};
    for (int i = 0; i < 22; ++i) p.in[i] = (const float*)d_in[i];
    p.out = (float*)d_out; p.ws = (unsigned char*)d_ws;
#if MK_MULTI
    for (int ph = 0; ph < N_PHASES; ++ph) { p.ph_lo = ph; p.ph_hi = ph + 1; hipLaunchKernelGGL(mk_fwd, dim3(grid), dim3(NTHR), LDS_BYTES, stream, p); }
#else
    p.ph_lo = 0; p.ph_hi = N_PHASES;
    (void)hipMemsetAsync((char*)d_ws + WS_BAR, 0, WS_ZERO_END - WS_BAR, stream);
    void* args[] = {&p};
    hipError_t e = hipLaunchCooperativeKernel((const void*)mk_fwd, dim3(grid), dim3(NTHR), args, LDS_BYTES, stream);
    if (e != hipSuccess) fprintf(stderr, "cooperative launch failed: %s (grid %d)\n", hipGetErrorString(e), grid);
#endif
}
```

```cpp
#include <hip/hip_runtime.h>
#include <hip/hip_cooperative_groups.h>
#include <cstdio>
#include <cstdint>
namespace cg = cooperative_groups;

#ifndef MK_MULTI
#define MK_MULTI 0
#endif

#ifndef DBL
#define DBL 0
#endif
#ifndef DRYM
#define DRYM 0
#endif
#ifndef PH_MASK
#define PH_MASK 0x3FF
#endif
#define LAS __attribute__((address_space(3)))
typedef unsigned short bf16_t;
typedef short bf16x8 __attribute__((ext_vector_type(8)));
typedef short s16x4 __attribute__((ext_vector_type(4)));
typedef float f32x4 __attribute__((ext_vector_type(4)));
typedef float f32x2 __attribute__((ext_vector_type(2)));
typedef float f32x16 __attribute__((ext_vector_type(16)));
typedef unsigned u32x4 __attribute__((ext_vector_type(4)));
typedef unsigned u32x2 __attribute__((ext_vector_type(2)));

constexpr int D = 1024, NB = 8, SEQ = 4096, DEPTH = 4, NT = NB * SEQ;
constexpr int NCH = 2, TC = NT / NCH, BPC = NB / NCH;
constexpr int INW = 10240, MEML = 256, MROWS = NB * MEML;
constexpr float EPS = 1e-6f;
constexpr int NTHR = 512;

constexpr size_t MiB = 1u << 20;
constexpr size_t WS_STATS = 0;
constexpr size_t WS_AGG = 256 * 1024;
constexpr size_t WS_BAR = 512 * 1024;
constexpr size_t WS_SS1 = 1 * MiB;
constexpr size_t WS_SS2 = WS_SS1 + 512 * 1024;
constexpr size_t WS_PCNT = 2 * MiB;
constexpr size_t WS_LFLAG = WS_PCNT + 16384;
constexpr size_t WS_ZERO_END = WS_LFLAG + 16384;
constexpr size_t WS_WIN = 3 * MiB;
constexpr size_t WS_WP = 83 * MiB;
constexpr size_t WS_WOUT = 107 * MiB;
constexpr size_t WS_WLRU = 115 * MiB;
constexpr size_t WS_WG = 117 * MiB;
constexpr size_t WS_KM = 118 * MiB;
constexpr size_t WS_VT = 134 * MiB;
constexpr size_t WS_H = 150 * MiB;
constexpr size_t WS_Z = 182 * MiB;
constexpr size_t ZSLOT = (size_t)TC * D * 2;
constexpr size_t WS_WKV = WS_Z;
constexpr size_t WS_MEMN = WS_Z + 16 * MiB;
constexpr size_t WS_LAU = WS_Z + 10 * ZSLOT;
constexpr size_t WS_LNP = WS_LAU + 2 * ZSLOT;
constexpr size_t WS_END = WS_LNP + (size_t)TC * 128;

constexpr int LDS_BYTES = 147456;

typedef __bf16 bf16x2_t __attribute__((ext_vector_type(2)));
__device__ __forceinline__ unsigned cvt_pk_bf16(float lo, float hi) { const f32x2 v = {lo, hi}; return __builtin_bit_cast(unsigned, __builtin_convertvector(v, bf16x2_t)); }
__device__ __forceinline__ float bflo(unsigned w) { return __uint_as_float(w << 16); }
__device__ __forceinline__ float bfhi(unsigned w) { return __uint_as_float(w & 0xffff0000u); }
__device__ __forceinline__ float bf1(bf16_t b) { return __uint_as_float(((unsigned)b) << 16); }
__device__ __forceinline__ bf16_t f2bf(float f) { return (bf16_t)(cvt_pk_bf16(f, 0.f) & 0xffffu); }
__device__ __forceinline__ float wave_sum(float v) {
#pragma unroll
    for (int o = 1; o < 64; o <<= 1) v += __shfl_xor(v, o);
    return v;
}
__device__ __forceinline__ int otid() { int t = threadIdx.x; asm volatile("" : "+v"(t)); return t; }
#define GAS __attribute__((address_space(1)))
template <class T> __device__ __forceinline__ T* asglobal(T* p) { return (T*)(GAS T*)p; }
__device__ __forceinline__ unsigned char* ows(unsigned char* w) { GAS unsigned char* g = (GAS unsigned char*)w; asm volatile("" : "+s"(g)); return (unsigned char*)g; }
__device__ __forceinline__ int obid() { int t = blockIdx.x; asm volatile("" : "+s"(t)); return t; }
__device__ __forceinline__ int ogrid() { int t = gridDim.x; asm volatile("" : "+s"(t)); return t; }
__device__ __forceinline__ float frcp(float x) { return __builtin_amdgcn_rcpf(x); }
__device__ __forceinline__ float fexp(float x) { return __builtin_amdgcn_exp2f(x * 1.44269504089f); }
__device__ __forceinline__ float sigm(float x) { return frcp(1.0f + fexp(-x)); }
__device__ __forceinline__ float silu(float x) { return x * frcp(1.0f + fexp(-x)); }
__device__ __forceinline__ float one_minus_exp(float x, float e, float w) {
    float q = 1.0f + x * (1.0f / 7.0f); q = 1.0f + x * (1.0f / 6.0f) * q; q = 1.0f + x * 0.2f * q; q = 1.0f + x * 0.25f * q; q = 1.0f + x * (1.0f / 3.0f) * q; q = 1.0f + x * 0.5f * q;
    const float d = 1.0f - e;
    return d + w * (-x * q - d);
}

namespace pg8 {
constexpr int BM = 256, BK = 64, HALF = 128, HTB = HALF * BK * 2, STAGE_BYTES = 8 * HTB, NXCD = 8, WGM = 8;
__host__ __device__ __forceinline__ int lds_byte(int r, int c) { const int st = (r >> 4) * 2 + (c >> 5), rr = r & 15, cc = c & 31, ob = rr * 64 + cc * 2; return st * 1024 + (ob ^ (((ob >> 9) & 1) << 5)); }
__host__ __device__ __forceinline__ void stage_rc(int b, int& R, int& C) { const int st = b / 1024, sb = b % 1024, swz = sb ^ (((sb >> 9) & 1) << 5); R = (st >> 1) * 16 + swz / 64; C = (st & 1) * 32 + (swz % 64) / 2; }
__host__ __device__ __forceinline__ int perm32(int rho) { const int n = rho >> 4, i = rho & 15; return 8 * (i >> 2) + 4 * n + (i & 3); }

struct Unit { const char* A; const char* B; int r0, c0, aux; };

template <class Epi, class Sched, bool ALIGN_EPI>
__device__ __forceinline__ void gemm_phase(LAS unsigned char* lds, const int K, const Sched& S, const Epi& E) {
    const int tid = otid(), wid = __builtin_amdgcn_readfirstlane(tid >> 6), lane = tid & 63, wr = wid >> 2, wc = wid & 3, fr = lane & 15, fq = lane >> 4;
    const int nt = K / BK;
    unsigned voffA[2], voffB[2];
#pragma unroll
    for (int i = 0; i < 2; ++i) { int R, C; stage_rc(tid * 16 + i * 8192, R, C); const int Rb = Epi::PERM ? ((R >> 5) * 64 + perm32(R & 31)) : R;
        voffA[i] = (unsigned)(R * K + C) * 2u; voffB[i] = (unsigned)(Rb * K + C) * 2u; }
    const size_t kstep = (size_t)(BK * 2);
    const size_t hstep = (size_t)HALF * K * 2;
    const size_t hstepB = Epi::PERM ? (size_t)32 * K * 2 : hstep;
    const unsigned ldsw = (unsigned)wid * 1024u;
    const int aoff = lds_byte(wr * 64 + fr, fq * 8), boff = lds_byte(wc * 32 + fr, fq * 8);
#define PG8_SA(b, h) (((b) * 2 + (h)) * HTB)
#define PG8_SB(b, h) ((4 + (b) * 2 + (h)) * HTB)
#define PG8_STAGE(bufoff, gbase, voff) do { _Pragma("unroll") for (int _i = 0; _i < 2; ++_i) \
        __builtin_amdgcn_global_load_lds((const unsigned*)((const char*)(gbase) + (voff)[_i]), (LAS unsigned*)(lds + (bufoff) + ldsw + _i * 8192), 16, 0, 0); } while (0)
#define PG8_LDA(dst, b, h) do { _Pragma("unroll") for (int m = 0; m < 4; ++m) _Pragma("unroll") for (int k = 0; k < 2; ++k) dst[m][k] = *(const LAS bf16x8*)(lds + PG8_SA(b, h) + aoff + m * 2048 + k * 1024); } while (0)
#define PG8_LDB(dst, b, h) do { _Pragma("unroll") for (int n = 0; n < 2; ++n) _Pragma("unroll") for (int k = 0; k < 2; ++k) dst[n][k] = *(const LAS bf16x8*)(lds + PG8_SB(b, h) + boff + n * 2048 + k * 1024); } while (0)
#define PG8_MMA(ai, bj, At, Bt) do { __builtin_amdgcn_s_setprio(1); _Pragma("unroll") for (int m = 0; m < 4; ++m) _Pragma("unroll") for (int n = 0; n < 2; ++n) _Pragma("unroll") for (int k = 0; k < 2; ++k) \
        acc[ai][bj][m][n] = __builtin_amdgcn_mfma_f32_16x16x32_bf16(Bt[n][k], At[m][k], acc[ai][bj][m][n], 0, 0, 0); __builtin_amdgcn_s_setprio(0); } while (0)
#define PG8_WAIT_V(n) asm volatile("s_waitcnt vmcnt(" #n ")" ::: "memory")
#define PG8_WAIT_L(n) asm volatile("s_waitcnt lgkmcnt(" #n ")" ::: "memory")
#define PG8_BAR __builtin_amdgcn_s_barrier()
#define PG8_SCHED __builtin_amdgcn_sched_barrier(0)
    Unit cur, nxt; int ui = 0;
    if (!S.next(0, cur)) return;
    f32x4 acc[2][2][4][2];
#pragma unroll
    for (int a = 0; a < 2; ++a)
#pragma unroll
        for (int b = 0; b < 2; ++b)
#pragma unroll
            for (int m = 0; m < 4; ++m)
#pragma unroll
                for (int n = 0; n < 2; ++n) acc[a][b][m][n] = (f32x4){0.f, 0.f, 0.f, 0.f};
    bf16x8 At[4][2], B0[2][2], B1[2][2];
    const char* cA = cur.A; const char* cB = cur.B;
    PG8_STAGE(PG8_SB(0, 0), cB, voffB); PG8_STAGE(PG8_SB(0, 1), cB + hstepB, voffB); PG8_STAGE(PG8_SA(0, 0), cA, voffA); PG8_STAGE(PG8_SA(0, 1), cA + hstep, voffA);
    if (wr == 1) PG8_BAR;
    PG8_WAIT_V(2); PG8_BAR;
    PG8_STAGE(PG8_SB(1, 0), cB + kstep, voffB); PG8_STAGE(PG8_SA(1, 0), cA + kstep, voffA); PG8_STAGE(PG8_SB(1, 1), cB + hstepB + kstep, voffB);
    PG8_WAIT_V(6); PG8_BAR;
    for (;;) {
        const bool has_next = S.next(ui + 1, nxt);
        const char* nA = has_next ? nxt.A : cA; const char* nB = has_next ? nxt.B : cB;
        for (int t = 0; t < nt; t += 2) {
            const bool last = (t == nt - 2);
            const char* a1 = cA + (size_t)(t + 1) * kstep;
            const char* a2 = last ? nA : cA + (size_t)(t + 2) * kstep; const char* b2 = last ? nB : cB + (size_t)(t + 2) * kstep;
            const char* a3 = a2 + kstep; const char* b3 = b2 + kstep;
            PG8_LDB(B0, 0, 0); PG8_LDB(B1, 0, 1); PG8_SCHED; PG8_LDA(At, 0, 0); PG8_STAGE(PG8_SA(1, 1), a1 + hstep, voffA);
            PG8_WAIT_V(8); PG8_WAIT_L(0); PG8_BAR; PG8_MMA(0, 0, At, B0); PG8_MMA(0, 1, At, B1); PG8_BAR; PG8_SCHED;
            PG8_LDA(At, 0, 1); PG8_STAGE(PG8_SB(0, 0), b2, voffB); PG8_STAGE(PG8_SB(0, 1), b2 + hstepB, voffB); PG8_STAGE(PG8_SA(0, 0), a2, voffA);
            PG8_WAIT_V(8); PG8_WAIT_L(0); PG8_BAR; PG8_MMA(1, 0, At, B0); PG8_MMA(1, 1, At, B1); PG8_BAR; PG8_SCHED;
            PG8_LDB(B0, 1, 0); PG8_LDB(B1, 1, 1); PG8_SCHED; PG8_LDA(At, 1, 0); PG8_STAGE(PG8_SA(0, 1), a2 + hstep, voffA);
            PG8_WAIT_V(8); PG8_WAIT_L(0); PG8_BAR; PG8_MMA(0, 0, At, B0); PG8_MMA(0, 1, At, B1); PG8_BAR; PG8_SCHED;
            PG8_LDA(At, 1, 1); PG8_STAGE(PG8_SB(1, 0), b3, voffB); PG8_STAGE(PG8_SB(1, 1), b3 + hstepB, voffB); PG8_STAGE(PG8_SA(1, 0), a3, voffA);
            PG8_WAIT_V(8); PG8_WAIT_L(0); PG8_BAR; PG8_MMA(1, 0, At, B0); PG8_MMA(1, 1, At, B1); PG8_BAR; PG8_SCHED;
        }
        if constexpr (ALIGN_EPI) { if (wr == 0) PG8_BAR; }
        bool zero = true;
        if constexpr (!Epi::AFTER_DRAIN) zero = E(acc, cur, wr, wc, fr, fq);
        if (!has_next) break;
        if (zero) {
#pragma unroll
            for (int a = 0; a < 2; ++a)
#pragma unroll
                for (int b = 0; b < 2; ++b)
#pragma unroll
                    for (int m = 0; m < 4; ++m)
#pragma unroll
                        for (int n = 0; n < 2; ++n) acc[a][b][m][n] = (f32x4){0.f, 0.f, 0.f, 0.f};
        }
        cur = nxt; cA = nA; cB = nB; ++ui;
        if constexpr (ALIGN_EPI) { if (wr == 1) PG8_BAR; }
    }
    PG8_WAIT_V(0);
    if constexpr (!ALIGN_EPI) { if (wr == 0) PG8_BAR; }
    PG8_BAR;
    if constexpr (Epi::AFTER_DRAIN) E.fused(acc, cur, wr, wc, fr, fq, lds, wid, lane);
#undef PG8_SA
#undef PG8_SB
#undef PG8_STAGE
#undef PG8_LDA
#undef PG8_LDB
#undef PG8_MMA
#undef PG8_WAIT_V
#undef PG8_WAIT_L
#undef PG8_BAR
#undef PG8_SCHED
}

struct EpiBf16 {
    static constexpr bool PERM = true, AFTER_DRAIN = false;
    bf16_t* O; int ldc; size_t split_stride; int split; const float* rowss; float* lnp;
    __device__ __forceinline__ bool operator()(f32x4 (&acc)[2][2][4][2], const Unit& u, int wr, int wc, int fr, int fq) const {
        const int row0 = u.r0 + wr * 64 + fr, pn = u.c0 >> 8;
        const bool paired = pn < 8, vtile = (pn >> 2) == 2;
        const int slot = paired ? 0 : (pn < 12 ? 1 : (pn >> 2));
        bf16_t* base = O + (size_t)slot * split_stride;
        const int col0 = paired ? (pn * 128 + wc * 32 + 8 * fq) : ((pn & 3) * 256 + wc * 64 + 8 * fq);
#pragma unroll
        for (int ai = 0; ai < 2; ++ai)
#pragma unroll
            for (int m = 0; m < 4; ++m) { bf16_t* rowp = base + (size_t)(row0 + ai * HALF + m * 16) * ldc + col0;
                float rs = 1.0f; if (rowss) { const f32x4 q = *(const f32x4*)(rowss + (size_t)(row0 + ai * HALF + m * 16) * 4); rs = __builtin_amdgcn_rsqf((((q.x + q.y) + q.z) + q.w) * (1.0f / D) + EPS); }
                if (paired) {
                    const f32x4 u0 = acc[ai][0][m][0] * rs, u1 = acc[ai][0][m][1] * rs, g0 = acc[ai][1][m][0] * rs, g1 = acc[ai][1][m][1] * rs;
                    u32x4 w; w.x = cvt_pk_bf16(u0[0] * silu(g0[0]), u0[1] * silu(g0[1])); w.y = cvt_pk_bf16(u0[2] * silu(g0[2]), u0[3] * silu(g0[3]));
                    w.z = cvt_pk_bf16(u1[0] * silu(g1[0]), u1[1] * silu(g1[1])); w.w = cvt_pk_bf16(u1[2] * silu(g1[2]), u1[3] * silu(g1[3]));
                    *(u32x4*)rowp = w;
                } else {
                    float ls = 0.f, lq = 0.f;
#pragma unroll
                    for (int bj = 0; bj < 2; ++bj) { const f32x4 v0 = acc[ai][bj][m][0] * rs, v1 = acc[ai][bj][m][1] * rs;
                        if (vtile) { ls += ((v0[0] + v0[1]) + (v0[2] + v0[3])) + ((v1[0] + v1[1]) + (v1[2] + v1[3]));
                            lq += ((v0[0] * v0[0] + v0[1] * v0[1]) + (v0[2] * v0[2] + v0[3] * v0[3])) + ((v1[0] * v1[0] + v1[1] * v1[1]) + (v1[2] * v1[2] + v1[3] * v1[3])); }
                        u32x4 w; w.x = cvt_pk_bf16(v0[0], v0[1]); w.y = cvt_pk_bf16(v0[2], v0[3]); w.z = cvt_pk_bf16(v1[0], v1[1]); w.w = cvt_pk_bf16(v1[2], v1[3]);
                        *(u32x4*)(rowp + bj * 32) = w; }
                    if (vtile) {
                        ls += __shfl_xor(ls, 16); ls += __shfl_xor(ls, 32); lq += __shfl_xor(lq, 16); lq += __shfl_xor(lq, 32);
                        if (fq == 0) *(f32x2*)(lnp + ((size_t)(row0 + ai * HALF + m * 16) * 16 + (pn & 3) * 4 + wc) * 2) = (f32x2){ls, lq}; } } }
        return true;
    }
};
struct EpiKV {
    static constexpr bool PERM = true, AFTER_DRAIN = false;
    bf16_t* KM; bf16_t* VT;
    __device__ __forceinline__ bool operator()(f32x4 (&acc)[2][2][4][2], const Unit& u, int wr, int wc, int fr, int fq) const {
        const int l = u.aux >> 1, isv = u.aux & 1; const int ldc = isv ? MROWS : D;
        bf16_t* base = (isv ? VT : KM) + (size_t)l * MROWS * D;
        const int row0 = u.r0 + wr * 64 + fr, col0 = u.c0 + wc * 64 + 8 * fq;
#pragma unroll
        for (int ai = 0; ai < 2; ++ai)
#pragma unroll
            for (int m = 0; m < 4; ++m) { bf16_t* rowp = base + (size_t)(row0 + ai * HALF + m * 16) * ldc + col0;
#pragma unroll
                for (int bj = 0; bj < 2; ++bj) { const f32x4 v0 = acc[ai][bj][m][0], v1 = acc[ai][bj][m][1];
                    u32x4 w; w.x = cvt_pk_bf16(v0[0], v0[1]); w.y = cvt_pk_bf16(v0[2], v0[3]); w.z = cvt_pk_bf16(v1[0], v1[1]); w.w = cvt_pk_bf16(v1[2], v1[3]);
                    *(u32x4*)(rowp + bj * 32) = w; } }
        return true;
    }
};
struct EpiF32 {
    static constexpr bool PERM = false, AFTER_DRAIN = false;
    float* C;
    __device__ __forceinline__ bool operator()(f32x4 (&acc)[2][2][4][2], const Unit& u, int wr, int wc, int fr, int fq) const {
        const int row0 = u.r0 + wr * 64 + fr, col0 = u.c0 + wc * 32 + 4 * fq;
#pragma unroll
        for (int ai = 0; ai < 2; ++ai)
#pragma unroll
            for (int m = 0; m < 4; ++m) { float* rowp = C + (size_t)(row0 + ai * HALF + m * 16) * D + col0;
#pragma unroll
                for (int bj = 0; bj < 2; ++bj)
#pragma unroll
                    for (int n = 0; n < 2; ++n) *(f32x4*)(rowp + bj * HALF + n * 16) = acc[ai][bj][m][n]; }
        return true;
    }
};

struct EpiOutNorm {
    static constexpr bool PERM = false, AFTER_DRAIN = true;
    const float* xsrc; float* xdst; bf16_t* H; const float* gpost; const float* gpre; float* slot1; float* slot2; unsigned* cnt; unsigned want;
    __device__ __forceinline__ bool operator()(f32x4 (&acc)[2][2][4][2], const Unit& u, int wr, int wc, int fr, int fq) const { return true; }
    __device__ __forceinline__ void fused(f32x4 (&acc)[2][2][4][2], const Unit& u, int wr, int wc, int fr, int fq, LAS unsigned char* lds, int wid, int lane) const {
        const int row0 = u.r0 + wr * 64 + fr, col0 = u.c0 + wc * 32 + 4 * fq, pn = u.c0 >> 8, tid = wid * 64 + lane;
        LAS float* P = (LAS float*)lds;
#pragma unroll
        for (int ai = 0; ai < 2; ++ai)
#pragma unroll
            for (int m = 0; m < 4; ++m) { float sq = 0.f;
#pragma unroll
                for (int bj = 0; bj < 2; ++bj)
#pragma unroll
                    for (int n = 0; n < 2; ++n) { const f32x4 v = acc[ai][bj][m][n]; sq += (v[0] * v[0] + v[1] * v[1]) + (v[2] * v[2] + v[3] * v[3]); }
                sq += __shfl_xor(sq, 16); sq += __shfl_xor(sq, 32);
                if (fq == 0) P[(ai * HALF + wr * 64 + m * 16 + fr) * 4 + wc] = sq; }
        asm volatile("s_waitcnt lgkmcnt(0)" ::: "memory"); __builtin_amdgcn_s_barrier(); asm volatile("" ::: "memory");
        if (tid < 256) { const f32x4 q = *(const LAS f32x4*)(P + tid * 4); __hip_atomic_store(slot1 + (size_t)(u.r0 + tid) * 4 + pn, ((q.x + q.y) + q.z) + q.w, __ATOMIC_RELAXED, __HIP_MEMORY_SCOPE_AGENT); }
        asm volatile("s_waitcnt vmcnt(0) lgkmcnt(0)" ::: "memory"); __builtin_amdgcn_s_barrier(); asm volatile("" ::: "memory");
        unsigned* pc = cnt + 64 * (u.r0 >> 8);
        if (wid == 0) {
            if (lane == 0) __hip_atomic_fetch_add(pc, 1u, __ATOMIC_RELAXED, __HIP_MEMORY_SCOPE_AGENT);
            unsigned sp = 0;
            while ((unsigned)__builtin_amdgcn_readfirstlane(__hip_atomic_load(pc, __ATOMIC_RELAXED, __HIP_MEMORY_SCOPE_AGENT)) < want) { __builtin_amdgcn_s_sleep(1); if (++sp > (1u << 22)) break; }
            __builtin_amdgcn_fence(__ATOMIC_ACQUIRE, "agent");
            asm volatile("s_waitcnt vmcnt(0)" ::: "memory"); }
        asm volatile("" ::: "memory"); __builtin_amdgcn_s_barrier(); asm volatile("" ::: "memory");
        f32x4 gp[2][2], gq[2][2];
#pragma unroll
        for (int bj = 0; bj < 2; ++bj)
#pragma unroll
            for (int n = 0; n < 2; ++n) { gp[bj][n] = *(const f32x4*)(gpost + col0 + bj * HALF + n * 16); gq[bj][n] = H ? *(const f32x4*)(gpre + col0 + bj * HALF + n * 16) : (f32x4){0.f, 0.f, 0.f, 0.f}; }
#pragma unroll
        for (int ai = 0; ai < 2; ++ai)
#pragma unroll
            for (int m = 0; m < 4; ++m) { const int row = row0 + ai * HALF + m * 16; const size_t off = (size_t)row * D + col0;
                const float t0 = __hip_atomic_load(slot1 + (size_t)row * 4 + 0, __ATOMIC_RELAXED, __HIP_MEMORY_SCOPE_AGENT), t1 = __hip_atomic_load(slot1 + (size_t)row * 4 + 1, __ATOMIC_RELAXED, __HIP_MEMORY_SCOPE_AGENT),
                            t2 = __hip_atomic_load(slot1 + (size_t)row * 4 + 2, __ATOMIC_RELAXED, __HIP_MEMORY_SCOPE_AGENT), t3 = __hip_atomic_load(slot1 + (size_t)row * 4 + 3, __ATOMIC_RELAXED, __HIP_MEMORY_SCOPE_AGENT);
                const float r1 = __builtin_amdgcn_rsqf((((t0 + t1) + t2) + t3) * (1.0f / D) + EPS);
                float s2 = 0.f;
#pragma unroll
                for (int bj = 0; bj < 2; ++bj)
#pragma unroll
                    for (int n = 0; n < 2; ++n) { const f32x4 xv = *(const f32x4*)(xsrc + off + bj * HALF + n * 16);
                        const f32x4 xn = xv + acc[ai][bj][m][n] * r1 * gp[bj][n];
                        *(f32x4*)(xdst + off + bj * HALF + n * 16) = xn;
                        s2 += (xn[0] * xn[0] + xn[1] * xn[1]) + (xn[2] * xn[2] + xn[3] * xn[3]);
                        if (H) { const f32x4 a = xn * gq[bj][n]; u32x2 w; w.x = cvt_pk_bf16(a[0], a[1]); w.y = cvt_pk_bf16(a[2], a[3]); *(u32x2*)(H + off + bj * HALF + n * 16) = w; } }
                s2 += __shfl_xor(s2, 16); s2 += __shfl_xor(s2, 32);
                if (fq == 0) P[(ai * HALF + wr * 64 + m * 16 + fr) * 4 + wc] = s2;
                asm volatile("" ::: "memory"); }
        asm volatile("s_waitcnt lgkmcnt(0)" ::: "memory"); __builtin_amdgcn_s_barrier(); asm volatile("" ::: "memory");
        if (H && tid < 256) { const f32x4 q = *(const LAS f32x4*)(P + tid * 4); slot2[(size_t)(u.r0 + tid) * 4 + pn] = ((q.x + q.y) + q.z) + q.w; }
    }
};
struct EpiMerge {
    static constexpr bool PERM = true, AFTER_DRAIN = false;
    const bf16_t* ML;
    bf16_t* O;
    __device__ __forceinline__ bool operator()(f32x4 (&acc)[2][2][4][2], const Unit& u, int wr, int wc, int fr, int fq) const {
        const int sub = u.aux;
        const int row0 = u.r0 + wr * 64 + fr, col0 = u.c0 + wc * 64 + 8 * fq;
        const bf16_t* l0 = ML + (size_t)sub * TC * D;
#pragma unroll
        for (int ai = 0; ai < 2; ++ai)
#pragma unroll
            for (int m = 0; m < 4; ++m) { const size_t off = (size_t)(row0 + ai * HALF + m * 16) * D + col0;
#pragma unroll
                for (int bj = 0; bj < 2; ++bj) {
                    const u32x4 a = *(const u32x4*)(l0 + off + bj * 32);
                    float la[8] = {bflo(a.x), bfhi(a.x), bflo(a.y), bfhi(a.y), bflo(a.z), bfhi(a.z), bflo(a.w), bfhi(a.w)};
                    float f[8];
                    if (sub < 2) {
                        const u32x4 b = *(const u32x4*)(l0 + (size_t)TC * D + off + bj * 32);
                        float lb[8] = {bflo(b.x), bfhi(b.x), bflo(b.y), bfhi(b.y), bflo(b.z), bfhi(b.z), bflo(b.w), bfhi(b.w)};
#pragma unroll
                        for (int j = 0; j < 8; ++j) { const float ea = fexp(-fminf(fmaxf(la[j], -60.f), 60.f)), eb = fexp(-fminf(fmaxf(lb[j], -60.f), 60.f)); f[j] = (1.0f + eb) * frcp(1.0f + ea); }
                    } else {
#pragma unroll
                        for (int j = 0; j < 8; ++j) f[j] = frcp(1.0f + fexp(-fminf(fmaxf(la[j], -60.f), 60.f)));
                    }
                    f32x4 v0 = acc[ai][bj][m][0], v1 = acc[ai][bj][m][1];
                    v0[0] *= f[0]; v0[1] *= f[1]; v0[2] *= f[2]; v0[3] *= f[3]; v1[0] *= f[4]; v1[1] *= f[5]; v1[2] *= f[6]; v1[3] *= f[7];
                    if (sub < 2) { acc[ai][bj][m][0] = v0; acc[ai][bj][m][1] = v1; }
                    else { u32x4 w; w.x = cvt_pk_bf16(v0[0], v0[1]); w.y = cvt_pk_bf16(v0[2], v0[3]); w.z = cvt_pk_bf16(v1[0], v1[1]); w.w = cvt_pk_bf16(v1[2], v1[3]);
                        *(u32x4*)(O + off + bj * 32) = w; }
                } }
        return sub == 2;
    }
};

struct SchedGrid {
    const char* A; const char* B; int nM, nN, nwg, G, c; size_t tstep;
    __device__ __forceinline__ bool next(int i, Unit& u) const {
        const long L = (long)i * G + c; if (L >= nwg) return false;
        int wgid = (int)L; { const int q = nwg / NXCD, r = nwg % NXCD, xcd = wgid % NXCD, off = wgid / NXCD; wgid = (xcd < r ? xcd * (q + 1) : r * (q + 1) + (xcd - r) * q) + off; }
        const int nig = WGM * nN, gid = wgid / nig, fm = gid * WGM, gsz = (nM - fm) < WGM ? (nM - fm) : WGM;
        const int pm = fm + ((wgid % nig) % gsz), pn = (wgid % nig) / gsz;
        u.A = A + (size_t)pm * tstep; u.B = B + (size_t)pn * tstep; u.r0 = pm * BM; u.c0 = pn * BM; u.aux = 0; return true;
    }
};
struct SchedKV {
    const char* MEMN; const char* WKV; int G, c;
    __device__ __forceinline__ bool next(int i, Unit& u) const {
        const int id = i * G + c; if (id >= 256) return false;
        const size_t tstep = (size_t)BM * D * 2;
        const int l = id >> 6, r = id & 63; const char* w = WKV + (size_t)l * 2048 * D * 2;
        if (r < 32) { const int pm = r >> 2, pn = r & 3; u.A = MEMN + pm * tstep; u.B = w + pn * tstep; u.r0 = pm * BM; u.c0 = pn * BM; u.aux = l << 1; }
        else { const int rr = r - 32, pm = rr >> 3, pn = rr & 7; u.A = w + (size_t)(4 + pm) * tstep; u.B = MEMN + pn * tstep; u.r0 = pm * BM; u.c0 = pn * BM; u.aux = (l << 1) | 1; }
        return true;
    }
};
struct SchedMerge {
    const char* Z; const char* WP; int G, c;
    __device__ __forceinline__ bool next(int i, Unit& u) const {
        const int tile = (i / 3) * G + c, sub = i % 3; if (tile >= (TC / BM) * 4) return false;
        const size_t tstep = (size_t)BM * D * 2;
        const int pm = tile >> 2, pn = tile & 3; const int slot = sub == 0 ? 0 : (sub == 1 ? 4 : 6);
        u.A = Z + (size_t)slot * ZSLOT + pm * tstep; u.B = WP + (size_t)sub * D * D * 2 + pn * tstep; u.r0 = pm * BM; u.c0 = pn * BM; u.aux = sub; return true;
    }
};
}

struct Params { const float* in[22]; float* out; unsigned char* ws; int ph_lo, ph_hi; };
typedef const __attribute__((address_space(4))) Params* KP;
enum { I_X = 0, I_MEM, I_MEMG, I_PREG, I_POSTG, I_WIN, I_LNG, I_LNB, I_WS, I_BS, I_CONVW, I_CONVB, I_WR, I_BR, I_WI, I_BI, I_LAM, I_WKV, I_WPA, I_WPB, I_WPC, I_WOUT };

__device__ __forceinline__ void transpose_item(const float* W, int ldw, bf16_t* WT, int ldt, int nblk, LAS float* scr, int item, int lane, bool remap = false) {
    const int kb = item / nblk, nb = item % nblk, k0 = 64 * kb, n0 = 32 * nb;
    int dn0 = n0;
    if (remap) { if (n0 < 1024) dn0 = ((n0 >> 7) * 8 + ((n0 >> 5) & 3) * 2) * 32; else if (n0 < 2048) dn0 = n0 + 1024; else if (n0 < 3072) { const int ch = n0 - 2048; dn0 = ((ch >> 7) * 8 + ((ch >> 5) & 3) * 2 + 1) * 32; } }
#pragma unroll 8
    for (int i = 0; i < 32; ++i) { const int kk = 2 * i + (lane >> 5); scr[kk * 33 + (lane & 31)] = W[(size_t)(k0 + kk) * ldw + n0 + (lane & 31)]; }
    asm volatile("s_waitcnt lgkmcnt(0)" ::: "memory");
    const int c = lane & 7;
#pragma unroll
    for (int j = 0; j < 4; ++j) { const int n = (lane >> 3) + 8 * j; const LAS float* s = scr + (8 * c) * 33 + n;
        u32x4 o; o.x = cvt_pk_bf16(s[0 * 33], s[1 * 33]); o.y = cvt_pk_bf16(s[2 * 33], s[3 * 33]); o.z = cvt_pk_bf16(s[4 * 33], s[5 * 33]); o.w = cvt_pk_bf16(s[6 * 33], s[7 * 33]);
        *(u32x4*)(WT + (size_t)(dn0 + n) * ldt + k0 + 8 * c) = o; }
    asm volatile("s_waitcnt lgkmcnt(0)" ::: "memory");
}
__device__ __forceinline__ void rms_row_to_bf16(const float* xrow, const float* g, bf16_t* orow, int lane) {
    const f32x4* xr = (const f32x4*)xrow + lane; const f32x4* gr = (const f32x4*)g + lane;
    f32x4 v[4]; float s = 0.f;
#pragma unroll
    for (int j = 0; j < 4; ++j) { v[j] = xr[64 * j]; s += (v[j].x * v[j].x + v[j].y * v[j].y) + (v[j].z * v[j].z + v[j].w * v[j].w); }
    const float r = __builtin_amdgcn_rsqf(wave_sum(s) * (1.0f / D) + EPS);
    u32x2* o8 = (u32x2*)orow + lane;
#pragma unroll
    for (int j = 0; j < 4; ++j) { const f32x4 gv = gr[64 * j]; u32x2 w; w.x = cvt_pk_bf16(v[j].x * r * gv.x, v[j].y * r * gv.y); w.y = cvt_pk_bf16(v[j].z * r * gv.z, v[j].w * r * gv.w); o8[64 * j] = w; }
}
__device__ __forceinline__ void row_to_aprime(const float* xrow, const float* g, bf16_t* orow, float* ss, int lane) {
    const f32x4* xr = (const f32x4*)xrow + lane; const f32x4* gr = (const f32x4*)g + lane;
    f32x4 v[4]; float s = 0.f;
#pragma unroll
    for (int j = 0; j < 4; ++j) { v[j] = xr[64 * j]; s += (v[j].x * v[j].x + v[j].y * v[j].y) + (v[j].z * v[j].z + v[j].w * v[j].w); }
    s = wave_sum(s);
    u32x2* o8 = (u32x2*)orow + lane;
#pragma unroll
    for (int j = 0; j < 4; ++j) { const f32x4 gv = gr[64 * j]; u32x2 w; w.x = cvt_pk_bf16(v[j].x * gv.x, v[j].y * gv.y); w.y = cvt_pk_bf16(v[j].z * gv.z, v[j].w * gv.w); o8[64 * j] = w; }
    if (lane == 0) *(f32x4*)ss = (f32x4){s, 0.f, 0.f, 0.f};
}
__device__ __forceinline__ void phase_prologue(KP p, LAS unsigned char* lds) {
    const int tid = otid(), lane = tid & 63, wave = tid >> 6;
    const int gw = obid() * 8 + wave, NGW = ogrid() * 8;
    LAS float* scr = (LAS float*)(lds + wave * 16384);
    unsigned char* ws = ows(p->ws);
    constexpr int PER_L = 5120 + 1024 + 4 * 512 + 128;
    for (int it = gw; it < DEPTH * PER_L; it += NGW) {
        const int l = it / PER_L; int r = it % PER_L;
        if (r < 5120) { transpose_item(asglobal(p->in[I_WIN]) + (size_t)l * D * INW, INW, (bf16_t*)(ws + WS_WIN) + (size_t)l * INW * D, D, INW / 32, scr, r, lane, true); continue; } r -= 5120;
        if (r < 1024) { transpose_item(asglobal(p->in[I_WKV]) + (size_t)l * D * 2048, 2048, (bf16_t*)(ws + WS_WKV) + (size_t)l * 2048 * D, D, 64, scr, r, lane); continue; } r -= 1024;
        if (r < 1536) { const int b = r / 512; transpose_item(asglobal(p->in[I_WPA + b]) + (size_t)l * D * D, D, (bf16_t*)(ws + WS_WP) + (size_t)(l * 3 + b) * D * D, D, 32, scr, r % 512, lane); continue; } r -= 1536;
        if (r < 512) { transpose_item(asglobal(p->in[I_WOUT]) + (size_t)l * D * D, D, (bf16_t*)(ws + WS_WOUT) + (size_t)l * D * D, D, 32, scr, r, lane); continue; } r -= 512;
        { const int ri = r >> 6, h = (r >> 3) & 7, sub = r & 7;
          transpose_item(asglobal(p->in[ri ? I_WI : I_WR]) + (size_t)(l * 8 + h) * 128 * 128, 128, (bf16_t*)(ws + WS_WLRU) + ((size_t)(l * 8 + h) * 256 + ri * 128) * 128, 128, 4, scr, sub, lane); }
    }
    { const float* W = asglobal(p->in[I_WS]); bf16_t* O = (bf16_t*)(ws + WS_WG);
      for (int i4 = obid() * NTHR + tid; i4 < DEPTH * 8 * 128 * 128 / 4; i4 += ogrid() * NTHR) {
          const int e = i4 * 4, j = e & 127, i = (e >> 7) & 127; f32x4 v = *(const f32x4*)(W + e);
          if (i < 64 && j >= 64) v = (f32x4){0.f, 0.f, 0.f, 0.f};
          u32x2 w; w.x = cvt_pk_bf16(v.x, v.y); w.y = cvt_pk_bf16(v.z, v.w); *(u32x2*)(O + e) = w; } }
    for (int m = gw; m < MROWS; m += NGW) rms_row_to_bf16(asglobal(p->in[I_MEM]) + (size_t)m * D, asglobal(p->in[I_MEMG]), (bf16_t*)(ws + WS_MEMN) + (size_t)m * D, lane);
    for (int m = gw; m < TC; m += NGW) row_to_aprime(asglobal(p->in[I_X]) + (size_t)m * D, asglobal(p->in[I_PREG]), (bf16_t*)(ws + WS_H) + (size_t)m * D, (float*)(ws + WS_SS2) + (size_t)m * 4, lane);
}

__device__ __forceinline__ int crow(int reg, int h) { return (reg & 3) + 8 * (reg >> 2) + 4 * h; }
constexpr int LR_XB = 0, LR_XA = 17408, LR_UA = 34816, LR_UU = 67584, LR_SEG = 100352, LR_CAR = 104448, LR_CW = 106496, LR_END = 109568;
template <int PASS>
__device__ __forceinline__ void lru_item(KP p, LAS unsigned char* lds, int l, int item, unsigned pass_tag) {
    const int tid = otid(), lane = tid & 63, wave = tid >> 6, l31 = lane & 31, hh = lane >> 5;
    const int e8 = item & 7, head = (item >> 3) & 7, bl = item >> 6;
    unsigned char* ws = ows(p->ws);
    bf16_t* zxb = (bf16_t*)(ws + WS_Z + 3 * ZSLOT); bf16_t* zgb = (bf16_t*)(ws + WS_Z + 4 * ZSLOT); bf16_t* zgo = zgb; unsigned* lau = (unsigned*)(ws + WS_LAU);
    float* agg = (float*)(ws + WS_AGG);
    const int rowbase = bl * SEQ + e8 * 512;
    const int tb = __builtin_amdgcn_readfirstlane(wave & 1), dblk = __builtin_amdgcn_readfirstlane(wave >> 1);
    bf16x8 wr_f[8], wi_f[8];
    { const bf16_t* w = (const bf16_t*)(ws + WS_WLRU) + ((size_t)(l * 8 + head) * 256 + dblk * 32 + l31) * 128 + 8 * hh;
#pragma unroll
      for (int s = 0; s < 8; ++s) { wr_f[s] = *(const bf16x8*)(w + 16 * s); wi_f[s] = *(const bf16x8*)(w + 128 * 128 + 16 * s); } }
    const int dl = dblk * 32 + l31, dg = l * D + head * 128 + dl;
    const float br = asglobal(p->in[I_BR])[dg], bi = asglobal(p->in[I_BI])[dg];
    float c8; { const float lam = asglobal(p->in[I_LAM])[dg]; const float nl = -lam; const float sp = nl > 20.f ? nl : log1pf(fexp(nl)); c8 = 8.0f * sp; }
    const float wser = (c8 < 0.3f) ? 1.0f : 0.0f;
    const unsigned lauoff = (unsigned)((4 * hh) * D + head * 128 + dblk * 32 + l31) * 4u;
    LAS float* CW = (LAS float*)(lds + LR_CW);
    for (int i = tid; i < 640; i += NTHR) { const int k = i >> 7, c = i & 127; CW[i] = (k < 4) ? asglobal(p->in[I_CONVW])[(size_t)(l * 4 + k) * D + head * 128 + c] : asglobal(p->in[I_CONVB])[l * D + head * 128 + c]; }
    LAS float* CAR = (LAS float*)(lds + LR_CAR);
    float cwr[5][8];
#pragma unroll
    for (int k = 0; k < 5; ++k)
#pragma unroll
        for (int e = 0; e < 8; ++e) cwr[k][e] = (k < 4) ? asglobal(p->in[I_CONVW])[(size_t)(l * 4 + k) * D + head * 128 + (tid & 15) * 8 + e] : asglobal(p->in[I_CONVB])[l * D + head * 128 + (tid & 15) * 8 + e];
    if (tid < 128) {
        float A = 1.f, H = 0.f;
        if (PASS == 2) { for (int e = 0; e < e8; ++e) { const float a2 = agg[((size_t)(item - e8 + e) * 128 + tid) * 2], h2 = agg[((size_t)(item - e8 + e) * 128 + tid) * 2 + 1]; H = a2 * H + h2; } }
        CAR[tid * 2] = A; CAR[tid * 2 + 1] = H;
    }
    LAS float* UA = (LAS float*)(lds + LR_UA); LAS float* UU = (LAS float*)(lds + LR_UU); LAS float* SEG = (LAS float*)(lds + LR_SEG);
    u32x4 pre[3];
#pragma unroll
    for (int k3 = 0; k3 < 3; ++k3) { const int i = tid + k3 * NTHR, r = i >> 4, ch = i & 15; pre[k3] = (u32x4){0u, 0u, 0u, 0u};
        if (i < 67 * 16 && e8 * 512 + r - 3 >= 0) pre[k3] = *(const u32x4*)(zxb + (size_t)(rowbase + r - 3) * D + head * 128 + ch * 8); }
    for (int tile = 0; tile < 8; ++tile) {
        const int row0 = rowbase + tile * 64;
        const int spos0 = e8 * 512 + tile * 64;
#pragma unroll
        for (int k3 = 0; k3 < 3; ++k3) { const int i = tid + k3 * NTHR; if (i < 67 * 16) *(LAS u32x4*)(lds + LR_XB + (i >> 4) * 256 + (i & 15) * 16) = pre[k3]; }
        __syncthreads();
        if (tile + 1 < 8) {
#pragma unroll
            for (int k3 = 0; k3 < 3; ++k3) { const int i = tid + k3 * NTHR, r = i >> 4, ch = i & 15; pre[k3] = (u32x4){0u, 0u, 0u, 0u};
                if (i < 67 * 16) pre[k3] = *(const u32x4*)(zxb + (size_t)(row0 + 64 + r - 3) * D + head * 128 + ch * 8); } }
#pragma unroll
        for (int k2 = 0; k2 < 2; ++k2) { const int idx = tid + k2 * NTHR, t = idx >> 4, ch = idx & 15;
            float xc[8];
#pragma unroll
            for (int e = 0; e < 8; ++e) xc[e] = cwr[4][e];
#pragma unroll
            for (int k = 0; k < 4; ++k) { const u32x4 v = *(const LAS u32x4*)(lds + LR_XB + (t + k) * 256 + ch * 16);
                const float x[8] = {bflo(v.x), bfhi(v.x), bflo(v.y), bfhi(v.y), bflo(v.z), bfhi(v.z), bflo(v.w), bfhi(v.w)};
#pragma unroll
                for (int e = 0; e < 8; ++e) xc[e] += x[e] * cwr[k][e]; }
            u32x4 w; w.x = cvt_pk_bf16(xc[0], xc[1]); w.y = cvt_pk_bf16(xc[2], xc[3]); w.z = cvt_pk_bf16(xc[4], xc[5]); w.w = cvt_pk_bf16(xc[6], xc[7]);
            *(LAS u32x4*)(lds + LR_XA + t * 272 + ch * 16) = w;
            *(LAS f32x4*)(UU + t * 128 + ch * 8) = (f32x4){xc[0], xc[1], xc[2], xc[3]}; *(LAS f32x4*)(UU + t * 128 + ch * 8 + 4) = (f32x4){xc[4], xc[5], xc[6], xc[7]}; }
        __syncthreads();
        bf16_t* gp = zgb + (size_t)(row0 + (tid >> 7) * 16) * D + head * 128 + (tid & 127); bf16_t* go = zgo + (size_t)(row0 + (tid >> 7) * 16) * D + head * 128 + (tid & 127); bf16_t gv[16];
        if (PASS == 2) {
#pragma unroll
            for (int t = 0; t < 16; ++t) gv[t] = gp[(size_t)t * D]; }
        f32x16 ar, ai;
#pragma unroll
        for (int i = 0; i < 16; ++i) { ar[i] = 0.f; ai[i] = 0.f; }
#pragma unroll
        for (int s = 0; s < 8; ++s) { const bf16x8 a = *(const LAS bf16x8*)(lds + LR_XA + (tb * 32 + l31) * 272 + (16 * s + 8 * hh) * 2);
            ar = __builtin_amdgcn_mfma_f32_32x32x16_bf16(a, wr_f[s], ar, 0, 0, 0); ai = __builtin_amdgcn_mfma_f32_32x32x16_bf16(a, wi_f[s], ai, 0, 0, 0); }
#pragma unroll
        for (int i = 0; i < 16; ++i) { const int t = tb * 32 + crow(i, hh);
            const float r = sigm(ar[i] + br), ig = sigm(ai[i] + bi);
            const float la = -c8 * r; const float a0 = fexp(la);
            const float dr = bflo(cvt_pk_bf16(one_minus_exp(la, a0, wser), 0.f));
            const float a = 1.0f - dr; const float mult = __builtin_amdgcn_sqrtf(fmaxf(dr * (2.0f - dr), 0.f));
            const float xcv = UU[t * 128 + dl];
            const unsigned pk = cvt_pk_bf16(dr, mult * ig * xcv);
            UA[t * 128 + dl] = a; UU[t * 128 + dl] = bfhi(pk);
            if (PASS == 1) *(unsigned*)((char*)lau + ((size_t)(row0 + tb * 32 + (i & 3) + 8 * (i >> 2)) * D * 4) + lauoff) = pk; }
        __syncthreads();
        { const int d = tid & 127, seg = tid >> 7; float A = 1.f, H = 0.f;
#pragma unroll
          for (int t = 0; t < 16; ++t) { const float a = UA[(seg * 16 + t) * 128 + d], uu = UU[(seg * 16 + t) * 128 + d]; H = a * H + uu; A *= a; }
          SEG[(seg * 128 + d) * 2] = A; SEG[(seg * 128 + d) * 2 + 1] = H;
          __syncthreads();
          const int cb = tile & 1; float cA = CAR[(cb * 128 + d) * 2], cH = CAR[(cb * 128 + d) * 2 + 1];
          for (int s2 = 0; s2 < seg; ++s2) { const float a2 = SEG[(s2 * 128 + d) * 2], h2 = SEG[(s2 * 128 + d) * 2 + 1]; cH = a2 * cH + h2; cA *= a2; }
          if (PASS == 2) { float h = cH;
#pragma unroll
              for (int t = 0; t < 16; ++t) { const float a = UA[(seg * 16 + t) * 128 + d], uu = UU[(seg * 16 + t) * 128 + d]; h = a * h + uu;
                  const float g = bf1(gv[t]); go[(size_t)t * D] = f2bf(h * silu(g)); } }
          if (seg == 3) { CAR[((cb ^ 1) * 128 + d) * 2] = cA * A; CAR[((cb ^ 1) * 128 + d) * 2 + 1] = A * cH + H; }
        }
    }
    __syncthreads();
    if (PASS == 1) {
        if (tid < 128) { __hip_atomic_store(agg + ((size_t)item * 128 + tid) * 2, CAR[tid * 2], __ATOMIC_RELAXED, __HIP_MEMORY_SCOPE_AGENT); __hip_atomic_store(agg + ((size_t)item * 128 + tid) * 2 + 1, CAR[tid * 2 + 1], __ATOMIC_RELAXED, __HIP_MEMORY_SCOPE_AGENT); }
        asm volatile("s_waitcnt vmcnt(0)" ::: "memory");
        __syncthreads();
        if (tid == 0) __hip_atomic_store((unsigned*)(ws + WS_LFLAG) + 16 * item, pass_tag, __ATOMIC_RELAXED, __HIP_MEMORY_SCOPE_AGENT);
    }
    __syncthreads();
}
constexpr int L2_SA = 0, L2_SH = 16384, L2_CIN = 32768;
__device__ __forceinline__ void lru_pass2(KP p, LAS unsigned char* lds, int l, int item, unsigned pass_tag, bool dry = false) {
    const int tid = otid(), dg = tid & 15, seg = tid >> 4;
    const int e8 = item & 7, head = (item >> 3) & 7, bl = item >> 6;
    unsigned char* ws = ows(p->ws);
    bf16_t* zgb = (bf16_t*)(ws + WS_Z + 4 * ZSLOT); bf16_t* zgo = dry ? (bf16_t*)(ws + WS_H) : zgb; const unsigned* lau = (const unsigned*)(ws + WS_LAU); float* agg = (float*)(ws + WS_AGG);
    const int rowbase = bl * SEQ + e8 * 512;
    LAS float* SA = (LAS float*)(lds + L2_SA); LAS float* SH = (LAS float*)(lds + L2_SH); LAS float* CIN = (LAS float*)(lds + L2_CIN);
    if (tid < 64) {
        if (tid < e8) { unsigned sp = 0; while (__hip_atomic_load((unsigned*)(ws + WS_LFLAG) + 16 * (item - e8 + tid), __ATOMIC_RELAXED, __HIP_MEMORY_SCOPE_AGENT) != pass_tag) { __builtin_amdgcn_s_sleep(1); if (++sp > (1u << 22)) break; } }
        __builtin_amdgcn_fence(__ATOMIC_ACQUIRE, "agent");
        asm volatile("s_waitcnt vmcnt(0)" ::: "memory"); }
    __syncthreads();
    float carry = 0.f;
    if (tid < 128) { for (int e = 0; e < e8; ++e) { const float a2 = __hip_atomic_load(agg + ((size_t)(item - e8 + e) * 128 + tid) * 2, __ATOMIC_RELAXED, __HIP_MEMORY_SCOPE_AGENT), h2 = __hip_atomic_load(agg + ((size_t)(item - e8 + e) * 128 + tid) * 2 + 1, __ATOMIC_RELAXED, __HIP_MEMORY_SCOPE_AGENT); carry = a2 * carry + h2; } }
    u32x4 pk[4][2], pkn[4][2], gv[4], gn[4];
    { const size_t o = (size_t)(rowbase + seg * 4) * D + head * 128 + dg * 8;
#pragma unroll
      for (int t = 0; t < 4; ++t) { pkn[t][0] = *(const u32x4*)(lau + o + (size_t)t * D); pkn[t][1] = *(const u32x4*)(lau + o + (size_t)t * D + 4); gn[t] = *(const u32x4*)(zgb + o + (size_t)t * D); } }
    for (int tile = 0; tile < 4; ++tile) {
        const size_t o = (size_t)(rowbase + tile * 128 + seg * 4) * D + head * 128 + dg * 8;
#pragma unroll
        for (int t = 0; t < 4; ++t) { pk[t][0] = pkn[t][0]; pk[t][1] = pkn[t][1]; gv[t] = gn[t]; }
        if (tile + 1 < 4) {
#pragma unroll
            for (int t = 0; t < 4; ++t) { pkn[t][0] = *(const u32x4*)(lau + o + (size_t)(128 + t) * D); pkn[t][1] = *(const u32x4*)(lau + o + (size_t)(128 + t) * D + 4); gn[t] = *(const u32x4*)(zgb + o + (size_t)(128 + t) * D); } }
        float A[8], H[8];
#pragma unroll
        for (int e = 0; e < 8; ++e) { A[e] = 1.f; H[e] = 0.f; }
#pragma unroll
        for (int t = 0; t < 4; ++t)
#pragma unroll
            for (int e = 0; e < 8; ++e) { const unsigned w = pk[t][e >> 2][e & 3]; const float a = 1.0f - bflo(w); H[e] = a * H[e] + bfhi(w); A[e] *= a; }
        *(LAS f32x4*)(SA + seg * 128 + dg * 8) = (f32x4){A[0], A[1], A[2], A[3]}; *(LAS f32x4*)(SA + seg * 128 + dg * 8 + 4) = (f32x4){A[4], A[5], A[6], A[7]};
        *(LAS f32x4*)(SH + seg * 128 + dg * 8) = (f32x4){H[0], H[1], H[2], H[3]}; *(LAS f32x4*)(SH + seg * 128 + dg * 8 + 4) = (f32x4){H[4], H[5], H[6], H[7]};
        __syncthreads();
        if (tid < 128) {
#pragma unroll 8
            for (int s2 = 0; s2 < 32; ++s2) { CIN[s2 * 128 + tid] = carry; carry = SA[s2 * 128 + tid] * carry + SH[s2 * 128 + tid]; } }
        __syncthreads();
        const f32x4 c0 = *(const LAS f32x4*)(CIN + seg * 128 + dg * 8), c1 = *(const LAS f32x4*)(CIN + seg * 128 + dg * 8 + 4);
        float h[8] = {c0[0], c0[1], c0[2], c0[3], c1[0], c1[1], c1[2], c1[3]};
#pragma unroll
        for (int t = 0; t < 4; ++t) { float y[8]; const u32x4 g = gv[t]; const float g8[8] = {bflo(g.x), bfhi(g.x), bflo(g.y), bfhi(g.y), bflo(g.z), bfhi(g.z), bflo(g.w), bfhi(g.w)};
#pragma unroll
            for (int e = 0; e < 8; ++e) { const unsigned w = pk[t][e >> 2][e & 3]; h[e] = (1.0f - bflo(w)) * h[e] + bfhi(w); y[e] = h[e] * silu(g8[e]); }
            u32x4 w4; w4.x = cvt_pk_bf16(y[0], y[1]); w4.y = cvt_pk_bf16(y[2], y[3]); w4.z = cvt_pk_bf16(y[4], y[5]); w4.w = cvt_pk_bf16(y[6], y[7]);
            *(u32x4*)(zgo + o + (size_t)t * D) = w4; }
    }
    __syncthreads();
}
__device__ __forceinline__ void ln_stats(KP p) {
    const int tid = otid(), lane = tid & 63, wave = tid >> 6;
    unsigned char* ws = ows(p->ws);
    const bf16_t* zv = (const bf16_t*)(ws + WS_Z + 1 * ZSLOT); float* st = (float*)(ws + WS_STATS);
    const int bid = obid();
    for (int k = 0; k < 8; ++k) { const int row = bid * 64 + wave * 8 + k; if (row >= TC) break;
        const u32x4* r = (const u32x4*)(zv + (size_t)row * D) + lane; const u32x4 a = r[0], b = r[64];
        float x[16] = {bflo(a.x), bfhi(a.x), bflo(a.y), bfhi(a.y), bflo(a.z), bfhi(a.z), bflo(a.w), bfhi(a.w), bflo(b.x), bfhi(b.x), bflo(b.y), bfhi(b.y), bflo(b.z), bfhi(b.z), bflo(b.w), bfhi(b.w)};
        float s = 0.f;
#pragma unroll
        for (int i = 0; i < 16; ++i) s += x[i];
        const float mean = wave_sum(s) * (1.0f / D); float q = 0.f;
#pragma unroll
        for (int i = 0; i < 16; ++i) { const float d = x[i] - mean; q += d * d; }
        const float rstd = __builtin_amdgcn_rsqf(wave_sum(q) * (1.0f / D) + EPS);
        if (lane == 0) { st[row * 2] = mean; st[row * 2 + 1] = rstd; } }
}

constexpr int GM_LN = 36864;
constexpr int GM_SV = 40960;
__device__ __forceinline__ void gmlp_items(KP p, LAS unsigned char* lds, int l, int c, int G, bool dry = false) {
    const int tid = otid(), lane = tid & 63, wave = tid >> 6, l31 = lane & 31, hh = lane >> 5;
    unsigned char* ws = ows(p->ws);
    const int nitems = (TC / 128) * 8;
    if (c >= nitems) return;
    const int g = c & 7;
    bf16_t* zu = (bf16_t*)(ws + WS_Z); bf16_t* zuo = dry ? (bf16_t*)(ws + WS_H) : zu; const bf16_t* zv = (const bf16_t*)(ws + WS_Z + 1 * ZSLOT); const bf16_t* zga = (const bf16_t*)(ws + WS_Z + 2 * ZSLOT);
    const float* lnp = (const float*)(ws + WS_LNP);
    LAS float* LN = (LAS float*)(lds + GM_LN); LAS float* SV = (LAS float*)(lds + GM_SV);
    if (tid < 256) LN[tid] = (tid < 128) ? asglobal(p->in[I_LNG])[l * D + g * 128 + tid] : asglobal(p->in[I_LNB])[l * D + g * 128 + tid - 128];
    const int cb = wave & 3, ib0 = (wave >> 2) * 2;
    bf16x8 wf[2][8];
    { const bf16_t* wg = (const bf16_t*)(ws + WS_WG) + (size_t)(l * 8 + g) * 128 * 128;
#pragma unroll
      for (int q = 0; q < 2; ++q)
#pragma unroll
        for (int s = 0; s < 8; ++s) wf[q][s] = *(const bf16x8*)(wg + (size_t)((ib0 + q) * 32 + l31) * 128 + 16 * s + 8 * hh); }
    const int c8 = tid & 15, jt = tid >> 4;
    const float* bsp = asglobal(p->in[I_BS]) + (size_t)(l * 8 + g) * 128;
    u32x4 vq[4]; f32x2 pq[4];
    { const int row0 = (c >> 3) * 128;
#pragma unroll
      for (int k = 0; k < 4; ++k) { vq[k] = *(const u32x4*)(zv + (size_t)(row0 + jt + 32 * k) * D + g * 128 + c8 * 8); pq[k] = *(const f32x2*)(lnp + (size_t)(row0 + jt + 32 * k) * 32 + 2 * c8); } }
    __syncthreads();
    for (int item = c; item < nitems; item += G) {
        const int row0 = (item >> 3) * 128;
#pragma unroll
        for (int k = 0; k < 4; ++k) { const int j = jt + 32 * k; float ssum = pq[k].x, qsum = pq[k].y;
#pragma unroll
            for (int o = 1; o < 16; o <<= 1) { ssum += __shfl_xor(ssum, o); qsum += __shfl_xor(qsum, o); }
            const float mean = ssum * (1.0f / D), rstd = __builtin_amdgcn_rsqf(fmaxf(qsum * (1.0f / D) - mean * mean, 0.f) + EPS);
            const u32x4 v = vq[k];
            const float x[8] = {bflo(v.x), bfhi(v.x), bflo(v.y), bfhi(v.y), bflo(v.z), bfhi(v.z), bflo(v.w), bfhi(v.w)};
            const int colb = ((((j >> 3) ^ c8) & 15) * 8 + (j & 7)) * 2;
#pragma unroll
            for (int e = 0; e < 8; ++e) { const float y = (x[e] - mean) * rstd * LN[c8 * 8 + e] + LN[128 + c8 * 8 + e]; *(LAS bf16_t*)(lds + (c8 * 8 + e) * 272 + colb) = f2bf(y); } }
        __syncthreads();
        if (item + G < nitems) { const int rown = ((item + G) >> 3) * 128;
#pragma unroll
            for (int k = 0; k < 4; ++k) { vq[k] = *(const u32x4*)(zv + (size_t)(rown + jt + 32 * k) * D + g * 128 + c8 * 8); pq[k] = *(const f32x2*)(lnp + (size_t)(rown + jt + 32 * k) * 32 + 2 * c8); } }
        u32x4 uq[4]; float bq[4];
#pragma unroll
        for (int k = 0; k < 4; ++k) { const size_t off = (size_t)(row0 + jt + 32 * k) * D + g * 128 + c8 * 8; uq[k] = *(const u32x4*)(zu + off); bq[k] = bsp[jt + 32 * k]; }
        f32x16 acc[2];
#pragma unroll
        for (int q = 0; q < 2; ++q)
#pragma unroll
            for (int i = 0; i < 16; ++i) acc[q][i] = 0.f;
#pragma unroll
        for (int s = 0; s < 8; ++s) { const int ch = cb * 32 + l31; const bf16x8 a = *(const LAS bf16x8*)(lds + ch * 272 + ((((2 * s + hh) ^ (ch >> 3)) & 15) * 16));
#pragma unroll
            for (int q = 0; q < 2; ++q) acc[q] = __builtin_amdgcn_mfma_f32_32x32x16_bf16(a, wf[q][s], acc[q], 0, 0, 0); }
#pragma unroll
        for (int q = 0; q < 2; ++q)
#pragma unroll
            for (int rg = 0; rg < 4; ++rg) *(LAS f32x4*)(SV + ((ib0 + q) * 32 + l31) * 132 + cb * 32 + 8 * rg + 4 * hh) = (f32x4){acc[q][4 * rg], acc[q][4 * rg + 1], acc[q][4 * rg + 2], acc[q][4 * rg + 3]};
        __syncthreads();
#pragma unroll
        for (int k = 0; k < 4; ++k) { const int i = jt + 32 * k; const size_t off = (size_t)(row0 + i) * D + g * 128 + c8 * 8;
            const f32x4 s0 = *(const LAS f32x4*)(SV + i * 132 + c8 * 8), s1 = *(const LAS f32x4*)(SV + i * 132 + c8 * 8 + 4);
            const float sv[8] = {s0[0], s0[1], s0[2], s0[3], s1[0], s1[1], s1[2], s1[3]};
            const u32x4 uu = uq[k];
            const float u8[8] = {bflo(uu.x), bfhi(uu.x), bflo(uu.y), bfhi(uu.y), bflo(uu.z), bfhi(uu.z), bflo(uu.w), bfhi(uu.w)};
            float y[8];
#pragma unroll
            for (int e = 0; e < 8; ++e) y[e] = u8[e] * (sv[e] + bq[k]);
            u32x4 w; w.x = cvt_pk_bf16(y[0], y[1]); w.y = cvt_pk_bf16(y[2], y[3]); w.z = cvt_pk_bf16(y[4], y[5]); w.w = cvt_pk_bf16(y[6], y[7]);
            *(u32x4*)(zuo + off) = w; }
    }
    __syncthreads();
}

constexpr int AT_STRIDE = 528;
__device__ __forceinline__ void attn_item(KP p, LAS unsigned char* lds, int l, int chunk, int item, bool dry = false) {
    const int tid = otid(), lane = tid & 63, wave = tid >> 6, l31 = lane & 31, hh = lane >> 5;
    const int tile = item & 15, hd = (item >> 4) & 3, bl = item >> 6, bg = chunk * BPC + bl;
    unsigned char* ws = ows(p->ws);
    const bf16_t* zq = (const bf16_t*)(ws + WS_Z + 5 * ZSLOT); bf16_t* zgc = (bf16_t*)(ws + WS_Z + 6 * ZSLOT); bf16_t* zgco = dry ? (bf16_t*)(ws + WS_H) : zgc;
    const bf16_t* KM = (const bf16_t*)(ws + WS_KM) + (size_t)l * MROWS * D + (size_t)bg * MEML * D + hd * 256;
    const bf16_t* VT = (const bf16_t*)(ws + WS_VT) + (size_t)l * D * MROWS + (size_t)hd * 256 * MROWS + bg * MEML;
    const int trow = bl * SEQ + tile * 256 + wave * 32 + l31;
    const bf16_t* qp = zq + (size_t)trow * D + hd * 256 + 8 * hh;
    const unsigned koff = (unsigned)((tid >> 5) * D + (tid & 31) * 8) * 2u, voff = (unsigned)((tid >> 5) * MROWS + (tid & 31) * 8) * 2u;
    const unsigned loff = (unsigned)((tid >> 5) * AT_STRIDE + (tid & 31) * 16);
#pragma unroll
    for (int k = 0; k < 16; ++k) *(LAS u32x4*)(lds + loff + k * 16 * AT_STRIDE) = *(const u32x4*)((const char*)KM + (size_t)k * 16 * D * 2 + koff);
    __syncthreads();
    const float k2 = 0.0625f * 1.44269504089f;
    bf16x8 pf[8][2];
    u32x4 vpre[8];
    float mA = 0.f, sumA = 0.f, alphaA = 1.f, sum = 0.f;
#pragma unroll
    for (int half = 0; half < 2; ++half) {
        f32x16 sc[4];
#pragma unroll
        for (int mb = 0; mb < 4; ++mb)
#pragma unroll
            for (int i = 0; i < 16; ++i) sc[mb][i] = 0.f;
        bf16x8 qc[4], qn[4];
#pragma unroll
        for (int s4 = 0; s4 < 4; ++s4) qc[s4] = *(const bf16x8*)(qp + 16 * s4);
#pragma unroll 1
        for (int sg = 0; sg < 4; ++sg) {
            if (sg < 3) {
#pragma unroll
                for (int s4 = 0; s4 < 4; ++s4) qn[s4] = *(const bf16x8*)(qp + 64 * (sg + 1) + 16 * s4); }
#pragma unroll
            for (int s4 = 0; s4 < 4; ++s4)
#pragma unroll
                for (int mb = 0; mb < 4; ++mb) { const bf16x8 a = *(const LAS bf16x8*)(lds + (half * 128 + mb * 32 + l31) * AT_STRIDE + (64 * sg + 16 * s4 + 8 * hh) * 2);
                    sc[mb] = __builtin_amdgcn_mfma_f32_32x32x16_bf16(a, qc[s4], sc[mb], 0, 0, 0); }
#pragma unroll
            for (int s4 = 0; s4 < 4; ++s4) qc[s4] = qn[s4];
        }
        if (half == 1) {
            __builtin_amdgcn_sched_barrier(0);
#pragma unroll
            for (int k = 0; k < 8; ++k) vpre[k] = *(const u32x4*)((const char*)VT + (size_t)k * 16 * MROWS * 2 + voff); }
        float mh = -3.0e38f;
#pragma unroll
        for (int mb = 0; mb < 4; ++mb)
#pragma unroll
            for (int i = 0; i < 16; ++i) mh = fmaxf(mh, sc[mb][i]);
        mh = fmaxf(mh, __shfl_xor(mh, 32));
        float mref;
        if (half == 0) { mA = mh; mref = mh; } else { mref = fmaxf(mA, mh); alphaA = __builtin_amdgcn_exp2f((mA - mref) * k2); }
        float sh = 0.f;
#pragma unroll
        for (int mb = 0; mb < 4; ++mb) {
#pragma unroll
            for (int i = 0; i < 16; ++i) { const float e = __builtin_amdgcn_exp2f((sc[mb][i] - mref) * k2); sc[mb][i] = e; sh += e; }
#pragma unroll
            for (int s2 = 0; s2 < 2; ++s2) { u32x4 w;
                w.x = cvt_pk_bf16(sc[mb][8 * s2 + 0], sc[mb][8 * s2 + 1]); w.y = cvt_pk_bf16(sc[mb][8 * s2 + 2], sc[mb][8 * s2 + 3]);
                w.z = cvt_pk_bf16(sc[mb][8 * s2 + 4], sc[mb][8 * s2 + 5]); w.w = cvt_pk_bf16(sc[mb][8 * s2 + 6], sc[mb][8 * s2 + 7]);
                pf[half * 4 + mb][s2] = __builtin_bit_cast(bf16x8, w); } }
        sh += __shfl_xor(sh, 32);
        if (half == 0) sumA = sh; else sum = sumA * alphaA + sh;
    }
    const float inv = frcp(sum);
    __syncthreads();
#pragma unroll
    for (int k = 0; k < 8; ++k) *(LAS u32x4*)(lds + loff + k * 16 * AT_STRIDE) = vpre[k];
#pragma unroll
    for (int k = 8; k < 16; ++k) *(LAS u32x4*)(lds + loff + k * 16 * AT_STRIDE) = *(const u32x4*)((const char*)VT + (size_t)k * 16 * MROWS * 2 + voff);
    u32x4 gcr[4][2];
    { const size_t off0 = (size_t)trow * D + hd * 256 + 8 * hh;
#pragma unroll
      for (int b4 = 0; b4 < 4; ++b4)
#pragma unroll
        for (int k = 0; k < 2; ++k) gcr[b4][k] = *(const u32x4*)(zgc + off0 + b4 * 32 + 16 * k); }
    __syncthreads();
#pragma unroll
    for (int db = 0; db < 8; ++db) { f32x16 o; u32x4 gc[2];
#pragma unroll
        for (int k = 0; k < 2; ++k) gc[k] = gcr[db & 3][k];
        if (db < 4) { const size_t off1 = (size_t)trow * D + hd * 256 + (db + 4) * 32 + 8 * hh;
#pragma unroll
            for (int k = 0; k < 2; ++k) gcr[db & 3][k] = *(const u32x4*)(zgc + off1 + 16 * k); }
#pragma unroll
        for (int i = 0; i < 16; ++i) o[i] = 0.f;
#pragma unroll
        for (int mb = 0; mb < 8; ++mb) {
            if (mb == 4) {
#pragma unroll
                for (int i = 0; i < 16; ++i) o[i] *= alphaA; }
#pragma unroll
            for (int s2 = 0; s2 < 2; ++s2) { const LAS unsigned char* vp = lds + (db * 32 + l31) * AT_STRIDE + (mb * 32 + 16 * s2 + 4 * hh) * 2;
                const s16x4 lo = *(const LAS s16x4*)vp, hi = *(const LAS s16x4*)(vp + 16);
                const bf16x8 a = __builtin_shufflevector(lo, hi, 0, 1, 2, 3, 4, 5, 6, 7);
                o = __builtin_amdgcn_mfma_f32_32x32x16_bf16(a, pf[mb][s2], o, 0, 0, 0); } }
#pragma unroll
        for (int k = 0; k < 2; ++k) { float v8[8];
#pragma unroll
            for (int j = 0; j < 4; ++j) { typedef unsigned u2v __attribute__((ext_vector_type(2)));
                const u2v sw = __builtin_amdgcn_permlane32_swap(__float_as_uint(o[8 * k + j]), __float_as_uint(o[8 * k + 4 + j]), false, false);
                v8[j] = __uint_as_float(sw[0]); v8[4 + j] = __uint_as_float(sw[1]); }
            const u32x4 g = gc[k]; const float g8[8] = {bflo(g.x), bfhi(g.x), bflo(g.y), bfhi(g.y), bflo(g.z), bfhi(g.z), bflo(g.w), bfhi(g.w)};
            float y[8];
#pragma unroll
            for (int e = 0; e < 8; ++e) y[e] = v8[e] * inv * silu(g8[e]);
            u32x4 w; w.x = cvt_pk_bf16(y[0], y[1]); w.y = cvt_pk_bf16(y[2], y[3]); w.z = cvt_pk_bf16(y[4], y[5]); w.w = cvt_pk_bf16(y[6], y[7]);
            *(u32x4*)(zgco + (size_t)trow * D + hd * 256 + db * 32 + 16 * k + 8 * hh) = w; } }
    __syncthreads();
}

__device__ __forceinline__ void row_phase(KP p, int l, int chunk, bool dry = false) {
    const int tid = otid(), lane = tid & 63, wave = tid >> 6;
    const int gw = obid() * 8 + wave, NGW = ogrid() * 8;
    unsigned char* ws = ows(p->ws);
    const float* outf = (const float*)(ws + WS_Z);
    const float* xsrc = (l == 0) ? asglobal(p->in[I_X]) : asglobal(p->out);
    const float* gpost = asglobal(p->in[I_POSTG]) + l * D; const float* gpre = asglobal(p->in[I_PREG]) + (l + 1 < DEPTH ? l + 1 : 0) * D;
    bf16_t* H = dry ? (bf16_t*)(ws + WS_Z + 4 * ZSLOT) : (bf16_t*)(ws + WS_H);
    float* xout = dry ? (float*)(ws + WS_Z + 2 * ZSLOT) - (size_t)chunk * TC * D : asglobal(p->out);
    for (int r = gw; r < TC; r += NGW) {
        const size_t grow = (size_t)chunk * TC + r;
        const f32x4* orow = (const f32x4*)(outf + (size_t)r * D) + lane; const f32x4* xr = (const f32x4*)(xsrc + grow * D) + lane;
        f32x4 o[4], x[4]; float s = 0.f;
#pragma unroll
        for (int j = 0; j < 4; ++j) { o[j] = orow[64 * j]; x[j] = xr[64 * j]; s += (o[j].x * o[j].x + o[j].y * o[j].y) + (o[j].z * o[j].z + o[j].w * o[j].w); }
        const float r1 = __builtin_amdgcn_rsqf(wave_sum(s) * (1.0f / D) + EPS); float s2 = 0.f;
        f32x4* xo = (f32x4*)(xout + grow * D) + lane;
#pragma unroll
        for (int j = 0; j < 4; ++j) { const f32x4 gv = ((const f32x4*)gpost)[lane + 64 * j]; x[j] = x[j] + o[j] * r1 * gv; xo[64 * j] = x[j];
            s2 += (x[j].x * x[j].x + x[j].y * x[j].y) + (x[j].z * x[j].z + x[j].w * x[j].w); }
        if (l + 1 < DEPTH) {
            const float r2 = __builtin_amdgcn_rsqf(wave_sum(s2) * (1.0f / D) + EPS); u32x2* h8 = (u32x2*)(H + (size_t)r * D) + lane;
#pragma unroll
            for (int j = 0; j < 4; ++j) { const f32x4 gv = ((const f32x4*)gpre)[lane + 64 * j]; u32x2 w; w.x = cvt_pk_bf16(x[j].x * r2 * gv.x, x[j].y * r2 * gv.y); w.y = cvt_pk_bf16(x[j].z * r2 * gv.z, x[j].w * r2 * gv.w); h8[64 * j] = w; }
        } else if (chunk + 1 < NCH) {
            rms_row_to_bf16(asglobal(p->in[I_X]) + ((size_t)(chunk + 1) * TC + r) * D, asglobal(p->in[I_PREG]), H + (size_t)r * D, lane);
        }
    }
}

#define XB_TMO      128
#define XB_XCNT(j)  (256  + 64 * (j))
#define XB_XSUB(j)  (1280 + 64 * (j))
#define XB_XGEN(j)  (2304 + 64 * (j))
#define XB_TOP      3328
#define XB_TOPGEN   3392
#define XCD_BAR_WORDS 3456
#define XB_SPIN_CAP (1u << 22)
__device__ __forceinline__ unsigned xb_ld(unsigned* p)              { return __hip_atomic_load(p, __ATOMIC_RELAXED, __HIP_MEMORY_SCOPE_AGENT); }
__device__ __forceinline__ unsigned xb_add(unsigned* p, unsigned v) { return __hip_atomic_fetch_add(p, v, __ATOMIC_RELAXED, __HIP_MEMORY_SCOPE_AGENT); }
__device__ __forceinline__ unsigned xb_xcc_id() { return (unsigned)__builtin_amdgcn_s_getreg((3 << 11) | 20) & 0xFu; }
#define XB_SPIN(cond, bar) do { unsigned _sp = 0; while (cond) { __builtin_amdgcn_s_sleep(1); \
    if ((++_sp & 255u) == 0u) { if (xb_ld(&(bar)[XB_TMO])) break; if (_sp > XB_SPIN_CAP) { atomicAdd(&(bar)[XB_TMO], 1u); break; } } } } while (0)
struct XcdBarrier { unsigned* bar; unsigned x; volatile LAS unsigned* st; };
__device__ __forceinline__ XcdBarrier xcd_barrier_post(unsigned* bar, volatile LAS unsigned* st) {
    XcdBarrier b; b.bar = bar; b.x = xb_xcc_id(); b.st = st;
    if (threadIdx.x == 0) (void)xb_add(&bar[XB_XCNT(b.x)], 1u);
    return b;
}
__device__ __forceinline__ void xcd_barrier_complete(unsigned* bar, unsigned x, unsigned& nloc, unsigned& nx) {
    const unsigned G = gridDim.x * gridDim.y * gridDim.z;
    unsigned sum, cnt, mine, sp = 0u;
    for (;;) {
        sum = 0u; cnt = 0u; mine = 0u;
#pragma unroll
        for (unsigned j = 0; j < 16; ++j) { const unsigned c = xb_ld(&bar[XB_XCNT(j)]); sum += c; cnt += (c > 0u) ? 1u : 0u; mine = (j == x) ? c : mine; }
        if (sum == G) break;
        __builtin_amdgcn_s_sleep(1);
        if ((++sp & 255u) == 0u) { if (xb_ld(&bar[XB_TMO])) break; if (sp > XB_SPIN_CAP) { atomicAdd(&bar[XB_TMO], 1u); break; } }
    }
    nloc = mine > 0u ? mine : 1u; nx = cnt > 0u ? cnt : 1u;
}
__device__ __forceinline__ void xcd_barrier(const XcdBarrier& b) {
    asm volatile("s_waitcnt vmcnt(0)" ::: "memory");
    __syncthreads();
    if (threadIdx.x == 0) {
        unsigned* bar = (unsigned*)ows((unsigned char*)b.bar);
        __builtin_amdgcn_s_waitcnt(0);
        unsigned nloc = b.st[0], nx = b.st[1];
        if (nloc == 0u) { xcd_barrier_complete(bar, b.x, nloc, nx); b.st[0] = nloc; b.st[1] = nx; }
        const unsigned old = xb_add(&bar[XB_XSUB(b.x)], 1u);
        const unsigned gen = old / nloc;
        if (old + 1u == (gen + 1u) * nloc) {
            __builtin_amdgcn_fence(__ATOMIC_RELEASE, "agent");
            asm volatile("s_waitcnt vmcnt(0)" ::: "memory");
            const unsigned og = xb_add(&bar[XB_TOP], 1u);
            const unsigned tg = og / nx;
            if (og + 1u == (tg + 1u) * nx) xb_add(&bar[XB_TOPGEN], 1u);
            else XB_SPIN(xb_ld(&bar[XB_TOPGEN]) == tg, bar);
            __builtin_amdgcn_fence(__ATOMIC_ACQUIRE, "agent");
            xb_add(&bar[XB_XGEN(b.x)], 1u);
            asm volatile("s_waitcnt vmcnt(0)" ::: "memory");
        } else {
            XB_SPIN(xb_ld(&bar[XB_XGEN(b.x)]) == gen, bar);
            __builtin_amdgcn_fence(__ATOMIC_ACQUIRE, "agent");
            asm volatile("s_waitcnt vmcnt(0)" ::: "memory");
        }
    }
    __syncthreads();
}

constexpr int N_PHASES = 2 + NCH * DEPTH * 4;
__global__ void __launch_bounds__(NTHR, 2) mk_fwd(Params pk) {
    extern __shared__ __attribute__((aligned(16))) unsigned char lds_raw[];
    LAS unsigned char* lds = (LAS unsigned char*)lds_raw;
    unsigned char* ws = pk.ws;
    int G = gridDim.x, c = blockIdx.x;
    volatile LAS unsigned* bst = (volatile LAS unsigned*)(lds + LDS_BYTES - 64);
    if (threadIdx.x < 2) bst[threadIdx.x] = 0u;
    __syncthreads();
    XcdBarrier bar; bar.bar = (unsigned*)(ws + WS_BAR); bar.x = 0; bar.st = bst;
    if (pk.ph_hi - pk.ph_lo > 1) bar = xcd_barrier_post((unsigned*)(ws + WS_BAR), bst);
    const int ph_hi = pk.ph_hi;
    for (int ph = pk.ph_lo; ph < ph_hi; ++ph) {
        KP p = (KP)__builtin_amdgcn_kernarg_segment_ptr(); asm volatile("" : "+s"(p));
        ws = ows(ws); asm volatile("" : "+s"(G), "+s"(c));
        if (ph == 0) { if constexpr ((PH_MASK & 1) != 0) phase_prologue(p, lds); }
        else if (ph == 1) { if constexpr ((PH_MASK & 2) != 0) {
            pg8::SchedKV S{(const char*)(ws + WS_MEMN), (const char*)(ws + WS_WKV), G, c};
            pg8::EpiKV E{(bf16_t*)(ws + WS_KM), (bf16_t*)(ws + WS_VT)};
            pg8::gemm_phase<pg8::EpiKV, pg8::SchedKV, true>(lds, D, S, E); }
        } else {
            const int s = (ph - 2) / 4, k = (ph - 2) % 4, chunk = s / DEPTH, l = s % DEPTH;
            for (int rep = 0; rep < (((DBL >> k) & 1) ? 2 : 1); ++rep) {
            if (rep) xcd_barrier(bar);
            if (k == 0) { if constexpr ((PH_MASK & 4) != 0) {
                pg8::SchedGrid S{(const char*)(ws + WS_H), (const char*)(ws + WS_WIN) + (size_t)l * INW * D * 2, TC / 256, INW / 256, (TC / 256) * (INW / 256), G, c, (size_t)256 * D * 2};
                pg8::EpiBf16 E{(bf16_t*)(ws + WS_Z), D, (size_t)TC * D, 1, (const float*)(ws + WS_SS2), (float*)(ws + WS_LNP)};
                pg8::gemm_phase<pg8::EpiBf16, pg8::SchedGrid, true>(lds, D, S, E); }
            } else if (k == 1) {
                if constexpr ((DRYM & 1) != 0) for (int it = c; it < 256; it += G) lru_item<1>(p, lds, l, it, (unsigned)(s + 1));
                if constexpr ((PH_MASK & 8) != 0) for (int it = c; it < 256; it += G) lru_item<1>(p, lds, l, it, (unsigned)(s + 1));
                if constexpr ((DRYM & 2) != 0) gmlp_items(p, lds, l, c, G, true);
                if constexpr ((PH_MASK & 32) != 0) gmlp_items(p, lds, l, c, G);
                if constexpr ((DRYM & 4) != 0) for (int it = c; it < 256; it += G) attn_item(p, lds, l, chunk, it, true);
                if constexpr ((PH_MASK & 64) != 0) for (int it = c; it < 256; it += G) attn_item(p, lds, l, chunk, it);
                if constexpr ((DRYM & 8) != 0) for (int it = c; it < 256; it += G) lru_pass2(p, lds, l, it, (unsigned)(s + 1), true);
                if constexpr ((PH_MASK & 16) != 0) for (int it = c; it < 256; it += G) lru_pass2(p, lds, l, it, (unsigned)(s + 1));
            } else if (k == 2) { if constexpr ((PH_MASK & 128) != 0) {
                pg8::SchedMerge S{(const char*)(ws + WS_Z), (const char*)(ws + WS_WP) + (size_t)l * 3 * D * D * 2, G, c};
                pg8::EpiMerge E{(const bf16_t*)(ws + WS_Z + 7 * ZSLOT), (bf16_t*)(ws + WS_Z + 5 * ZSLOT)};
                pg8::gemm_phase<pg8::EpiMerge, pg8::SchedMerge, true>(lds, D, S, E); }
            } else { if constexpr ((PH_MASK & 256) != 0) {
                const bool lastl = (l + 1 == DEPTH);
                pg8::SchedGrid S{(const char*)(ws + WS_Z + 5 * ZSLOT), (const char*)(ws + WS_WOUT) + (size_t)l * D * D * 2, TC / 256, 4, (TC / 256) * 4, G, c, (size_t)256 * D * 2};
                pg8::EpiOutNorm E{(l == 0 ? asglobal(p->in[I_X]) : asglobal(p->out)) + (size_t)chunk * TC * D, asglobal(p->out) + (size_t)chunk * TC * D, lastl ? (bf16_t*)nullptr : (bf16_t*)(ws + WS_H),
                                  asglobal(p->in[I_POSTG]) + l * D, asglobal(p->in[I_PREG]) + (lastl ? 0 : l + 1) * D, (float*)(ws + WS_SS1), (float*)(ws + WS_SS2),
                                  (unsigned*)(ws + WS_PCNT), 4u * (unsigned)(s + 1)};
                pg8::gemm_phase<pg8::EpiOutNorm, pg8::SchedGrid, true>(lds, D, S, E);
                if (lastl && chunk + 1 < NCH) {
                    const int wave = otid() >> 6, lane = otid() & 63;
                    for (int m = c * 8 + wave; m < TC; m += G * 8) row_to_aprime(asglobal(p->in[I_X]) + ((size_t)(chunk + 1) * TC + m) * D, asglobal(p->in[I_PREG]), (bf16_t*)(ws + WS_H) + (size_t)m * D, (float*)(ws + WS_SS2) + (size_t)m * 4, lane);
                } } }
            }
        }
        if (ph + 1 < ph_hi) { if (ph_hi == -12345) cg::this_grid().sync();
                              xcd_barrier(bar); }
    }
}

extern "C" void kernel_launch(void* const* d_in, const int* in_sizes, int n_in, void* d_out, int out_size, void* d_ws, size_t ws_size, hipStream_t stream) {
    static int grid = 0;
    if (grid == 0) {
        if (n_in != 22 || out_size != NT * D || ws_size < WS_END) { fprintf(stderr, "kernel_launch: unexpected problem (n_in %d, out %d, ws %zu < %zu)\n", n_in, out_size, ws_size, (size_t)WS_END); grid = -1; return; }
        if (hipFuncSetAttribute((const void*)mk_fwd, hipFuncAttributeMaxDynamicSharedMemorySize, LDS_BYTES) != hipSuccess) { fprintf(stderr, "kernel_launch: hipFuncSetAttribute failed\n"); grid = -1; return; }
        int dev = 0, cus = 0, per_cu = 0;
        (void)hipGetDevice(&dev); (void)hipDeviceGetAttribute(&cus, hipDeviceAttributeMultiprocessorCount, dev);
        (void)hipOccupancyMaxActiveBlocksPerMultiprocessor(&per_cu, (const void*)mk_fwd, NTHR, LDS_BYTES);
        (void)hipGetLastError();
        grid = cus > 0 ? cus : 256;
        if (per_cu < 1) fprintf(stderr, "kernel_launch: occupancy query says %d blocks per CU\n", per_cu);
    }
    if (grid < 0) return;
    Params p{};
    for (int i = 0; i < 22; ++i) p.in[i] = (const float*)d_in[i];
    p.out = (float*)d_out; p.ws = (unsigned char*)d_ws;
#if MK_MULTI
    for (int ph = 0; ph < N_PHASES; ++ph) { p.ph_lo = ph; p.ph_hi = ph + 1; hipLaunchKernelGGL(mk_fwd, dim3(grid), dim3(NTHR), LDS_BYTES, stream, p); }
#else
    p.ph_lo = 0; p.ph_hi = N_PHASES;
    (void)hipMemsetAsync((char*)d_ws + WS_BAR, 0, WS_ZERO_END - WS_BAR, stream);
    void* args[] = {&p};
    hipError_t e = hipLaunchCooperativeKernel((const void*)mk_fwd, dim3(grid), dim3(NTHR), args, LDS_BYTES, stream);
    if (e != hipSuccess) fprintf(stderr, "cooperative launch failed: %s (grid %d)\n", hipGetErrorString(e), grid);
#endif
}
```

```cpp
#include <hip/hip_runtime.h>
#include <hip/hip_cooperative_groups.h>
#include <cstdio>
#include <cstdint>
namespace cg = cooperative_groups;

#ifndef MK_MULTI
#define MK_MULTI 0
#endif

#ifndef DBL
#define DBL 0
#endif
#ifndef DRYM
#define DRYM 0
#endif
#ifndef PH_MASK
#define PH_MASK 0x3FF
#endif
#define LAS __attribute__((address_space(3)))
typedef unsigned short bf16_t;
typedef short bf16x8 __attribute__((ext_vector_type(8)));
typedef short s16x4 __attribute__((ext_vector_type(4)));
typedef float f32x4 __attribute__((ext_vector_type(4)));
typedef float f32x2 __attribute__((ext_vector_type(2)));
typedef float f32x16 __attribute__((ext_vector_type(16)));
typedef unsigned u32x4 __attribute__((ext_vector_type(4)));
typedef unsigned u32x2 __attribute__((ext_vector_type(2)));

constexpr int D = 1024, NB = 8, SEQ = 4096, DEPTH = 4, NT = NB * SEQ;
constexpr int NCH = 2, TC = NT / NCH, BPC = NB / NCH;
constexpr int INW = 10240, MEML = 256, MROWS = NB * MEML;
constexpr float EPS = 1e-6f;
constexpr int NTHR = 512;

constexpr size_t MiB = 1u << 20;
constexpr size_t WS_STATS = 0;
constexpr size_t WS_AGG = 256 * 1024;
constexpr size_t WS_BAR = 512 * 1024;
constexpr size_t WS_SS1 = 1 * MiB;
constexpr size_t WS_SS2 = WS_SS1 + 512 * 1024;
constexpr size_t WS_PCNT = 2 * MiB;
constexpr size_t WS_LFLAG = WS_PCNT + 16384;
constexpr size_t WS_PCNT2 = WS_LFLAG + 16384;
constexpr size_t WS_ZERO_END = WS_PCNT2 + 16384;
constexpr size_t WS_WIN = 3 * MiB;
constexpr size_t WS_WP = 83 * MiB;
constexpr size_t WS_WOUT = 107 * MiB;
constexpr size_t WS_WLRU = 115 * MiB;
constexpr size_t WS_WG = 117 * MiB;
constexpr size_t WS_KM = 118 * MiB;
constexpr size_t WS_VT = 134 * MiB;
constexpr size_t WS_H = 150 * MiB;
constexpr size_t WS_Z = 182 * MiB;
constexpr size_t ZSLOT = (size_t)TC * D * 2;
constexpr size_t WS_WKV = WS_Z;
constexpr size_t WS_MEMN = WS_Z + 16 * MiB;
constexpr size_t WS_LAU = WS_Z + 10 * ZSLOT;
constexpr size_t WS_LNP = WS_LAU + 2 * ZSLOT;
constexpr size_t WS_END = WS_LNP + (size_t)TC * 128;

constexpr int LDS_BYTES = 147456;

typedef __bf16 bf16x2_t __attribute__((ext_vector_type(2)));
__device__ __forceinline__ unsigned cvt_pk_bf16(float lo, float hi) { const f32x2 v = {lo, hi}; return __builtin_bit_cast(unsigned, __builtin_convertvector(v, bf16x2_t)); }
__device__ __forceinline__ float bflo(unsigned w) { return __uint_as_float(w << 16); }
__device__ __forceinline__ float bfhi(unsigned w) { return __uint_as_float(w & 0xffff0000u); }
__device__ __forceinline__ float bf1(bf16_t b) { return __uint_as_float(((unsigned)b) << 16); }
__device__ __forceinline__ bf16_t f2bf(float f) { return (bf16_t)(cvt_pk_bf16(f, 0.f) & 0xffffu); }
__device__ __forceinline__ float wave_sum(float v) {
#pragma unroll
    for (int o = 1; o < 64; o <<= 1) v += __shfl_xor(v, o);
    return v;
}
__device__ __forceinline__ int otid() { int t = threadIdx.x; asm volatile("" : "+v"(t)); return t; }
#define GAS __attribute__((address_space(1)))
template <class T> __device__ __forceinline__ T* asglobal(T* p) { return (T*)(GAS T*)p; }
__device__ __forceinline__ unsigned char* ows(unsigned char* w) { GAS unsigned char* g = (GAS unsigned char*)w; asm volatile("" : "+s"(g)); return (unsigned char*)g; }
__device__ __forceinline__ int obid() { int t = blockIdx.x; asm volatile("" : "+s"(t)); return t; }
__device__ __forceinline__ int ogrid() { int t = gridDim.x; asm volatile("" : "+s"(t)); return t; }
__device__ __forceinline__ float frcp(float x) { return __builtin_amdgcn_rcpf(x); }
__device__ __forceinline__ float fexp(float x) { return __builtin_amdgcn_exp2f(x * 1.44269504089f); }
__device__ __forceinline__ float sigm(float x) { return frcp(1.0f + fexp(-x)); }
__device__ __forceinline__ float silu(float x) { return x * frcp(1.0f + fexp(-x)); }
__device__ __forceinline__ float one_minus_exp(float x, float e, float w) {
    float q = 1.0f + x * (1.0f / 7.0f); q = 1.0f + x * (1.0f / 6.0f) * q; q = 1.0f + x * 0.2f * q; q = 1.0f + x * 0.25f * q; q = 1.0f + x * (1.0f / 3.0f) * q; q = 1.0f + x * 0.5f * q;
    const float d = 1.0f - e;
    return d + w * (-x * q - d);
}

namespace pg8 {
constexpr int BM = 256, BK = 64, HALF = 128, HTB = HALF * BK * 2, STAGE_BYTES = 8 * HTB, NXCD = 8, WGM = 8;
__host__ __device__ __forceinline__ int lds_byte(int r, int c) { const int st = (r >> 4) * 2 + (c >> 5), rr = r & 15, cc = c & 31, ob = rr * 64 + cc * 2; return st * 1024 + (ob ^ (((ob >> 9) & 1) << 5)); }
__host__ __device__ __forceinline__ void stage_rc(int b, int& R, int& C) { const int st = b / 1024, sb = b % 1024, swz = sb ^ (((sb >> 9) & 1) << 5); R = (st >> 1) * 16 + swz / 64; C = (st & 1) * 32 + (swz % 64) / 2; }
__host__ __device__ __forceinline__ int perm32(int rho) { const int n = rho >> 4, i = rho & 15; return 8 * (i >> 2) + 4 * n + (i & 3); }

struct Unit { const char* A; const char* B; int r0, c0, aux; };

template <class Epi, class Sched, bool ALIGN_EPI>
__device__ __forceinline__ void gemm_phase(LAS unsigned char* lds, const int K, const Sched& S, const Epi& E) {
    const int tid = otid(), wid = __builtin_amdgcn_readfirstlane(tid >> 6), lane = tid & 63, wr = wid >> 2, wc = wid & 3, fr = lane & 15, fq = lane >> 4;
    const int nt = K / BK;
    unsigned voffA[2], voffB[2];
#pragma unroll
    for (int i = 0; i < 2; ++i) { int R, C; stage_rc(tid * 16 + i * 8192, R, C); const int Rb = Epi::PERM ? ((R >> 5) * 64 + perm32(R & 31)) : R;
        voffA[i] = (unsigned)(R * K + C) * 2u; voffB[i] = (unsigned)(Rb * K + C) * 2u; }
    const size_t kstep = (size_t)(BK * 2);
    const size_t hstep = (size_t)HALF * K * 2;
    const size_t hstepB = Epi::PERM ? (size_t)32 * K * 2 : hstep;
    const unsigned ldsw = (unsigned)wid * 1024u;
    const int aoff = lds_byte(wr * 64 + fr, fq * 8), boff = lds_byte(wc * 32 + fr, fq * 8);
#define PG8_SA(b, h) (((b) * 2 + (h)) * HTB)
#define PG8_SB(b, h) ((4 + (b) * 2 + (h)) * HTB)
#define PG8_STAGE(bufoff, gbase, voff) do { _Pragma("unroll") for (int _i = 0; _i < 2; ++_i) \
        __builtin_amdgcn_global_load_lds((const unsigned*)((const char*)(gbase) + (voff)[_i]), (LAS unsigned*)(lds + (bufoff) + ldsw + _i * 8192), 16, 0, 0); } while (0)
#define PG8_LDA(dst, b, h) do { _Pragma("unroll") for (int m = 0; m < 4; ++m) _Pragma("unroll") for (int k = 0; k < 2; ++k) dst[m][k] = *(const LAS bf16x8*)(lds + PG8_SA(b, h) + aoff + m * 2048 + k * 1024); } while (0)
#define PG8_LDB(dst, b, h) do { _Pragma("unroll") for (int n = 0; n < 2; ++n) _Pragma("unroll") for (int k = 0; k < 2; ++k) dst[n][k] = *(const LAS bf16x8*)(lds + PG8_SB(b, h) + boff + n * 2048 + k * 1024); } while (0)
#define PG8_MMA(ai, bj, At, Bt) do { __builtin_amdgcn_s_setprio(1); _Pragma("unroll") for (int m = 0; m < 4; ++m) _Pragma("unroll") for (int n = 0; n < 2; ++n) _Pragma("unroll") for (int k = 0; k < 2; ++k) \
        acc[ai][bj][m][n] = __builtin_amdgcn_mfma_f32_16x16x32_bf16(Bt[n][k], At[m][k], acc[ai][bj][m][n], 0, 0, 0); __builtin_amdgcn_s_setprio(0); } while (0)
#define PG8_WAIT_V(n) asm volatile("s_waitcnt vmcnt(" #n ")" ::: "memory")
#define PG8_WAIT_L(n) asm volatile("s_waitcnt lgkmcnt(" #n ")" ::: "memory")
#define PG8_BAR __builtin_amdgcn_s_barrier()
#define PG8_SCHED __builtin_amdgcn_sched_barrier(0)
    Unit cur, nxt; int ui = 0;
    if (!S.next(0, cur)) return;
    f32x4 acc[2][2][4][2];
#pragma unroll
    for (int a = 0; a < 2; ++a)
#pragma unroll
        for (int b = 0; b < 2; ++b)
#pragma unroll
            for (int m = 0; m < 4; ++m)
#pragma unroll
                for (int n = 0; n < 2; ++n) acc[a][b][m][n] = (f32x4){0.f, 0.f, 0.f, 0.f};
    bf16x8 At[4][2], B0[2][2], B1[2][2];
    const char* cA = cur.A; const char* cB = cur.B;
    PG8_STAGE(PG8_SB(0, 0), cB, voffB); PG8_STAGE(PG8_SB(0, 1), cB + hstepB, voffB); PG8_STAGE(PG8_SA(0, 0), cA, voffA); PG8_STAGE(PG8_SA(0, 1), cA + hstep, voffA);
    if (wr == 1) PG8_BAR;
    PG8_WAIT_V(2); PG8_BAR;
    PG8_STAGE(PG8_SB(1, 0), cB + kstep, voffB); PG8_STAGE(PG8_SA(1, 0), cA + kstep, voffA); PG8_STAGE(PG8_SB(1, 1), cB + hstepB + kstep, voffB);
    PG8_WAIT_V(6); PG8_BAR;
    for (;;) {
        const bool has_next = S.next(ui + 1, nxt);
        const char* nA = has_next ? nxt.A : cA; const char* nB = has_next ? nxt.B : cB;
        for (int t = 0; t < nt; t += 2) {
            const bool last = (t == nt - 2);
            const char* a1 = cA + (size_t)(t + 1) * kstep;
            const char* a2 = last ? nA : cA + (size_t)(t + 2) * kstep; const char* b2 = last ? nB : cB + (size_t)(t + 2) * kstep;
            const char* a3 = a2 + kstep; const char* b3 = b2 + kstep;
            PG8_LDB(B0, 0, 0); PG8_LDB(B1, 0, 1); PG8_SCHED; PG8_LDA(At, 0, 0); PG8_STAGE(PG8_SA(1, 1), a1 + hstep, voffA);
            PG8_WAIT_V(8); PG8_WAIT_L(0); PG8_BAR; PG8_MMA(0, 0, At, B0); PG8_MMA(0, 1, At, B1); PG8_BAR; PG8_SCHED;
            PG8_LDA(At, 0, 1); PG8_STAGE(PG8_SB(0, 0), b2, voffB); PG8_STAGE(PG8_SB(0, 1), b2 + hstepB, voffB); PG8_STAGE(PG8_SA(0, 0), a2, voffA);
            PG8_WAIT_V(8); PG8_WAIT_L(0); PG8_BAR; PG8_MMA(1, 0, At, B0); PG8_MMA(1, 1, At, B1); PG8_BAR; PG8_SCHED;
            PG8_LDB(B0, 1, 0); PG8_LDB(B1, 1, 1); PG8_SCHED; PG8_LDA(At, 1, 0); PG8_STAGE(PG8_SA(0, 1), a2 + hstep, voffA);
            PG8_WAIT_V(8); PG8_WAIT_L(0); PG8_BAR; PG8_MMA(0, 0, At, B0); PG8_MMA(0, 1, At, B1); PG8_BAR; PG8_SCHED;
            PG8_LDA(At, 1, 1); PG8_STAGE(PG8_SB(1, 0), b3, voffB); PG8_STAGE(PG8_SB(1, 1), b3 + hstepB, voffB); PG8_STAGE(PG8_SA(1, 0), a3, voffA);
            PG8_WAIT_V(8); PG8_WAIT_L(0); PG8_BAR; PG8_MMA(1, 0, At, B0); PG8_MMA(1, 1, At, B1); PG8_BAR; PG8_SCHED;
        }
        if constexpr (ALIGN_EPI) { if (wr == 0) PG8_BAR; }
        bool zero = true;
        if constexpr (!Epi::AFTER_DRAIN) zero = E(acc, cur, wr, wc, fr, fq);
        if (!has_next) break;
        if (zero) {
#pragma unroll
            for (int a = 0; a < 2; ++a)
#pragma unroll
                for (int b = 0; b < 2; ++b)
#pragma unroll
                    for (int m = 0; m < 4; ++m)
#pragma unroll
                        for (int n = 0; n < 2; ++n) acc[a][b][m][n] = (f32x4){0.f, 0.f, 0.f, 0.f};
        }
        cur = nxt; cA = nA; cB = nB; ++ui;
        if constexpr (ALIGN_EPI) { if (wr == 1) PG8_BAR; }
    }
    PG8_WAIT_V(0);
    if constexpr (!ALIGN_EPI) { if (wr == 0) PG8_BAR; }
    PG8_BAR;
    if constexpr (Epi::AFTER_DRAIN) E.fused(acc, cur, wr, wc, fr, fq, lds, wid, lane);
#undef PG8_SA
#undef PG8_SB
#undef PG8_STAGE
#undef PG8_LDA
#undef PG8_LDB
#undef PG8_MMA
#undef PG8_WAIT_V
#undef PG8_WAIT_L
#undef PG8_BAR
#undef PG8_SCHED
}

struct EpiBf16 {
    static constexpr bool PERM = true, AFTER_DRAIN = false;
    bf16_t* O; int ldc; size_t split_stride; int split; const float* rowss; float* lnp;
    __device__ __forceinline__ bool operator()(f32x4 (&acc)[2][2][4][2], const Unit& u, int wr, int wc, int fr, int fq) const {
        const int row0 = u.r0 + wr * 64 + fr, pn = u.c0 >> 8;
        const bool paired = pn < 8, vtile = (pn >> 2) == 2;
        const int slot = paired ? 0 : (pn < 12 ? 1 : (pn >> 2));
        bf16_t* base = O + (size_t)slot * split_stride;
        const int col0 = paired ? (pn * 128 + wc * 32 + 8 * fq) : ((pn & 3) * 256 + wc * 64 + 8 * fq);
#pragma unroll
        for (int ai = 0; ai < 2; ++ai)
#pragma unroll
            for (int m = 0; m < 4; ++m) { bf16_t* rowp = base + (size_t)(row0 + ai * HALF + m * 16) * ldc + col0;
                float rs = 1.0f; if (rowss) { const f32x4 q = *(const f32x4*)(rowss + (size_t)(row0 + ai * HALF + m * 16) * 4); rs = __builtin_amdgcn_rsqf((((q.x + q.y) + q.z) + q.w) * (1.0f / D) + EPS); }
                if (paired) {
                    const f32x4 u0 = acc[ai][0][m][0] * rs, u1 = acc[ai][0][m][1] * rs, g0 = acc[ai][1][m][0] * rs, g1 = acc[ai][1][m][1] * rs;
                    u32x4 w; w.x = cvt_pk_bf16(u0[0] * silu(g0[0]), u0[1] * silu(g0[1])); w.y = cvt_pk_bf16(u0[2] * silu(g0[2]), u0[3] * silu(g0[3]));
                    w.z = cvt_pk_bf16(u1[0] * silu(g1[0]), u1[1] * silu(g1[1])); w.w = cvt_pk_bf16(u1[2] * silu(g1[2]), u1[3] * silu(g1[3]));
                    *(u32x4*)rowp = w;
                } else {
                    float ls = 0.f, lq = 0.f;
#pragma unroll
                    for (int bj = 0; bj < 2; ++bj) { const f32x4 v0 = acc[ai][bj][m][0] * rs, v1 = acc[ai][bj][m][1] * rs;
                        if (vtile) { ls += ((v0[0] + v0[1]) + (v0[2] + v0[3])) + ((v1[0] + v1[1]) + (v1[2] + v1[3]));
                            lq += ((v0[0] * v0[0] + v0[1] * v0[1]) + (v0[2] * v0[2] + v0[3] * v0[3])) + ((v1[0] * v1[0] + v1[1] * v1[1]) + (v1[2] * v1[2] + v1[3] * v1[3])); }
                        u32x4 w; w.x = cvt_pk_bf16(v0[0], v0[1]); w.y = cvt_pk_bf16(v0[2], v0[3]); w.z = cvt_pk_bf16(v1[0], v1[1]); w.w = cvt_pk_bf16(v1[2], v1[3]);
                        *(u32x4*)(rowp + bj * 32) = w; }
                    if (vtile) {
                        ls += __shfl_xor(ls, 16); ls += __shfl_xor(ls, 32); lq += __shfl_xor(lq, 16); lq += __shfl_xor(lq, 32);
                        if (fq == 0) *(f32x2*)(lnp + ((size_t)(row0 + ai * HALF + m * 16) * 16 + (pn & 3) * 4 + wc) * 2) = (f32x2){ls, lq}; } } }
        return true;
    }
};
struct EpiKV {
    static constexpr bool PERM = true, AFTER_DRAIN = false;
    bf16_t* KM; bf16_t* VT;
    __device__ __forceinline__ bool operator()(f32x4 (&acc)[2][2][4][2], const Unit& u, int wr, int wc, int fr, int fq) const {
        const int l = u.aux >> 1, isv = u.aux & 1; const int ldc = isv ? MROWS : D;
        bf16_t* base = (isv ? VT : KM) + (size_t)l * MROWS * D;
        const int row0 = u.r0 + wr * 64 + fr, col0 = u.c0 + wc * 64 + 8 * fq;
#pragma unroll
        for (int ai = 0; ai < 2; ++ai)
#pragma unroll
            for (int m = 0; m < 4; ++m) { bf16_t* rowp = base + (size_t)(row0 + ai * HALF + m * 16) * ldc + col0;
#pragma unroll
                for (int bj = 0; bj < 2; ++bj) { const f32x4 v0 = acc[ai][bj][m][0], v1 = acc[ai][bj][m][1];
                    u32x4 w; w.x = cvt_pk_bf16(v0[0], v0[1]); w.y = cvt_pk_bf16(v0[2], v0[3]); w.z = cvt_pk_bf16(v1[0], v1[1]); w.w = cvt_pk_bf16(v1[2], v1[3]);
                    *(u32x4*)(rowp + bj * 32) = w; } }
        return true;
    }
};
struct EpiF32 {
    static constexpr bool PERM = false, AFTER_DRAIN = false;
    float* C;
    __device__ __forceinline__ bool operator()(f32x4 (&acc)[2][2][4][2], const Unit& u, int wr, int wc, int fr, int fq) const {
        const int row0 = u.r0 + wr * 64 + fr, col0 = u.c0 + wc * 32 + 4 * fq;
#pragma unroll
        for (int ai = 0; ai < 2; ++ai)
#pragma unroll
            for (int m = 0; m < 4; ++m) { float* rowp = C + (size_t)(row0 + ai * HALF + m * 16) * D + col0;
#pragma unroll
                for (int bj = 0; bj < 2; ++bj)
#pragma unroll
                    for (int n = 0; n < 2; ++n) *(f32x4*)(rowp + bj * HALF + n * 16) = acc[ai][bj][m][n]; }
        return true;
    }
};

struct EpiOutNorm {
    static constexpr bool PERM = false, AFTER_DRAIN = true;
    const float* xsrc; float* xdst; bf16_t* H; const float* gpost; const float* gpre; float* slot1; float* slot2; unsigned* cnt; unsigned want; unsigned* cnt2; unsigned want2;
    __device__ __forceinline__ bool operator()(f32x4 (&acc)[2][2][4][2], const Unit& u, int wr, int wc, int fr, int fq) const { return true; }
    __device__ __forceinline__ void exchange(LAS float* P, float* slot, unsigned* pcnt, unsigned wnt, const Unit& u, int pn, int tid, int wid, int lane) const {
        asm volatile("s_waitcnt lgkmcnt(0)" ::: "memory"); __builtin_amdgcn_s_barrier(); asm volatile("" ::: "memory");
        if (tid < 256) { const f32x4 q = *(const LAS f32x4*)(P + tid * 4); __hip_atomic_store(slot + (size_t)(u.r0 + tid) * 4 + pn, ((q.x + q.y) + q.z) + q.w, __ATOMIC_RELAXED, __HIP_MEMORY_SCOPE_AGENT); }
        asm volatile("s_waitcnt vmcnt(0) lgkmcnt(0)" ::: "memory"); __builtin_amdgcn_s_barrier(); asm volatile("" ::: "memory");
        unsigned* pc = pcnt + 64 * (u.r0 >> 8);
        if (wid == 0) {
            if (lane == 0) __hip_atomic_fetch_add(pc, 1u, __ATOMIC_RELAXED, __HIP_MEMORY_SCOPE_AGENT);
            unsigned sp = 0;
            while ((unsigned)__builtin_amdgcn_readfirstlane(__hip_atomic_load(pc, __ATOMIC_RELAXED, __HIP_MEMORY_SCOPE_AGENT)) < wnt) { __builtin_amdgcn_s_sleep(1); if (++sp > (1u << 22)) break; }
            __builtin_amdgcn_fence(__ATOMIC_ACQUIRE, "agent");
            asm volatile("s_waitcnt vmcnt(0)" ::: "memory"); }
        asm volatile("" ::: "memory"); __builtin_amdgcn_s_barrier(); asm volatile("" ::: "memory");
    }
    __device__ __forceinline__ float rowscale(const float* slot, int row) const {
        const float t0 = __hip_atomic_load(slot + (size_t)row * 4 + 0, __ATOMIC_RELAXED, __HIP_MEMORY_SCOPE_AGENT), t1 = __hip_atomic_load(slot + (size_t)row * 4 + 1, __ATOMIC_RELAXED, __HIP_MEMORY_SCOPE_AGENT),
                    t2 = __hip_atomic_load(slot + (size_t)row * 4 + 2, __ATOMIC_RELAXED, __HIP_MEMORY_SCOPE_AGENT), t3 = __hip_atomic_load(slot + (size_t)row * 4 + 3, __ATOMIC_RELAXED, __HIP_MEMORY_SCOPE_AGENT);
        return __builtin_amdgcn_rsqf((((t0 + t1) + t2) + t3) * (1.0f / D) + EPS);
    }
    __device__ __forceinline__ void fused(f32x4 (&acc)[2][2][4][2], const Unit& u, int wr, int wc, int fr, int fq, LAS unsigned char* lds, int wid, int lane) const {
        const int row0 = u.r0 + wr * 64 + fr, col0 = u.c0 + wc * 32 + 4 * fq, pn = u.c0 >> 8, tid = wid * 64 + lane;
        LAS float* P = (LAS float*)lds;
#pragma unroll
        for (int ai = 0; ai < 2; ++ai)
#pragma unroll
            for (int m = 0; m < 4; ++m) { float sq = 0.f;
#pragma unroll
                for (int bj = 0; bj < 2; ++bj)
#pragma unroll
                    for (int n = 0; n < 2; ++n) { const f32x4 v = acc[ai][bj][m][n]; sq += (v[0] * v[0] + v[1] * v[1]) + (v[2] * v[2] + v[3] * v[3]); }
                sq += __shfl_xor(sq, 16); sq += __shfl_xor(sq, 32);
                if (fq == 0) P[(ai * HALF + wr * 64 + m * 16 + fr) * 4 + wc] = sq; }
        exchange(P, slot1, cnt, want, u, pn, tid, wid, lane);
        f32x4 gp[2][2];
#pragma unroll
        for (int bj = 0; bj < 2; ++bj)
#pragma unroll
            for (int n = 0; n < 2; ++n) gp[bj][n] = *(const f32x4*)(gpost + col0 + bj * HALF + n * 16);
#pragma unroll
        for (int ai = 0; ai < 2; ++ai)
#pragma unroll
            for (int m = 0; m < 4; ++m) { const int row = row0 + ai * HALF + m * 16; const size_t off = (size_t)row * D + col0;
                const float r1 = rowscale(slot1, row);
                float s2 = 0.f;
#pragma unroll
                for (int bj = 0; bj < 2; ++bj)
#pragma unroll
                    for (int n = 0; n < 2; ++n) { const f32x4 xv = *(const f32x4*)(xsrc + off + bj * HALF + n * 16);
                        const f32x4 xn = xv + acc[ai][bj][m][n] * r1 * gp[bj][n];
                        *(f32x4*)(xdst + off + bj * HALF + n * 16) = xn; acc[ai][bj][m][n] = xn;
                        s2 += (xn[0] * xn[0] + xn[1] * xn[1]) + (xn[2] * xn[2] + xn[3] * xn[3]); }
                s2 += __shfl_xor(s2, 16); s2 += __shfl_xor(s2, 32);
                if (fq == 0) P[(ai * HALF + wr * 64 + m * 16 + fr) * 4 + wc] = s2;
                asm volatile("" ::: "memory"); }
        if (H) {
            exchange(P, slot2, cnt2, want2, u, pn, tid, wid, lane);
#pragma unroll
            for (int bj = 0; bj < 2; ++bj)
#pragma unroll
                for (int n = 0; n < 2; ++n) gp[bj][n] = *(const f32x4*)(gpre + col0 + bj * HALF + n * 16);
#pragma unroll
            for (int ai = 0; ai < 2; ++ai)
#pragma unroll
                for (int m = 0; m < 4; ++m) { const int row = row0 + ai * HALF + m * 16; const size_t off = (size_t)row * D + col0;
                    const float r2 = rowscale(slot2, row);
#pragma unroll
                    for (int bj = 0; bj < 2; ++bj)
#pragma unroll
                        for (int n = 0; n < 2; ++n) { const f32x4 a = acc[ai][bj][m][n] * r2 * gp[bj][n]; u32x2 w; w.x = cvt_pk_bf16(a[0], a[1]); w.y = cvt_pk_bf16(a[2], a[3]); *(u32x2*)(H + off + bj * HALF + n * 16) = w; } } }
    }
};
struct EpiMerge {
    static constexpr bool PERM = true, AFTER_DRAIN = false;
    const bf16_t* ML;
    bf16_t* O;
    __device__ __forceinline__ bool operator()(f32x4 (&acc)[2][2][4][2], const Unit& u, int wr, int wc, int fr, int fq) const {
        const int sub = u.aux;
        const int row0 = u.r0 + wr * 64 + fr, col0 = u.c0 + wc * 64 + 8 * fq;
        const bf16_t* l0 = ML + (size_t)sub * TC * D;
#pragma unroll
        for (int ai = 0; ai < 2; ++ai)
#pragma unroll
            for (int m = 0; m < 4; ++m) { const size_t off = (size_t)(row0 + ai * HALF + m * 16) * D + col0;
#pragma unroll
                for (int bj = 0; bj < 2; ++bj) {
                    const u32x4 a = *(const u32x4*)(l0 + off + bj * 32);
                    float la[8] = {bflo(a.x), bfhi(a.x), bflo(a.y), bfhi(a.y), bflo(a.z), bfhi(a.z), bflo(a.w), bfhi(a.w)};
                    float f[8];
                    if (sub < 2) {
                        const u32x4 b = *(const u32x4*)(l0 + (size_t)TC * D + off + bj * 32);
                        float lb[8] = {bflo(b.x), bfhi(b.x), bflo(b.y), bfhi(b.y), bflo(b.z), bfhi(b.z), bflo(b.w), bfhi(b.w)};
#pragma unroll
                        for (int j = 0; j < 8; ++j) { const float ea = fexp(-fminf(fmaxf(la[j], -60.f), 60.f)), eb = fexp(-fminf(fmaxf(lb[j], -60.f), 60.f)); f[j] = (1.0f + eb) * frcp(1.0f + ea); }
                    } else {
#pragma unroll
                        for (int j = 0; j < 8; ++j) f[j] = frcp(1.0f + fexp(-fminf(fmaxf(la[j], -60.f), 60.f)));
                    }
                    f32x4 v0 = acc[ai][bj][m][0], v1 = acc[ai][bj][m][1];
                    v0[0] *= f[0]; v0[1] *= f[1]; v0[2] *= f[2]; v0[3] *= f[3]; v1[0] *= f[4]; v1[1] *= f[5]; v1[2] *= f[6]; v1[3] *= f[7];
                    if (sub < 2) { acc[ai][bj][m][0] = v0; acc[ai][bj][m][1] = v1; }
                    else { u32x4 w; w.x = cvt_pk_bf16(v0[0], v0[1]); w.y = cvt_pk_bf16(v0[2], v0[3]); w.z = cvt_pk_bf16(v1[0], v1[1]); w.w = cvt_pk_bf16(v1[2], v1[3]);
                        *(u32x4*)(O + off + bj * 32) = w; }
                } }
        return sub == 2;
    }
};

struct SchedGrid {
    const char* A; const char* B; int nM, nN, nwg, G, c; size_t tstep;
    __device__ __forceinline__ bool next(int i, Unit& u) const {
        const long L = (long)i * G + c; if (L >= nwg) return false;
        int wgid = (int)L; { const int q = nwg / NXCD, r = nwg % NXCD, xcd = wgid % NXCD, off = wgid / NXCD; wgid = (xcd < r ? xcd * (q + 1) : r * (q + 1) + (xcd - r) * q) + off; }
        const int nig = WGM * nN, gid = wgid / nig, fm = gid * WGM, gsz = (nM - fm) < WGM ? (nM - fm) : WGM;
        const int pm = fm + ((wgid % nig) % gsz), pn = (wgid % nig) / gsz;
        u.A = A + (size_t)pm * tstep; u.B = B + (size_t)pn * tstep; u.r0 = pm * BM; u.c0 = pn * BM; u.aux = 0; return true;
    }
};
struct SchedKV {
    const char* MEMN; const char* WKV; int G, c;
    __device__ __forceinline__ bool next(int i, Unit& u) const {
        const int id = i * G + c; if (id >= 256) return false;
        const size_t tstep = (size_t)BM * D * 2;
        const int l = id >> 6, r = id & 63; const char* w = WKV + (size_t)l * 2048 * D * 2;
        if (r < 32) { const int pm = r >> 2, pn = r & 3; u.A = MEMN + pm * tstep; u.B = w + pn * tstep; u.r0 = pm * BM; u.c0 = pn * BM; u.aux = l << 1; }
        else { const int rr = r - 32, pm = rr >> 3, pn = rr & 7; u.A = w + (size_t)(4 + pm) * tstep; u.B = MEMN + pn * tstep; u.r0 = pm * BM; u.c0 = pn * BM; u.aux = (l << 1) | 1; }
        return true;
    }
};
struct SchedMerge {
    const char* Z; const char* WP; int G, c;
    __device__ __forceinline__ bool next(int i, Unit& u) const {
        const int tile = (i / 3) * G + c, sub = i % 3; if (tile >= (TC / BM) * 4) return false;
        const size_t tstep = (size_t)BM * D * 2;
        const int pm = tile >> 2, pn = tile & 3; const int slot = sub == 0 ? 0 : (sub == 1 ? 4 : 6);
        u.A = Z + (size_t)slot * ZSLOT + pm * tstep; u.B = WP + (size_t)sub * D * D * 2 + pn * tstep; u.r0 = pm * BM; u.c0 = pn * BM; u.aux = sub; return true;
    }
};
}

struct Params { const float* in[22]; float* out; unsigned char* ws; int ph_lo, ph_hi; };
typedef const __attribute__((address_space(4))) Params* KP;
enum { I_X = 0, I_MEM, I_MEMG, I_PREG, I_POSTG, I_WIN, I_LNG, I_LNB, I_WS, I_BS, I_CONVW, I_CONVB, I_WR, I_BR, I_WI, I_BI, I_LAM, I_WKV, I_WPA, I_WPB, I_WPC, I_WOUT };

__device__ __forceinline__ void transpose_item(const float* W, int ldw, bf16_t* WT, int ldt, int nblk, LAS float* scr, int item, int lane, bool remap = false) {
    const int kb = item / nblk, nb = item % nblk, k0 = 64 * kb, n0 = 32 * nb;
    int dn0 = n0;
    if (remap) { if (n0 < 1024) dn0 = ((n0 >> 7) * 8 + ((n0 >> 5) & 3) * 2) * 32; else if (n0 < 2048) dn0 = n0 + 1024; else if (n0 < 3072) { const int ch = n0 - 2048; dn0 = ((ch >> 7) * 8 + ((ch >> 5) & 3) * 2 + 1) * 32; } }
#pragma unroll 8
    for (int i = 0; i < 32; ++i) { const int kk = 2 * i + (lane >> 5); scr[kk * 33 + (lane & 31)] = W[(size_t)(k0 + kk) * ldw + n0 + (lane & 31)]; }
    asm volatile("s_waitcnt lgkmcnt(0)" ::: "memory");
    const int c = lane & 7;
#pragma unroll
    for (int j = 0; j < 4; ++j) { const int n = (lane >> 3) + 8 * j; const LAS float* s = scr + (8 * c) * 33 + n;
        u32x4 o; o.x = cvt_pk_bf16(s[0 * 33], s[1 * 33]); o.y = cvt_pk_bf16(s[2 * 33], s[3 * 33]); o.z = cvt_pk_bf16(s[4 * 33], s[5 * 33]); o.w = cvt_pk_bf16(s[6 * 33], s[7 * 33]);
        *(u32x4*)(WT + (size_t)(dn0 + n) * ldt + k0 + 8 * c) = o; }
    asm volatile("s_waitcnt lgkmcnt(0)" ::: "memory");
}
__device__ __forceinline__ void rms_row_to_bf16(const float* xrow, const float* g, bf16_t* orow, int lane) {
    const f32x4* xr = (const f32x4*)xrow + lane; const f32x4* gr = (const f32x4*)g + lane;
    f32x4 v[4]; float s = 0.f;
#pragma unroll
    for (int j = 0; j < 4; ++j) { v[j] = xr[64 * j]; s += (v[j].x * v[j].x + v[j].y * v[j].y) + (v[j].z * v[j].z + v[j].w * v[j].w); }
    const float r = __builtin_amdgcn_rsqf(wave_sum(s) * (1.0f / D) + EPS);
    u32x2* o8 = (u32x2*)orow + lane;
#pragma unroll
    for (int j = 0; j < 4; ++j) { const f32x4 gv = gr[64 * j]; u32x2 w; w.x = cvt_pk_bf16(v[j].x * r * gv.x, v[j].y * r * gv.y); w.y = cvt_pk_bf16(v[j].z * r * gv.z, v[j].w * r * gv.w); o8[64 * j] = w; }
}
__device__ __forceinline__ void row_to_aprime(const float* xrow, const float* g, bf16_t* orow, float* ss, int lane) {
    const f32x4* xr = (const f32x4*)xrow + lane; const f32x4* gr = (const f32x4*)g + lane;
    f32x4 v[4]; float s = 0.f;
#pragma unroll
    for (int j = 0; j < 4; ++j) { v[j] = xr[64 * j]; s += (v[j].x * v[j].x + v[j].y * v[j].y) + (v[j].z * v[j].z + v[j].w * v[j].w); }
    s = wave_sum(s);
    u32x2* o8 = (u32x2*)orow + lane;
#pragma unroll
    for (int j = 0; j < 4; ++j) { const f32x4 gv = gr[64 * j]; u32x2 w; w.x = cvt_pk_bf16(v[j].x * gv.x, v[j].y * gv.y); w.y = cvt_pk_bf16(v[j].z * gv.z, v[j].w * gv.w); o8[64 * j] = w; }
    if (lane == 0) *(f32x4*)ss = (f32x4){s, 0.f, 0.f, 0.f};
}
__device__ __forceinline__ void phase_prologue(KP p, LAS unsigned char* lds) {
    const int tid = otid(), lane = tid & 63, wave = tid >> 6;
    const int gw = obid() * 8 + wave, NGW = ogrid() * 8;
    LAS float* scr = (LAS float*)(lds + wave * 16384);
    unsigned char* ws = ows(p->ws);
    constexpr int PER_L = 5120 + 1024 + 4 * 512 + 128;
    for (int it = gw; it < DEPTH * PER_L; it += NGW) {
        const int l = it / PER_L; int r = it % PER_L;
        if (r < 5120) { transpose_item(asglobal(p->in[I_WIN]) + (size_t)l * D * INW, INW, (bf16_t*)(ws + WS_WIN) + (size_t)l * INW * D, D, INW / 32, scr, r, lane, true); continue; } r -= 5120;
        if (r < 1024) { transpose_item(asglobal(p->in[I_WKV]) + (size_t)l * D * 2048, 2048, (bf16_t*)(ws + WS_WKV) + (size_t)l * 2048 * D, D, 64, scr, r, lane); continue; } r -= 1024;
        if (r < 1536) { const int b = r / 512; transpose_item(asglobal(p->in[I_WPA + b]) + (size_t)l * D * D, D, (bf16_t*)(ws + WS_WP) + (size_t)(l * 3 + b) * D * D, D, 32, scr, r % 512, lane); continue; } r -= 1536;
        if (r < 512) { transpose_item(asglobal(p->in[I_WOUT]) + (size_t)l * D * D, D, (bf16_t*)(ws + WS_WOUT) + (size_t)l * D * D, D, 32, scr, r, lane); continue; } r -= 512;
        { const int ri = r >> 6, h = (r >> 3) & 7, sub = r & 7;
          transpose_item(asglobal(p->in[ri ? I_WI : I_WR]) + (size_t)(l * 8 + h) * 128 * 128, 128, (bf16_t*)(ws + WS_WLRU) + ((size_t)(l * 8 + h) * 256 + ri * 128) * 128, 128, 4, scr, sub, lane); }
    }
    { const float* W = asglobal(p->in[I_WS]); bf16_t* O = (bf16_t*)(ws + WS_WG);
      for (int i4 = obid() * NTHR + tid; i4 < DEPTH * 8 * 128 * 128 / 4; i4 += ogrid() * NTHR) {
          const int e = i4 * 4, j = e & 127, i = (e >> 7) & 127; f32x4 v = *(const f32x4*)(W + e);
          if (i < 64 && j >= 64) v = (f32x4){0.f, 0.f, 0.f, 0.f};
          u32x2 w; w.x = cvt_pk_bf16(v.x, v.y); w.y = cvt_pk_bf16(v.z, v.w); *(u32x2*)(O + e) = w; } }
    for (int m = gw; m < MROWS; m += NGW) rms_row_to_bf16(asglobal(p->in[I_MEM]) + (size_t)m * D, asglobal(p->in[I_MEMG]), (bf16_t*)(ws + WS_MEMN) + (size_t)m * D, lane);
    for (int m = gw; m < TC; m += NGW) rms_row_to_bf16(asglobal(p->in[I_X]) + (size_t)m * D, asglobal(p->in[I_PREG]), (bf16_t*)(ws + WS_H) + (size_t)m * D, lane);
}

__device__ __forceinline__ int crow(int reg, int h) { return (reg & 3) + 8 * (reg >> 2) + 4 * h; }
constexpr int LR_XB = 0, LR_XA = 17408, LR_UA = 34816, LR_UU = 67584, LR_SEG = 100352, LR_CAR = 104448, LR_CW = 106496, LR_END = 109568;
template <int PASS>
__device__ __forceinline__ void lru_item(KP p, LAS unsigned char* lds, int l, int item, unsigned pass_tag) {
    const int tid = otid(), lane = tid & 63, wave = tid >> 6, l31 = lane & 31, hh = lane >> 5;
    const int e8 = item & 7, head = (item >> 3) & 7, bl = item >> 6;
    unsigned char* ws = ows(p->ws);
    bf16_t* zxb = (bf16_t*)(ws + WS_Z + 3 * ZSLOT); bf16_t* zgb = (bf16_t*)(ws + WS_Z + 4 * ZSLOT); bf16_t* zgo = zgb; unsigned* lau = (unsigned*)(ws + WS_LAU);
    float* agg = (float*)(ws + WS_AGG);
    const int rowbase = bl * SEQ + e8 * 512;
    const int tb = __builtin_amdgcn_readfirstlane(wave & 1), dblk = __builtin_amdgcn_readfirstlane(wave >> 1);
    bf16x8 wr_f[8], wi_f[8];
    { const bf16_t* w = (const bf16_t*)(ws + WS_WLRU) + ((size_t)(l * 8 + head) * 256 + dblk * 32 + l31) * 128 + 8 * hh;
#pragma unroll
      for (int s = 0; s < 8; ++s) { wr_f[s] = *(const bf16x8*)(w + 16 * s); wi_f[s] = *(const bf16x8*)(w + 128 * 128 + 16 * s); } }
    const int dl = dblk * 32 + l31, dg = l * D + head * 128 + dl;
    const float br = asglobal(p->in[I_BR])[dg], bi = asglobal(p->in[I_BI])[dg];
    float c8; { const float lam = asglobal(p->in[I_LAM])[dg]; const float nl = -lam; const float sp = nl > 20.f ? nl : log1pf(fexp(nl)); c8 = 8.0f * sp; }
    const float wser = (c8 < 0.3f) ? 1.0f : 0.0f;
    const unsigned lauoff = (unsigned)((4 * hh) * D + head * 128 + dblk * 32 + l31) * 4u;
    LAS float* CW = (LAS float*)(lds + LR_CW);
    for (int i = tid; i < 640; i += NTHR) { const int k = i >> 7, c = i & 127; CW[i] = (k < 4) ? asglobal(p->in[I_CONVW])[(size_t)(l * 4 + k) * D + head * 128 + c] : asglobal(p->in[I_CONVB])[l * D + head * 128 + c]; }
    LAS float* CAR = (LAS float*)(lds + LR_CAR);
    float cwr[5][8];
#pragma unroll
    for (int k = 0; k < 5; ++k)
#pragma unroll
        for (int e = 0; e < 8; ++e) cwr[k][e] = (k < 4) ? asglobal(p->in[I_CONVW])[(size_t)(l * 4 + k) * D + head * 128 + (tid & 15) * 8 + e] : asglobal(p->in[I_CONVB])[l * D + head * 128 + (tid & 15) * 8 + e];
    if (tid < 128) {
        float A = 1.f, H = 0.f;
        if (PASS == 2) { for (int e = 0; e < e8; ++e) { const float a2 = agg[((size_t)(item - e8 + e) * 128 + tid) * 2], h2 = agg[((size_t)(item - e8 + e) * 128 + tid) * 2 + 1]; H = a2 * H + h2; } }
        CAR[tid * 2] = A; CAR[tid * 2 + 1] = H;
    }
    LAS float* UA = (LAS float*)(lds + LR_UA); LAS float* UU = (LAS float*)(lds + LR_UU); LAS float* SEG = (LAS float*)(lds + LR_SEG);
    u32x4 pre[3];
#pragma unroll
    for (int k3 = 0; k3 < 3; ++k3) { const int i = tid + k3 * NTHR, r = i >> 4, ch = i & 15; pre[k3] = (u32x4){0u, 0u, 0u, 0u};
        if (i < 67 * 16 && e8 * 512 + r - 3 >= 0) pre[k3] = *(const u32x4*)(zxb + (size_t)(rowbase + r - 3) * D + head * 128 + ch * 8); }
    for (int tile = 0; tile < 8; ++tile) {
        const int row0 = rowbase + tile * 64;
        const int spos0 = e8 * 512 + tile * 64;
#pragma unroll
        for (int k3 = 0; k3 < 3; ++k3) { const int i = tid + k3 * NTHR; if (i < 67 * 16) *(LAS u32x4*)(lds + LR_XB + (i >> 4) * 256 + (i & 15) * 16) = pre[k3]; }
        __syncthreads();
        if (tile + 1 < 8) {
#pragma unroll
            for (int k3 = 0; k3 < 3; ++k3) { const int i = tid + k3 * NTHR, r = i >> 4, ch = i & 15; pre[k3] = (u32x4){0u, 0u, 0u, 0u};
                if (i < 67 * 16) pre[k3] = *(const u32x4*)(zxb + (size_t)(row0 + 64 + r - 3) * D + head * 128 + ch * 8); } }
#pragma unroll
        for (int k2 = 0; k2 < 2; ++k2) { const int idx = tid + k2 * NTHR, t = idx >> 4, ch = idx & 15;
            float xc[8];
#pragma unroll
            for (int e = 0; e < 8; ++e) xc[e] = cwr[4][e];
#pragma unroll
            for (int k = 0; k < 4; ++k) { const u32x4 v = *(const LAS u32x4*)(lds + LR_XB + (t + k) * 256 + ch * 16);
                const float x[8] = {bflo(v.x), bfhi(v.x), bflo(v.y), bfhi(v.y), bflo(v.z), bfhi(v.z), bflo(v.w), bfhi(v.w)};
#pragma unroll
                for (int e = 0; e < 8; ++e) xc[e] += x[e] * cwr[k][e]; }
            u32x4 w; w.x = cvt_pk_bf16(xc[0], xc[1]); w.y = cvt_pk_bf16(xc[2], xc[3]); w.z = cvt_pk_bf16(xc[4], xc[5]); w.w = cvt_pk_bf16(xc[6], xc[7]);
            *(LAS u32x4*)(lds + LR_XA + t * 272 + ch * 16) = w;
            *(LAS f32x4*)(UU + t * 128 + ch * 8) = (f32x4){xc[0], xc[1], xc[2], xc[3]}; *(LAS f32x4*)(UU + t * 128 + ch * 8 + 4) = (f32x4){xc[4], xc[5], xc[6], xc[7]}; }
        __syncthreads();
        bf16_t* gp = zgb + (size_t)(row0 + (tid >> 7) * 16) * D + head * 128 + (tid & 127); bf16_t* go = zgo + (size_t)(row0 + (tid >> 7) * 16) * D + head * 128 + (tid & 127); bf16_t gv[16];
        if (PASS == 2) {
#pragma unroll
            for (int t = 0; t < 16; ++t) gv[t] = gp[(size_t)t * D]; }
        f32x16 ar, ai;
#pragma unroll
        for (int i = 0; i < 16; ++i) { ar[i] = 0.f; ai[i] = 0.f; }
#pragma unroll
        for (int s = 0; s < 8; ++s) { const bf16x8 a = *(const LAS bf16x8*)(lds + LR_XA + (tb * 32 + l31) * 272 + (16 * s + 8 * hh) * 2);
            ar = __builtin_amdgcn_mfma_f32_32x32x16_bf16(a, wr_f[s], ar, 0, 0, 0); ai = __builtin_amdgcn_mfma_f32_32x32x16_bf16(a, wi_f[s], ai, 0, 0, 0); }
#pragma unroll
        for (int i = 0; i < 16; ++i) { const int t = tb * 32 + crow(i, hh);
            const float r = sigm(ar[i] + br), ig = sigm(ai[i] + bi);
            const float la = -c8 * r; const float a0 = fexp(la);
            const float dr = bflo(cvt_pk_bf16(one_minus_exp(la, a0, wser), 0.f));
            const float a = 1.0f - dr; const float mult = __builtin_amdgcn_sqrtf(fmaxf(dr * (2.0f - dr), 0.f));
            const float xcv = UU[t * 128 + dl];
            const unsigned pk = cvt_pk_bf16(dr, mult * ig * xcv);
            UA[t * 128 + dl] = a; UU[t * 128 + dl] = bfhi(pk);
            if (PASS == 1) *(unsigned*)((char*)lau + ((size_t)(row0 + tb * 32 + (i & 3) + 8 * (i >> 2)) * D * 4) + lauoff) = pk; }
        __syncthreads();
        { const int d = tid & 127, seg = tid >> 7; float A = 1.f, H = 0.f;
#pragma unroll
          for (int t = 0; t < 16; ++t) { const float a = UA[(seg * 16 + t) * 128 + d], uu = UU[(seg * 16 + t) * 128 + d]; H = a * H + uu; A *= a; }
          SEG[(seg * 128 + d) * 2] = A; SEG[(seg * 128 + d) * 2 + 1] = H;
          __syncthreads();
          const int cb = tile & 1; float cA = CAR[(cb * 128 + d) * 2], cH = CAR[(cb * 128 + d) * 2 + 1];
          for (int s2 = 0; s2 < seg; ++s2) { const float a2 = SEG[(s2 * 128 + d) * 2], h2 = SEG[(s2 * 128 + d) * 2 + 1]; cH = a2 * cH + h2; cA *= a2; }
          if (PASS == 2) { float h = cH;
#pragma unroll
              for (int t = 0; t < 16; ++t) { const float a = UA[(seg * 16 + t) * 128 + d], uu = UU[(seg * 16 + t) * 128 + d]; h = a * h + uu;
                  const float g = bf1(gv[t]); go[(size_t)t * D] = f2bf(h * silu(g)); } }
          if (seg == 3) { CAR[((cb ^ 1) * 128 + d) * 2] = cA * A; CAR[((cb ^ 1) * 128 + d) * 2 + 1] = A * cH + H; }
        }
    }
    __syncthreads();
    if (PASS == 1) {
        if (tid < 128) { __hip_atomic_store(agg + ((size_t)item * 128 + tid) * 2, CAR[tid * 2], __ATOMIC_RELAXED, __HIP_MEMORY_SCOPE_AGENT); __hip_atomic_store(agg + ((size_t)item * 128 + tid) * 2 + 1, CAR[tid * 2 + 1], __ATOMIC_RELAXED, __HIP_MEMORY_SCOPE_AGENT); }
        asm volatile("s_waitcnt vmcnt(0)" ::: "memory");
        __syncthreads();
        if (tid == 0) __hip_atomic_store((unsigned*)(ws + WS_LFLAG) + 16 * item, pass_tag, __ATOMIC_RELAXED, __HIP_MEMORY_SCOPE_AGENT);
    }
    __syncthreads();
}
constexpr int L2_SA = 0, L2_SH = 16384, L2_CIN = 32768;
__device__ __forceinline__ void lru_pass2(KP p, LAS unsigned char* lds, int l, int item, unsigned pass_tag, bool dry = false) {
    const int tid = otid(), dg = tid & 15, seg = tid >> 4;
    const int e8 = item & 7, head = (item >> 3) & 7, bl = item >> 6;
    unsigned char* ws = ows(p->ws);
    bf16_t* zgb = (bf16_t*)(ws + WS_Z + 4 * ZSLOT); bf16_t* zgo = dry ? (bf16_t*)(ws + WS_H) : zgb; const unsigned* lau = (const unsigned*)(ws + WS_LAU); float* agg = (float*)(ws + WS_AGG);
    const int rowbase = bl * SEQ + e8 * 512;
    LAS float* SA = (LAS float*)(lds + L2_SA); LAS float* SH = (LAS float*)(lds + L2_SH); LAS float* CIN = (LAS float*)(lds + L2_CIN);
    if (tid < 64) {
        if (tid < e8) { unsigned sp = 0; while (__hip_atomic_load((unsigned*)(ws + WS_LFLAG) + 16 * (item - e8 + tid), __ATOMIC_RELAXED, __HIP_MEMORY_SCOPE_AGENT) != pass_tag) { __builtin_amdgcn_s_sleep(1); if (++sp > (1u << 22)) break; } }
        __builtin_amdgcn_fence(__ATOMIC_ACQUIRE, "agent");
        asm volatile("s_waitcnt vmcnt(0)" ::: "memory"); }
    __syncthreads();
    float carry = 0.f;
    if (tid < 128) { for (int e = 0; e < e8; ++e) { const float a2 = __hip_atomic_load(agg + ((size_t)(item - e8 + e) * 128 + tid) * 2, __ATOMIC_RELAXED, __HIP_MEMORY_SCOPE_AGENT), h2 = __hip_atomic_load(agg + ((size_t)(item - e8 + e) * 128 + tid) * 2 + 1, __ATOMIC_RELAXED, __HIP_MEMORY_SCOPE_AGENT); carry = a2 * carry + h2; } }
    u32x4 pk[4][2], pkn[4][2], gv[4], gn[4];
    { const size_t o = (size_t)(rowbase + seg * 4) * D + head * 128 + dg * 8;
#pragma unroll
      for (int t = 0; t < 4; ++t) { pkn[t][0] = *(const u32x4*)(lau + o + (size_t)t * D); pkn[t][1] = *(const u32x4*)(lau + o + (size_t)t * D + 4); gn[t] = *(const u32x4*)(zgb + o + (size_t)t * D); } }
    for (int tile = 0; tile < 4; ++tile) {
        const size_t o = (size_t)(rowbase + tile * 128 + seg * 4) * D + head * 128 + dg * 8;
#pragma unroll
        for (int t = 0; t < 4; ++t) { pk[t][0] = pkn[t][0]; pk[t][1] = pkn[t][1]; gv[t] = gn[t]; }
        if (tile + 1 < 4) {
#pragma unroll
            for (int t = 0; t < 4; ++t) { pkn[t][0] = *(const u32x4*)(lau + o + (size_t)(128 + t) * D); pkn[t][1] = *(const u32x4*)(lau + o + (size_t)(128 + t) * D + 4); gn[t] = *(const u32x4*)(zgb + o + (size_t)(128 + t) * D); } }
        float A[8], H[8];
#pragma unroll
        for (int e = 0; e < 8; ++e) { A[e] = 1.f; H[e] = 0.f; }
#pragma unroll
        for (int t = 0; t < 4; ++t)
#pragma unroll
            for (int e = 0; e < 8; ++e) { const unsigned w = pk[t][e >> 2][e & 3]; const float a = 1.0f - bflo(w); H[e] = a * H[e] + bfhi(w); A[e] *= a; }
        *(LAS f32x4*)(SA + seg * 128 + dg * 8) = (f32x4){A[0], A[1], A[2], A[3]}; *(LAS f32x4*)(SA + seg * 128 + dg * 8 + 4) = (f32x4){A[4], A[5], A[6], A[7]};
        *(LAS f32x4*)(SH + seg * 128 + dg * 8) = (f32x4){H[0], H[1], H[2], H[3]}; *(LAS f32x4*)(SH + seg * 128 + dg * 8 + 4) = (f32x4){H[4], H[5], H[6], H[7]};
        __syncthreads();
        if (tid < 128) {
#pragma unroll 8
            for (int s2 = 0; s2 < 32; ++s2) { CIN[s2 * 128 + tid] = carry; carry = SA[s2 * 128 + tid] * carry + SH[s2 * 128 + tid]; } }
        __syncthreads();
        const f32x4 c0 = *(const LAS f32x4*)(CIN + seg * 128 + dg * 8), c1 = *(const LAS f32x4*)(CIN + seg * 128 + dg * 8 + 4);
        float h[8] = {c0[0], c0[1], c0[2], c0[3], c1[0], c1[1], c1[2], c1[3]};
#pragma unroll
        for (int t = 0; t < 4; ++t) { float y[8]; const u32x4 g = gv[t]; const float g8[8] = {bflo(g.x), bfhi(g.x), bflo(g.y), bfhi(g.y), bflo(g.z), bfhi(g.z), bflo(g.w), bfhi(g.w)};
#pragma unroll
            for (int e = 0; e < 8; ++e) { const unsigned w = pk[t][e >> 2][e & 3]; h[e] = (1.0f - bflo(w)) * h[e] + bfhi(w); y[e] = h[e] * silu(g8[e]); }
            u32x4 w4; w4.x = cvt_pk_bf16(y[0], y[1]); w4.y = cvt_pk_bf16(y[2], y[3]); w4.z = cvt_pk_bf16(y[4], y[5]); w4.w = cvt_pk_bf16(y[6], y[7]);
            *(u32x4*)(zgo + o + (size_t)t * D) = w4; }
    }
    __syncthreads();
}
__device__ __forceinline__ void ln_stats(KP p) {
    const int tid = otid(), lane = tid & 63, wave = tid >> 6;
    unsigned char* ws = ows(p->ws);
    const bf16_t* zv = (const bf16_t*)(ws + WS_Z + 1 * ZSLOT); float* st = (float*)(ws + WS_STATS);
    const int bid = obid();
    for (int k = 0; k < 8; ++k) { const int row = bid * 64 + wave * 8 + k; if (row >= TC) break;
        const u32x4* r = (const u32x4*)(zv + (size_t)row * D) + lane; const u32x4 a = r[0], b = r[64];
        float x[16] = {bflo(a.x), bfhi(a.x), bflo(a.y), bfhi(a.y), bflo(a.z), bfhi(a.z), bflo(a.w), bfhi(a.w), bflo(b.x), bfhi(b.x), bflo(b.y), bfhi(b.y), bflo(b.z), bfhi(b.z), bflo(b.w), bfhi(b.w)};
        float s = 0.f;
#pragma unroll
        for (int i = 0; i < 16; ++i) s += x[i];
        const float mean = wave_sum(s) * (1.0f / D); float q = 0.f;
#pragma unroll
        for (int i = 0; i < 16; ++i) { const float d = x[i] - mean; q += d * d; }
        const float rstd = __builtin_amdgcn_rsqf(wave_sum(q) * (1.0f / D) + EPS);
        if (lane == 0) { st[row * 2] = mean; st[row * 2 + 1] = rstd; } }
}

constexpr int GM_LN = 36864;
constexpr int GM_SV = 40960;
__device__ __forceinline__ void gmlp_items(KP p, LAS unsigned char* lds, int l, int c, int G, bool dry = false) {
    const int tid = otid(), lane = tid & 63, wave = tid >> 6, l31 = lane & 31, hh = lane >> 5;
    unsigned char* ws = ows(p->ws);
    const int nitems = (TC / 128) * 8;
    if (c >= nitems) return;
    const int g = c & 7;
    bf16_t* zu = (bf16_t*)(ws + WS_Z); bf16_t* zuo = dry ? (bf16_t*)(ws + WS_H) : zu; const bf16_t* zv = (const bf16_t*)(ws + WS_Z + 1 * ZSLOT); const bf16_t* zga = (const bf16_t*)(ws + WS_Z + 2 * ZSLOT);
    const float* lnp = (const float*)(ws + WS_LNP);
    LAS float* LN = (LAS float*)(lds + GM_LN); LAS float* SV = (LAS float*)(lds + GM_SV);
    if (tid < 256) LN[tid] = (tid < 128) ? asglobal(p->in[I_LNG])[l * D + g * 128 + tid] : asglobal(p->in[I_LNB])[l * D + g * 128 + tid - 128];
    const int cb = wave & 3, ib0 = (wave >> 2) * 2;
    bf16x8 wf[2][8];
    { const bf16_t* wg = (const bf16_t*)(ws + WS_WG) + (size_t)(l * 8 + g) * 128 * 128;
#pragma unroll
      for (int q = 0; q < 2; ++q)
#pragma unroll
        for (int s = 0; s < 8; ++s) wf[q][s] = *(const bf16x8*)(wg + (size_t)((ib0 + q) * 32 + l31) * 128 + 16 * s + 8 * hh); }
    const int c8 = tid & 15, jt = tid >> 4;
    const float* bsp = asglobal(p->in[I_BS]) + (size_t)(l * 8 + g) * 128;
    u32x4 vq[4]; f32x2 pq[4];
    { const int row0 = (c >> 3) * 128;
#pragma unroll
      for (int k = 0; k < 4; ++k) { vq[k] = *(const u32x4*)(zv + (size_t)(row0 + jt + 32 * k) * D + g * 128 + c8 * 8); pq[k] = *(const f32x2*)(lnp + (size_t)(row0 + jt + 32 * k) * 32 + 2 * c8); } }
    __syncthreads();
    for (int item = c; item < nitems; item += G) {
        const int row0 = (item >> 3) * 128;
#pragma unroll
        for (int k = 0; k < 4; ++k) { const int j = jt + 32 * k; float ssum = pq[k].x, qsum = pq[k].y;
#pragma unroll
            for (int o = 1; o < 16; o <<= 1) { ssum += __shfl_xor(ssum, o); qsum += __shfl_xor(qsum, o); }
            const float mean = ssum * (1.0f / D), rstd = __builtin_amdgcn_rsqf(fmaxf(qsum * (1.0f / D) - mean * mean, 0.f) + EPS);
            const u32x4 v = vq[k];
            const float x[8] = {bflo(v.x), bfhi(v.x), bflo(v.y), bfhi(v.y), bflo(v.z), bfhi(v.z), bflo(v.w), bfhi(v.w)};
            const int colb = ((((j >> 3) ^ c8) & 15) * 8 + (j & 7)) * 2;
#pragma unroll
            for (int e = 0; e < 8; ++e) { const float y = (x[e] - mean) * rstd * LN[c8 * 8 + e] + LN[128 + c8 * 8 + e]; *(LAS bf16_t*)(lds + (c8 * 8 + e) * 272 + colb) = f2bf(y); } }
        __syncthreads();
        if (item + G < nitems) { const int rown = ((item + G) >> 3) * 128;
#pragma unroll
            for (int k = 0; k < 4; ++k) { vq[k] = *(const u32x4*)(zv + (size_t)(rown + jt + 32 * k) * D + g * 128 + c8 * 8); pq[k] = *(const f32x2*)(lnp + (size_t)(rown + jt + 32 * k) * 32 + 2 * c8); } }
        u32x4 uq[4]; float bq[4];
#pragma unroll
        for (int k = 0; k < 4; ++k) { const size_t off = (size_t)(row0 + jt + 32 * k) * D + g * 128 + c8 * 8; uq[k] = *(const u32x4*)(zu + off); bq[k] = bsp[jt + 32 * k]; }
        f32x16 acc[2];
#pragma unroll
        for (int q = 0; q < 2; ++q)
#pragma unroll
            for (int i = 0; i < 16; ++i) acc[q][i] = 0.f;
#pragma unroll
        for (int s = 0; s < 8; ++s) { const int ch = cb * 32 + l31; const bf16x8 a = *(const LAS bf16x8*)(lds + ch * 272 + ((((2 * s + hh) ^ (ch >> 3)) & 15) * 16));
#pragma unroll
            for (int q = 0; q < 2; ++q) acc[q] = __builtin_amdgcn_mfma_f32_32x32x16_bf16(a, wf[q][s], acc[q], 0, 0, 0); }
#pragma unroll
        for (int q = 0; q < 2; ++q)
#pragma unroll
            for (int rg = 0; rg < 4; ++rg) *(LAS f32x4*)(SV + ((ib0 + q) * 32 + l31) * 132 + cb * 32 + 8 * rg + 4 * hh) = (f32x4){acc[q][4 * rg], acc[q][4 * rg + 1], acc[q][4 * rg + 2], acc[q][4 * rg + 3]};
        __syncthreads();
#pragma unroll
        for (int k = 0; k < 4; ++k) { const int i = jt + 32 * k; const size_t off = (size_t)(row0 + i) * D + g * 128 + c8 * 8;
            const f32x4 s0 = *(const LAS f32x4*)(SV + i * 132 + c8 * 8), s1 = *(const LAS f32x4*)(SV + i * 132 + c8 * 8 + 4);
            const float sv[8] = {s0[0], s0[1], s0[2], s0[3], s1[0], s1[1], s1[2], s1[3]};
            const u32x4 uu = uq[k];
            const float u8[8] = {bflo(uu.x), bfhi(uu.x), bflo(uu.y), bfhi(uu.y), bflo(uu.z), bfhi(uu.z), bflo(uu.w), bfhi(uu.w)};
            float y[8];
#pragma unroll
            for (int e = 0; e < 8; ++e) y[e] = u8[e] * (sv[e] + bq[k]);
            u32x4 w; w.x = cvt_pk_bf16(y[0], y[1]); w.y = cvt_pk_bf16(y[2], y[3]); w.z = cvt_pk_bf16(y[4], y[5]); w.w = cvt_pk_bf16(y[6], y[7]);
            *(u32x4*)(zuo + off) = w; }
    }
    __syncthreads();
}

constexpr int AT_STRIDE = 528;
__device__ __forceinline__ void attn_item(KP p, LAS unsigned char* lds, int l, int chunk, int item, bool dry = false) {
    const int tid = otid(), lane = tid & 63, wave = tid >> 6, l31 = lane & 31, hh = lane >> 5;
    const int tile = item & 15, hd = (item >> 4) & 3, bl = item >> 6, bg = chunk * BPC + bl;
    unsigned char* ws = ows(p->ws);
    const bf16_t* zq = (const bf16_t*)(ws + WS_Z + 5 * ZSLOT); bf16_t* zgc = (bf16_t*)(ws + WS_Z + 6 * ZSLOT); bf16_t* zgco = dry ? (bf16_t*)(ws + WS_H) : zgc;
    const bf16_t* KM = (const bf16_t*)(ws + WS_KM) + (size_t)l * MROWS * D + (size_t)bg * MEML * D + hd * 256;
    const bf16_t* VT = (const bf16_t*)(ws + WS_VT) + (size_t)l * D * MROWS + (size_t)hd * 256 * MROWS + bg * MEML;
    const int trow = bl * SEQ + tile * 256 + wave * 32 + l31;
    const bf16_t* qp = zq + (size_t)trow * D + hd * 256 + 8 * hh;
    const unsigned koff = (unsigned)((tid >> 5) * D + (tid & 31) * 8) * 2u, voff = (unsigned)((tid >> 5) * MROWS + (tid & 31) * 8) * 2u;
    const unsigned loff = (unsigned)((tid >> 5) * AT_STRIDE + (tid & 31) * 16);
#pragma unroll
    for (int k = 0; k < 16; ++k) *(LAS u32x4*)(lds + loff + k * 16 * AT_STRIDE) = *(const u32x4*)((const char*)KM + (size_t)k * 16 * D * 2 + koff);
    __syncthreads();
    const float k2 = 0.0625f * 1.44269504089f;
    bf16x8 pf[8][2];
    u32x4 vpre[8];
    float mA = 0.f, sumA = 0.f, alphaA = 1.f, sum = 0.f;
#pragma unroll
    for (int half = 0; half < 2; ++half) {
        f32x16 sc[4];
#pragma unroll
        for (int mb = 0; mb < 4; ++mb)
#pragma unroll
            for (int i = 0; i < 16; ++i) sc[mb][i] = 0.f;
        bf16x8 qc[4], qn[4];
#pragma unroll
        for (int s4 = 0; s4 < 4; ++s4) qc[s4] = *(const bf16x8*)(qp + 16 * s4);
#pragma unroll 1
        for (int sg = 0; sg < 4; ++sg) {
            if (sg < 3) {
#pragma unroll
                for (int s4 = 0; s4 < 4; ++s4) qn[s4] = *(const bf16x8*)(qp + 64 * (sg + 1) + 16 * s4); }
#pragma unroll
            for (int s4 = 0; s4 < 4; ++s4)
#pragma unroll
                for (int mb = 0; mb < 4; ++mb) { const bf16x8 a = *(const LAS bf16x8*)(lds + (half * 128 + mb * 32 + l31) * AT_STRIDE + (64 * sg + 16 * s4 + 8 * hh) * 2);
                    sc[mb] = __builtin_amdgcn_mfma_f32_32x32x16_bf16(a, qc[s4], sc[mb], 0, 0, 0); }
#pragma unroll
            for (int s4 = 0; s4 < 4; ++s4) qc[s4] = qn[s4];
        }
        if (half == 1) {
            __builtin_amdgcn_sched_barrier(0);
#pragma unroll
            for (int k = 0; k < 8; ++k) vpre[k] = *(const u32x4*)((const char*)VT + (size_t)k * 16 * MROWS * 2 + voff); }
        float mh = -3.0e38f;
#pragma unroll
        for (int mb = 0; mb < 4; ++mb)
#pragma unroll
            for (int i = 0; i < 16; ++i) mh = fmaxf(mh, sc[mb][i]);
        mh = fmaxf(mh, __shfl_xor(mh, 32));
        float mref;
        if (half == 0) { mA = mh; mref = mh; } else { mref = fmaxf(mA, mh); alphaA = __builtin_amdgcn_exp2f((mA - mref) * k2); }
        float sh = 0.f;
#pragma unroll
        for (int mb = 0; mb < 4; ++mb) {
#pragma unroll
            for (int i = 0; i < 16; ++i) { const float e = __builtin_amdgcn_exp2f((sc[mb][i] - mref) * k2); sc[mb][i] = e; sh += e; }
#pragma unroll
            for (int s2 = 0; s2 < 2; ++s2) { u32x4 w;
                w.x = cvt_pk_bf16(sc[mb][8 * s2 + 0], sc[mb][8 * s2 + 1]); w.y = cvt_pk_bf16(sc[mb][8 * s2 + 2], sc[mb][8 * s2 + 3]);
                w.z = cvt_pk_bf16(sc[mb][8 * s2 + 4], sc[mb][8 * s2 + 5]); w.w = cvt_pk_bf16(sc[mb][8 * s2 + 6], sc[mb][8 * s2 + 7]);
                pf[half * 4 + mb][s2] = __builtin_bit_cast(bf16x8, w); } }
        sh += __shfl_xor(sh, 32);
        if (half == 0) sumA = sh; else sum = sumA * alphaA + sh;
    }
    const float inv = frcp(sum);
    __syncthreads();
#pragma unroll
    for (int k = 0; k < 8; ++k) *(LAS u32x4*)(lds + loff + k * 16 * AT_STRIDE) = vpre[k];
#pragma unroll
    for (int k = 8; k < 16; ++k) *(LAS u32x4*)(lds + loff + k * 16 * AT_STRIDE) = *(const u32x4*)((const char*)VT + (size_t)k * 16 * MROWS * 2 + voff);
    u32x4 gcr[4][2];
    { const size_t off0 = (size_t)trow * D + hd * 256 + 8 * hh;
#pragma unroll
      for (int b4 = 0; b4 < 4; ++b4)
#pragma unroll
        for (int k = 0; k < 2; ++k) gcr[b4][k] = *(const u32x4*)(zgc + off0 + b4 * 32 + 16 * k); }
    __syncthreads();
#pragma unroll
    for (int db = 0; db < 8; ++db) { f32x16 o; u32x4 gc[2];
#pragma unroll
        for (int k = 0; k < 2; ++k) gc[k] = gcr[db & 3][k];
        if (db < 4) { const size_t off1 = (size_t)trow * D + hd * 256 + (db + 4) * 32 + 8 * hh;
#pragma unroll
            for (int k = 0; k < 2; ++k) gcr[db & 3][k] = *(const u32x4*)(zgc + off1 + 16 * k); }
#pragma unroll
        for (int i = 0; i < 16; ++i) o[i] = 0.f;
#pragma unroll
        for (int mb = 0; mb < 8; ++mb) {
            if (mb == 4) {
#pragma unroll
                for (int i = 0; i < 16; ++i) o[i] *= alphaA; }
#pragma unroll
            for (int s2 = 0; s2 < 2; ++s2) { const LAS unsigned char* vp = lds + (db * 32 + l31) * AT_STRIDE + (mb * 32 + 16 * s2 + 4 * hh) * 2;
                const s16x4 lo = *(const LAS s16x4*)vp, hi = *(const LAS s16x4*)(vp + 16);
                const bf16x8 a = __builtin_shufflevector(lo, hi, 0, 1, 2, 3, 4, 5, 6, 7);
                o = __builtin_amdgcn_mfma_f32_32x32x16_bf16(a, pf[mb][s2], o, 0, 0, 0); } }
#pragma unroll
        for (int k = 0; k < 2; ++k) { float v8[8];
#pragma unroll
            for (int j = 0; j < 4; ++j) { typedef unsigned u2v __attribute__((ext_vector_type(2)));
                const u2v sw = __builtin_amdgcn_permlane32_swap(__float_as_uint(o[8 * k + j]), __float_as_uint(o[8 * k + 4 + j]), false, false);
                v8[j] = __uint_as_float(sw[0]); v8[4 + j] = __uint_as_float(sw[1]); }
            const u32x4 g = gc[k]; const float g8[8] = {bflo(g.x), bfhi(g.x), bflo(g.y), bfhi(g.y), bflo(g.z), bfhi(g.z), bflo(g.w), bfhi(g.w)};
            float y[8];
#pragma unroll
            for (int e = 0; e < 8; ++e) y[e] = v8[e] * inv * silu(g8[e]);
            u32x4 w; w.x = cvt_pk_bf16(y[0], y[1]); w.y = cvt_pk_bf16(y[2], y[3]); w.z = cvt_pk_bf16(y[4], y[5]); w.w = cvt_pk_bf16(y[6], y[7]);
            *(u32x4*)(zgco + (size_t)trow * D + hd * 256 + db * 32 + 16 * k + 8 * hh) = w; } }
    __syncthreads();
}

__device__ __forceinline__ void row_phase(KP p, int l, int chunk, bool dry = false) {
    const int tid = otid(), lane = tid & 63, wave = tid >> 6;
    const int gw = obid() * 8 + wave, NGW = ogrid() * 8;
    unsigned char* ws = ows(p->ws);
    const float* outf = (const float*)(ws + WS_Z);
    const float* xsrc = (l == 0) ? asglobal(p->in[I_X]) : asglobal(p->out);
    const float* gpost = asglobal(p->in[I_POSTG]) + l * D; const float* gpre = asglobal(p->in[I_PREG]) + (l + 1 < DEPTH ? l + 1 : 0) * D;
    bf16_t* H = dry ? (bf16_t*)(ws + WS_Z + 4 * ZSLOT) : (bf16_t*)(ws + WS_H);
    float* xout = dry ? (float*)(ws + WS_Z + 2 * ZSLOT) - (size_t)chunk * TC * D : asglobal(p->out);
    for (int r = gw; r < TC; r += NGW) {
        const size_t grow = (size_t)chunk * TC + r;
        const f32x4* orow = (const f32x4*)(outf + (size_t)r * D) + lane; const f32x4* xr = (const f32x4*)(xsrc + grow * D) + lane;
        f32x4 o[4], x[4]; float s = 0.f;
#pragma unroll
        for (int j = 0; j < 4; ++j) { o[j] = orow[64 * j]; x[j] = xr[64 * j]; s += (o[j].x * o[j].x + o[j].y * o[j].y) + (o[j].z * o[j].z + o[j].w * o[j].w); }
        const float r1 = __builtin_amdgcn_rsqf(wave_sum(s) * (1.0f / D) + EPS); float s2 = 0.f;
        f32x4* xo = (f32x4*)(xout + grow * D) + lane;
#pragma unroll
        for (int j = 0; j < 4; ++j) { const f32x4 gv = ((const f32x4*)gpost)[lane + 64 * j]; x[j] = x[j] + o[j] * r1 * gv; xo[64 * j] = x[j];
            s2 += (x[j].x * x[j].x + x[j].y * x[j].y) + (x[j].z * x[j].z + x[j].w * x[j].w); }
        if (l + 1 < DEPTH) {
            const float r2 = __builtin_amdgcn_rsqf(wave_sum(s2) * (1.0f / D) + EPS); u32x2* h8 = (u32x2*)(H + (size_t)r * D) + lane;
#pragma unroll
            for (int j = 0; j < 4; ++j) { const f32x4 gv = ((const f32x4*)gpre)[lane + 64 * j]; u32x2 w; w.x = cvt_pk_bf16(x[j].x * r2 * gv.x, x[j].y * r2 * gv.y); w.y = cvt_pk_bf16(x[j].z * r2 * gv.z, x[j].w * r2 * gv.w); h8[64 * j] = w; }
        } else if (chunk + 1 < NCH) {
            rms_row_to_bf16(asglobal(p->in[I_X]) + ((size_t)(chunk + 1) * TC + r) * D, asglobal(p->in[I_PREG]), H + (size_t)r * D, lane);
        }
    }
}

#define XB_TMO      128
#define XB_XCNT(j)  (256  + 64 * (j))
#define XB_XSUB(j)  (1280 + 64 * (j))
#define XB_XGEN(j)  (2304 + 64 * (j))
#define XB_TOP      3328
#define XB_TOPGEN   3392
#define XCD_BAR_WORDS 3456
#define XB_SPIN_CAP (1u << 22)
__device__ __forceinline__ unsigned xb_ld(unsigned* p)              { return __hip_atomic_load(p, __ATOMIC_RELAXED, __HIP_MEMORY_SCOPE_AGENT); }
__device__ __forceinline__ unsigned xb_add(unsigned* p, unsigned v) { return __hip_atomic_fetch_add(p, v, __ATOMIC_RELAXED, __HIP_MEMORY_SCOPE_AGENT); }
__device__ __forceinline__ unsigned xb_xcc_id() { return (unsigned)__builtin_amdgcn_s_getreg((3 << 11) | 20) & 0xFu; }
#define XB_SPIN(cond, bar) do { unsigned _sp = 0; while (cond) { __builtin_amdgcn_s_sleep(1); \
    if ((++_sp & 255u) == 0u) { if (xb_ld(&(bar)[XB_TMO])) break; if (_sp > XB_SPIN_CAP) { atomicAdd(&(bar)[XB_TMO], 1u); break; } } } } while (0)
struct XcdBarrier { unsigned* bar; unsigned x; volatile LAS unsigned* st; };
__device__ __forceinline__ XcdBarrier xcd_barrier_post(unsigned* bar, volatile LAS unsigned* st) {
    XcdBarrier b; b.bar = bar; b.x = xb_xcc_id(); b.st = st;
    if (threadIdx.x == 0) (void)xb_add(&bar[XB_XCNT(b.x)], 1u);
    return b;
}
__device__ __forceinline__ void xcd_barrier_complete(unsigned* bar, unsigned x, unsigned& nloc, unsigned& nx) {
    const unsigned G = gridDim.x * gridDim.y * gridDim.z;
    unsigned sum, cnt, mine, sp = 0u;
    for (;;) {
        sum = 0u; cnt = 0u; mine = 0u;
#pragma unroll
        for (unsigned j = 0; j < 16; ++j) { const unsigned c = xb_ld(&bar[XB_XCNT(j)]); sum += c; cnt += (c > 0u) ? 1u : 0u; mine = (j == x) ? c : mine; }
        if (sum == G) break;
        __builtin_amdgcn_s_sleep(1);
        if ((++sp & 255u) == 0u) { if (xb_ld(&bar[XB_TMO])) break; if (sp > XB_SPIN_CAP) { atomicAdd(&bar[XB_TMO], 1u); break; } }
    }
    nloc = mine > 0u ? mine : 1u; nx = cnt > 0u ? cnt : 1u;
}
__device__ __forceinline__ void xcd_barrier(const XcdBarrier& b) {
    asm volatile("s_waitcnt vmcnt(0)" ::: "memory");
    __syncthreads();
    if (threadIdx.x == 0) {
        unsigned* bar = (unsigned*)ows((unsigned char*)b.bar);
        __builtin_amdgcn_s_waitcnt(0);
        unsigned nloc = b.st[0], nx = b.st[1];
        if (nloc == 0u) { xcd_barrier_complete(bar, b.x, nloc, nx); b.st[0] = nloc; b.st[1] = nx; }
        const unsigned old = xb_add(&bar[XB_XSUB(b.x)], 1u);
        const unsigned gen = old / nloc;
        if (old + 1u == (gen + 1u) * nloc) {
            __builtin_amdgcn_fence(__ATOMIC_RELEASE, "agent");
            asm volatile("s_waitcnt vmcnt(0)" ::: "memory");
            const unsigned og = xb_add(&bar[XB_TOP], 1u);
            const unsigned tg = og / nx;
            if (og + 1u == (tg + 1u) * nx) xb_add(&bar[XB_TOPGEN], 1u);
            else XB_SPIN(xb_ld(&bar[XB_TOPGEN]) == tg, bar);
            __builtin_amdgcn_fence(__ATOMIC_ACQUIRE, "agent");
            xb_add(&bar[XB_XGEN(b.x)], 1u);
            asm volatile("s_waitcnt vmcnt(0)" ::: "memory");
        } else {
            XB_SPIN(xb_ld(&bar[XB_XGEN(b.x)]) == gen, bar);
            __builtin_amdgcn_fence(__ATOMIC_ACQUIRE, "agent");
            asm volatile("s_waitcnt vmcnt(0)" ::: "memory");
        }
    }
    __syncthreads();
}

constexpr int N_PHASES = 2 + NCH * DEPTH * 4;
__global__ void __launch_bounds__(NTHR, 2) mk_fwd(Params pk) {
    extern __shared__ __attribute__((aligned(16))) unsigned char lds_raw[];
    LAS unsigned char* lds = (LAS unsigned char*)lds_raw;
    unsigned char* ws = pk.ws;
    int G = gridDim.x, c = blockIdx.x;
    volatile LAS unsigned* bst = (volatile LAS unsigned*)(lds + LDS_BYTES - 64);
    if (threadIdx.x < 2) bst[threadIdx.x] = 0u;
    __syncthreads();
    XcdBarrier bar; bar.bar = (unsigned*)(ws + WS_BAR); bar.x = 0; bar.st = bst;
    if (pk.ph_hi - pk.ph_lo > 1) bar = xcd_barrier_post((unsigned*)(ws + WS_BAR), bst);
    const int ph_hi = pk.ph_hi;
    for (int ph = pk.ph_lo; ph < ph_hi; ++ph) {
        KP p = (KP)__builtin_amdgcn_kernarg_segment_ptr(); asm volatile("" : "+s"(p));
        ws = ows(ws); asm volatile("" : "+s"(G), "+s"(c));
        if (ph == 0) { if constexpr ((PH_MASK & 1) != 0) phase_prologue(p, lds); }
        else if (ph == 1) { if constexpr ((PH_MASK & 2) != 0) {
            pg8::SchedKV S{(const char*)(ws + WS_MEMN), (const char*)(ws + WS_WKV), G, c};
            pg8::EpiKV E{(bf16_t*)(ws + WS_KM), (bf16_t*)(ws + WS_VT)};
            pg8::gemm_phase<pg8::EpiKV, pg8::SchedKV, true>(lds, D, S, E); }
        } else {
            const int s = (ph - 2) / 4, k = (ph - 2) % 4, chunk = s / DEPTH, l = s % DEPTH;
            for (int rep = 0; rep < (((DBL >> k) & 1) ? 2 : 1); ++rep) {
            if (rep) xcd_barrier(bar);
            if (k == 0) { if constexpr ((PH_MASK & 4) != 0) {
                pg8::SchedGrid S{(const char*)(ws + WS_H), (const char*)(ws + WS_WIN) + (size_t)l * INW * D * 2, TC / 256, INW / 256, (TC / 256) * (INW / 256), G, c, (size_t)256 * D * 2};
                pg8::EpiBf16 E{(bf16_t*)(ws + WS_Z), D, (size_t)TC * D, 1, (const float*)nullptr, (float*)(ws + WS_LNP)};
                pg8::gemm_phase<pg8::EpiBf16, pg8::SchedGrid, true>(lds, D, S, E); }
            } else if (k == 1) {
                if constexpr ((DRYM & 1) != 0) for (int it = c; it < 256; it += G) lru_item<1>(p, lds, l, it, (unsigned)(s + 1));
                if constexpr ((PH_MASK & 8) != 0) for (int it = c; it < 256; it += G) lru_item<1>(p, lds, l, it, (unsigned)(s + 1));
                if constexpr ((DRYM & 2) != 0) gmlp_items(p, lds, l, c, G, true);
                if constexpr ((PH_MASK & 32) != 0) gmlp_items(p, lds, l, c, G);
                if constexpr ((DRYM & 4) != 0) for (int it = c; it < 256; it += G) attn_item(p, lds, l, chunk, it, true);
                if constexpr ((PH_MASK & 64) != 0) for (int it = c; it < 256; it += G) attn_item(p, lds, l, chunk, it);
                if constexpr ((DRYM & 8) != 0) for (int it = c; it < 256; it += G) lru_pass2(p, lds, l, it, (unsigned)(s + 1), true);
                if constexpr ((PH_MASK & 16) != 0) for (int it = c; it < 256; it += G) lru_pass2(p, lds, l, it, (unsigned)(s + 1));
            } else if (k == 2) { if constexpr ((PH_MASK & 128) != 0) {
                pg8::SchedMerge S{(const char*)(ws + WS_Z), (const char*)(ws + WS_WP) + (size_t)l * 3 * D * D * 2, G, c};
                pg8::EpiMerge E{(const bf16_t*)(ws + WS_Z + 7 * ZSLOT), (bf16_t*)(ws + WS_Z + 5 * ZSLOT)};
                pg8::gemm_phase<pg8::EpiMerge, pg8::SchedMerge, true>(lds, D, S, E); }
            } else { if constexpr ((PH_MASK & 256) != 0) {
                const bool lastl = (l + 1 == DEPTH);
                pg8::SchedGrid S{(const char*)(ws + WS_Z + 5 * ZSLOT), (const char*)(ws + WS_WOUT) + (size_t)l * D * D * 2, TC / 256, 4, (TC / 256) * 4, G, c, (size_t)256 * D * 2};
                pg8::EpiOutNorm E{(l == 0 ? asglobal(p->in[I_X]) : asglobal(p->out)) + (size_t)chunk * TC * D, asglobal(p->out) + (size_t)chunk * TC * D, lastl ? (bf16_t*)nullptr : (bf16_t*)(ws + WS_H),
                                  asglobal(p->in[I_POSTG]) + l * D, asglobal(p->in[I_PREG]) + (lastl ? 0 : l + 1) * D, (float*)(ws + WS_SS1), (float*)(ws + WS_SS2),
                                  (unsigned*)(ws + WS_PCNT), 4u * (unsigned)(s + 1), (unsigned*)(ws + WS_PCNT2), 4u * (unsigned)(chunk * (DEPTH - 1) + l + 1)};
                pg8::gemm_phase<pg8::EpiOutNorm, pg8::SchedGrid, true>(lds, D, S, E);
                if (lastl && chunk + 1 < NCH) {
                    const int wave = otid() >> 6, lane = otid() & 63;
                    for (int m = c * 8 + wave; m < TC; m += G * 8) rms_row_to_bf16(asglobal(p->in[I_X]) + ((size_t)(chunk + 1) * TC + m) * D, asglobal(p->in[I_PREG]), (bf16_t*)(ws + WS_H) + (size_t)m * D, lane);
                } } }
            }
        }
        if (ph + 1 < ph_hi) { if (ph_hi == -12345) cg::this_grid().sync();
                              xcd_barrier(bar); }
    }
}

extern "C" void kernel_launch(void* const* d_in, const int* in_sizes, int n_in, void* d_out, int out_size, void* d_ws, size_t ws_size, hipStream_t stream) {
    static int grid = 0;
    if (grid == 0) {
        if (n_in != 22 || out_size != NT * D || ws_size < WS_END) { fprintf(stderr, "kernel_launch: unexpected problem (n_in %d, out %d, ws %zu < %zu)\n", n_in, out_size, ws_size, (size_t)WS_END); grid = -1; return; }
        if (hipFuncSetAttribute((const void*)mk_fwd, hipFuncAttributeMaxDynamicSharedMemorySize, LDS_BYTES) != hipSuccess) { fprintf(stderr, "kernel_launch: hipFuncSetAttribute failed\n"); grid = -1; return; }
        int dev = 0, cus = 0, per_cu = 0;
        (void)hipGetDevice(&dev); (void)hipDeviceGetAttribute(&cus, hipDeviceAttributeMultiprocessorCount, dev);
        (void)hipOccupancyMaxActiveBlocksPerMultiprocessor(&per_cu, (const void*)mk_fwd, NTHR, LDS_BYTES);
        (void)hipGetLastError();
        grid = cus > 0 ? cus : 256;
        if (per_cu < 1) fprintf(stderr, "kernel_launch: occupancy query says %d blocks per CU\n", per_cu);
    }
    if (grid < 0) return;
    Params p{};
    for (int i = 0; i < 22; ++i) p.in[i] = (const float*)d_in[i];
    p.out = (float*)d_out; p.ws = (unsigned char*)d_ws;
#if MK_MULTI
    for (int ph = 0; ph < N_PHASES; ++ph) { p.ph_lo = ph; p.ph_hi = ph + 1; hipLaunchKernelGGL(mk_fwd, dim3(grid), dim3(NTHR), LDS_BYTES, stream, p); }
#else
    p.ph_lo = 0; p.ph_hi = N_PHASES;
    (void)hipMemsetAsync((char*)d_ws + WS_BAR, 0, WS_ZERO_END - WS_BAR, stream);
    void* args[] = {&p};
    hipError_t e = hipLaunchCooperativeKernel((const void*)mk_fwd, dim3(grid), dim3(NTHR), args, LDS_BYTES, stream);
    if (e != hipSuccess) fprintf(stderr, "cooperative launch failed: %s (grid %d)\n", hipGetErrorString(e), grid);
#endif
}
```

```cpp
#include <hip/hip_runtime.h>
#include <hip/hip_cooperative_groups.h>
#include <cstdio>
#include <cstdint>
namespace cg = cooperative_groups;

#ifndef MK_MULTI
#define MK_MULTI 0
#endif

#ifndef DBL
#define DBL 0
#endif
#ifndef DRYM
#define DRYM 0
#endif
#ifndef PH_MASK
#define PH_MASK 0x3FF
#endif
#define LAS __attribute__((address_space(3)))
typedef unsigned short bf16_t;
typedef short bf16x8 __attribute__((ext_vector_type(8)));
typedef short s16x4 __attribute__((ext_vector_type(4)));
typedef float f32x4 __attribute__((ext_vector_type(4)));
typedef float f32x2 __attribute__((ext_vector_type(2)));
typedef float f32x16 __attribute__((ext_vector_type(16)));
typedef unsigned u32x4 __attribute__((ext_vector_type(4)));
typedef unsigned u32x2 __attribute__((ext_vector_type(2)));

constexpr int D = 1024, NB = 8, SEQ = 4096, DEPTH = 4, NT = NB * SEQ;
constexpr int NCH = 2, TC = NT / NCH, BPC = NB / NCH;
constexpr int INW = 10240, MEML = 256, MROWS = NB * MEML;
constexpr float EPS = 1e-6f;
constexpr int NTHR = 512;

constexpr size_t MiB = 1u << 20;
constexpr size_t WS_STATS = 0;
constexpr size_t WS_AGG = 256 * 1024;
constexpr size_t WS_BAR = 512 * 1024;
constexpr size_t WS_SS1 = 1 * MiB;
constexpr size_t WS_SS2 = WS_SS1 + 512 * 1024;
constexpr size_t WS_PCNT = 2 * MiB;
constexpr size_t WS_LFLAG = WS_PCNT + 16384;
constexpr size_t WS_PCNT2 = WS_LFLAG + 16384;
constexpr size_t WS_ZERO_END = WS_PCNT2 + 16384;
constexpr size_t WS_WIN = 3 * MiB;
constexpr size_t WS_WP = 83 * MiB;
constexpr size_t WS_WOUT = 107 * MiB;
constexpr size_t WS_WLRU = 115 * MiB;
constexpr size_t WS_WG = 117 * MiB;
constexpr size_t WS_KM = 118 * MiB;
constexpr size_t WS_VT = 134 * MiB;
constexpr size_t WS_H = 150 * MiB;
constexpr size_t WS_Z = 182 * MiB;
constexpr size_t ZSLOT = (size_t)TC * D * 2;
constexpr size_t WS_WKV = WS_Z;
constexpr size_t WS_MEMN = WS_Z + 16 * MiB;
constexpr size_t WS_LAU = WS_Z + 10 * ZSLOT;
constexpr size_t WS_LNP = WS_LAU + 2 * ZSLOT;
constexpr size_t WS_END = WS_LNP + (size_t)TC * 128;

constexpr int LDS_BYTES = 147456;

typedef __bf16 bf16x2_t __attribute__((ext_vector_type(2)));
__device__ __forceinline__ unsigned cvt_pk_bf16(float lo, float hi) { const f32x2 v = {lo, hi}; return __builtin_bit_cast(unsigned, __builtin_convertvector(v, bf16x2_t)); }
__device__ __forceinline__ float bflo(unsigned w) { return __uint_as_float(w << 16); }
__device__ __forceinline__ float bfhi(unsigned w) { return __uint_as_float(w & 0xffff0000u); }
__device__ __forceinline__ float bf1(bf16_t b) { return __uint_as_float(((unsigned)b) << 16); }
__device__ __forceinline__ bf16_t f2bf(float f) { return (bf16_t)(cvt_pk_bf16(f, 0.f) & 0xffffu); }
__device__ __forceinline__ float wave_sum(float v) {
#pragma unroll
    for (int o = 1; o < 64; o <<= 1) v += __shfl_xor(v, o);
    return v;
}
__device__ __forceinline__ int otid() { int t = threadIdx.x; asm volatile("" : "+v"(t)); return t; }
#define GAS __attribute__((address_space(1)))
template <class T> __device__ __forceinline__ T* asglobal(T* p) { return (T*)(GAS T*)p; }
__device__ __forceinline__ unsigned char* ows(unsigned char* w) { GAS unsigned char* g = (GAS unsigned char*)w; asm volatile("" : "+s"(g)); return (unsigned char*)g; }
__device__ __forceinline__ int obid() { int t = blockIdx.x; asm volatile("" : "+s"(t)); return t; }
__device__ __forceinline__ int ogrid() { int t = gridDim.x; asm volatile("" : "+s"(t)); return t; }
__device__ __forceinline__ float frcp(float x) { return __builtin_amdgcn_rcpf(x); }
__device__ __forceinline__ float fexp(float x) { return __builtin_amdgcn_exp2f(x * 1.44269504089f); }
__device__ __forceinline__ float sigm(float x) { return frcp(1.0f + fexp(-x)); }
__device__ __forceinline__ float silu(float x) { return x * frcp(1.0f + fexp(-x)); }
__device__ __forceinline__ float one_minus_exp(float x, float e, float w) {
    float q = 1.0f + x * (1.0f / 7.0f); q = 1.0f + x * (1.0f / 6.0f) * q; q = 1.0f + x * 0.2f * q; q = 1.0f + x * 0.25f * q; q = 1.0f + x * (1.0f / 3.0f) * q; q = 1.0f + x * 0.5f * q;
    const float d = 1.0f - e;
    return d + w * (-x * q - d);
}

namespace pg8 {
constexpr int BM = 256, BK = 64, HALF = 128, HTB = HALF * BK * 2, STAGE_BYTES = 8 * HTB, NXCD = 8, WGM = 8;
__host__ __device__ __forceinline__ int lds_byte(int r, int c) { const int st = (r >> 4) * 2 + (c >> 5), rr = r & 15, cc = c & 31, ob = rr * 64 + cc * 2; return st * 1024 + (ob ^ (((ob >> 9) & 1) << 5)); }
__host__ __device__ __forceinline__ void stage_rc(int b, int& R, int& C) { const int st = b / 1024, sb = b % 1024, swz = sb ^ (((sb >> 9) & 1) << 5); R = (st >> 1) * 16 + swz / 64; C = (st & 1) * 32 + (swz % 64) / 2; }
__host__ __device__ __forceinline__ int perm32(int rho) { const int n = rho >> 4, i = rho & 15; return 8 * (i >> 2) + 4 * n + (i & 3); }

struct Unit { const char* A; const char* B; int r0, c0, aux; };

template <class Epi, class Sched, bool ALIGN_EPI>
__device__ __forceinline__ void gemm_phase(LAS unsigned char* lds, const int K, const Sched& S, const Epi& E) {
    const int tid = otid(), wid = __builtin_amdgcn_readfirstlane(tid >> 6), lane = tid & 63, wr = wid >> 2, wc = wid & 3, fr = lane & 15, fq = lane >> 4;
    const int nt = K / BK;
    unsigned voffA[2], voffB[2];
#pragma unroll
    for (int i = 0; i < 2; ++i) { int R, C; stage_rc(tid * 16 + i * 8192, R, C); const int Rb = Epi::PERM ? ((R >> 5) * 64 + perm32(R & 31)) : R;
        voffA[i] = (unsigned)(R * K + C) * 2u; voffB[i] = (unsigned)(Rb * K + C) * 2u; }
    const size_t kstep = (size_t)(BK * 2);
    const size_t hstep = (size_t)HALF * K * 2;
    const size_t hstepB = Epi::PERM ? (size_t)32 * K * 2 : hstep;
    const unsigned ldsw = (unsigned)wid * 1024u;
    const int aoff = lds_byte(wr * 64 + fr, fq * 8), boff = lds_byte(wc * 32 + fr, fq * 8);
#define PG8_SA(b, h) (((b) * 2 + (h)) * HTB)
#define PG8_SB(b, h) ((4 + (b) * 2 + (h)) * HTB)
#define PG8_STAGE(bufoff, gbase, voff) do { _Pragma("unroll") for (int _i = 0; _i < 2; ++_i) \
        __builtin_amdgcn_global_load_lds((const unsigned*)((const char*)(gbase) + (voff)[_i]), (LAS unsigned*)(lds + (bufoff) + ldsw + _i * 8192), 16, 0, 0); } while (0)
#define PG8_LDA(dst, b, h) do { _Pragma("unroll") for (int m = 0; m < 4; ++m) _Pragma("unroll") for (int k = 0; k < 2; ++k) dst[m][k] = *(const LAS bf16x8*)(lds + PG8_SA(b, h) + aoff + m * 2048 + k * 1024); } while (0)
#define PG8_LDB(dst, b, h) do { _Pragma("unroll") for (int n = 0; n < 2; ++n) _Pragma("unroll") for (int k = 0; k < 2; ++k) dst[n][k] = *(const LAS bf16x8*)(lds + PG8_SB(b, h) + boff + n * 2048 + k * 1024); } while (0)
#define PG8_MMA(ai, bj, At, Bt) do { __builtin_amdgcn_s_setprio(1); _Pragma("unroll") for (int m = 0; m < 4; ++m) _Pragma("unroll") for (int n = 0; n < 2; ++n) _Pragma("unroll") for (int k = 0; k < 2; ++k) \
        acc[ai][bj][m][n] = __builtin_amdgcn_mfma_f32_16x16x32_bf16(Bt[n][k], At[m][k], acc[ai][bj][m][n], 0, 0, 0); __builtin_amdgcn_s_setprio(0); } while (0)
#define PG8_WAIT_V(n) asm volatile("s_waitcnt vmcnt(" #n ")" ::: "memory")
#define PG8_WAIT_L(n) asm volatile("s_waitcnt lgkmcnt(" #n ")" ::: "memory")
#define PG8_BAR __builtin_amdgcn_s_barrier()
#define PG8_SCHED __builtin_amdgcn_sched_barrier(0)
    Unit cur, nxt; int ui = 0;
    if (!S.next(0, cur)) return;
    f32x4 acc[2][2][4][2];
#pragma unroll
    for (int a = 0; a < 2; ++a)
#pragma unroll
        for (int b = 0; b < 2; ++b)
#pragma unroll
            for (int m = 0; m < 4; ++m)
#pragma unroll
                for (int n = 0; n < 2; ++n) acc[a][b][m][n] = (f32x4){0.f, 0.f, 0.f, 0.f};
    bf16x8 At[4][2], B0[2][2], B1[2][2];
    const char* cA = cur.A; const char* cB = cur.B;
    PG8_STAGE(PG8_SB(0, 0), cB, voffB); PG8_STAGE(PG8_SB(0, 1), cB + hstepB, voffB); PG8_STAGE(PG8_SA(0, 0), cA, voffA); PG8_STAGE(PG8_SA(0, 1), cA + hstep, voffA);
    if (wr == 1) PG8_BAR;
    PG8_WAIT_V(2); PG8_BAR;
    PG8_STAGE(PG8_SB(1, 0), cB + kstep, voffB); PG8_STAGE(PG8_SA(1, 0), cA + kstep, voffA); PG8_STAGE(PG8_SB(1, 1), cB + hstepB + kstep, voffB);
    PG8_WAIT_V(6); PG8_BAR;
    for (;;) {
        const bool has_next = S.next(ui + 1, nxt);
        const char* nA = has_next ? nxt.A : cA; const char* nB = has_next ? nxt.B : cB;
        for (int t = 0; t < nt; t += 2) {
            const bool last = (t == nt - 2);
            const char* a1 = cA + (size_t)(t + 1) * kstep;
            const char* a2 = last ? nA : cA + (size_t)(t + 2) * kstep; const char* b2 = last ? nB : cB + (size_t)(t + 2) * kstep;
            const char* a3 = a2 + kstep; const char* b3 = b2 + kstep;
            PG8_LDB(B0, 0, 0); PG8_LDB(B1, 0, 1); PG8_SCHED; PG8_LDA(At, 0, 0); PG8_STAGE(PG8_SA(1, 1), a1 + hstep, voffA);
            PG8_WAIT_V(8); PG8_WAIT_L(0); PG8_BAR; PG8_MMA(0, 0, At, B0); PG8_MMA(0, 1, At, B1); PG8_BAR; PG8_SCHED;
            PG8_LDA(At, 0, 1); PG8_STAGE(PG8_SB(0, 0), b2, voffB); PG8_STAGE(PG8_SB(0, 1), b2 + hstepB, voffB); PG8_STAGE(PG8_SA(0, 0), a2, voffA);
            PG8_WAIT_V(8); PG8_WAIT_L(0); PG8_BAR; PG8_MMA(1, 0, At, B0); PG8_MMA(1, 1, At, B1); PG8_BAR; PG8_SCHED;
            PG8_LDB(B0, 1, 0); PG8_LDB(B1, 1, 1); PG8_SCHED; PG8_LDA(At, 1, 0); PG8_STAGE(PG8_SA(0, 1), a2 + hstep, voffA);
            PG8_WAIT_V(8); PG8_WAIT_L(0); PG8_BAR; PG8_MMA(0, 0, At, B0); PG8_MMA(0, 1, At, B1); PG8_BAR; PG8_SCHED;
            PG8_LDA(At, 1, 1); PG8_STAGE(PG8_SB(1, 0), b3, voffB); PG8_STAGE(PG8_SB(1, 1), b3 + hstepB, voffB); PG8_STAGE(PG8_SA(1, 0), a3, voffA);
            PG8_WAIT_V(8); PG8_WAIT_L(0); PG8_BAR; PG8_MMA(1, 0, At, B0); PG8_MMA(1, 1, At, B1); PG8_BAR; PG8_SCHED;
        }
        if constexpr (ALIGN_EPI) { if (wr == 0) PG8_BAR; }
        bool zero = true;
        if constexpr (!Epi::AFTER_DRAIN) zero = E(acc, cur, wr, wc, fr, fq);
        if (!has_next) break;
        if (zero) {
#pragma unroll
            for (int a = 0; a < 2; ++a)
#pragma unroll
                for (int b = 0; b < 2; ++b)
#pragma unroll
                    for (int m = 0; m < 4; ++m)
#pragma unroll
                        for (int n = 0; n < 2; ++n) acc[a][b][m][n] = (f32x4){0.f, 0.f, 0.f, 0.f};
        }
        cur = nxt; cA = nA; cB = nB; ++ui;
        if constexpr (ALIGN_EPI) { if (wr == 1) PG8_BAR; }
    }
    PG8_WAIT_V(0);
    if constexpr (!ALIGN_EPI) { if (wr == 0) PG8_BAR; }
    PG8_BAR;
    if constexpr (Epi::AFTER_DRAIN) E.fused(acc, cur, wr, wc, fr, fq, lds, wid, lane);
#undef PG8_SA
#undef PG8_SB
#undef PG8_STAGE
#undef PG8_LDA
#undef PG8_LDB
#undef PG8_MMA
#undef PG8_WAIT_V
#undef PG8_WAIT_L
#undef PG8_BAR
#undef PG8_SCHED
}

struct EpiBf16 {
    static constexpr bool PERM = true, AFTER_DRAIN = false;
    bf16_t* O; int ldc; size_t split_stride; int split; const float* rowss; float* lnp;
    __device__ __forceinline__ bool operator()(f32x4 (&acc)[2][2][4][2], const Unit& u, int wr, int wc, int fr, int fq) const {
        const int row0 = u.r0 + wr * 64 + fr, pn = u.c0 >> 8;
        const bool paired = pn < 8, vtile = (pn >> 2) == 2;
        const int slot = paired ? 0 : (pn < 12 ? 1 : (pn >> 2));
        bf16_t* base = O + (size_t)slot * split_stride;
        const int col0 = paired ? (pn * 128 + wc * 32 + 8 * fq) : ((pn & 3) * 256 + wc * 64 + 8 * fq);
#pragma unroll
        for (int ai = 0; ai < 2; ++ai)
#pragma unroll
            for (int m = 0; m < 4; ++m) { bf16_t* rowp = base + (size_t)(row0 + ai * HALF + m * 16) * ldc + col0;
                float rs = 1.0f; if (rowss) { const f32x4 q = *(const f32x4*)(rowss + (size_t)(row0 + ai * HALF + m * 16) * 4); rs = __builtin_amdgcn_rsqf((((q.x + q.y) + q.z) + q.w) * (1.0f / D) + EPS); }
                if (paired) {
                    const f32x4 u0 = acc[ai][0][m][0] * rs, u1 = acc[ai][0][m][1] * rs, g0 = acc[ai][1][m][0] * rs, g1 = acc[ai][1][m][1] * rs;
                    u32x4 w; w.x = cvt_pk_bf16(u0[0] * silu(g0[0]), u0[1] * silu(g0[1])); w.y = cvt_pk_bf16(u0[2] * silu(g0[2]), u0[3] * silu(g0[3]));
                    w.z = cvt_pk_bf16(u1[0] * silu(g1[0]), u1[1] * silu(g1[1])); w.w = cvt_pk_bf16(u1[2] * silu(g1[2]), u1[3] * silu(g1[3]));
                    *(u32x4*)rowp = w;
                } else {
                    float ls = 0.f, lq = 0.f;
#pragma unroll
                    for (int bj = 0; bj < 2; ++bj) { const f32x4 v0 = acc[ai][bj][m][0] * rs, v1 = acc[ai][bj][m][1] * rs;
                        if (vtile) { ls += ((v0[0] + v0[1]) + (v0[2] + v0[3])) + ((v1[0] + v1[1]) + (v1[2] + v1[3]));
                            lq += ((v0[0] * v0[0] + v0[1] * v0[1]) + (v0[2] * v0[2] + v0[3] * v0[3])) + ((v1[0] * v1[0] + v1[1] * v1[1]) + (v1[2] * v1[2] + v1[3] * v1[3])); }
                        u32x4 w; w.x = cvt_pk_bf16(v0[0], v0[1]); w.y = cvt_pk_bf16(v0[2], v0[3]); w.z = cvt_pk_bf16(v1[0], v1[1]); w.w = cvt_pk_bf16(v1[2], v1[3]);
                        *(u32x4*)(rowp + bj * 32) = w; }
                    if (vtile) {
                        ls += __shfl_xor(ls, 16); ls += __shfl_xor(ls, 32); lq += __shfl_xor(lq, 16); lq += __shfl_xor(lq, 32);
                        if (fq == 0) *(f32x2*)(lnp + ((size_t)(row0 + ai * HALF + m * 16) * 16 + (pn & 3) * 4 + wc) * 2) = (f32x2){ls, lq}; } } }
        return true;
    }
};
struct EpiKV {
    static constexpr bool PERM = true, AFTER_DRAIN = false;
    bf16_t* KM; bf16_t* VT;
    __device__ __forceinline__ bool operator()(f32x4 (&acc)[2][2][4][2], const Unit& u, int wr, int wc, int fr, int fq) const {
        const int l = u.aux >> 1, isv = u.aux & 1; const int ldc = isv ? MROWS : D;
        bf16_t* base = (isv ? VT : KM) + (size_t)l * MROWS * D;
        const int row0 = u.r0 + wr * 64 + fr, col0 = u.c0 + wc * 64 + 8 * fq;
#pragma unroll
        for (int ai = 0; ai < 2; ++ai)
#pragma unroll
            for (int m = 0; m < 4; ++m) { bf16_t* rowp = base + (size_t)(row0 + ai * HALF + m * 16) * ldc + col0;
#pragma unroll
                for (int bj = 0; bj < 2; ++bj) { const f32x4 v0 = acc[ai][bj][m][0], v1 = acc[ai][bj][m][1];
                    u32x4 w; w.x = cvt_pk_bf16(v0[0], v0[1]); w.y = cvt_pk_bf16(v0[2], v0[3]); w.z = cvt_pk_bf16(v1[0], v1[1]); w.w = cvt_pk_bf16(v1[2], v1[3]);
                    *(u32x4*)(rowp + bj * 32) = w; } }
        return true;
    }
};
struct EpiF32 {
    static constexpr bool PERM = false, AFTER_DRAIN = false;
    float* C;
    __device__ __forceinline__ bool operator()(f32x4 (&acc)[2][2][4][2], const Unit& u, int wr, int wc, int fr, int fq) const {
        const int row0 = u.r0 + wr * 64 + fr, col0 = u.c0 + wc * 32 + 4 * fq;
#pragma unroll
        for (int ai = 0; ai < 2; ++ai)
#pragma unroll
            for (int m = 0; m < 4; ++m) { float* rowp = C + (size_t)(row0 + ai * HALF + m * 16) * D + col0;
#pragma unroll
                for (int bj = 0; bj < 2; ++bj)
#pragma unroll
                    for (int n = 0; n < 2; ++n) *(f32x4*)(rowp + bj * HALF + n * 16) = acc[ai][bj][m][n]; }
        return true;
    }
};

struct EpiOutNorm {
    static constexpr bool PERM = false, AFTER_DRAIN = true;
    const float* xsrc; float* xdst; bf16_t* H; const float* gpost; const float* gpre; float* slot1; float* slot2; unsigned* cnt; unsigned want; unsigned* cnt2; unsigned want2;
    __device__ __forceinline__ bool operator()(f32x4 (&acc)[2][2][4][2], const Unit& u, int wr, int wc, int fr, int fq) const { return true; }
    __device__ __forceinline__ void exchange(LAS float* P, float* slot, unsigned* pcnt, unsigned wnt, const Unit& u, int pn, int tid, int wid, int lane) const {
        asm volatile("s_waitcnt lgkmcnt(0)" ::: "memory"); __builtin_amdgcn_s_barrier(); asm volatile("" ::: "memory");
        if (tid < 256) { const f32x4 q = *(const LAS f32x4*)(P + tid * 4); __hip_atomic_store(slot + (size_t)(u.r0 + tid) * 4 + pn, ((q.x + q.y) + q.z) + q.w, __ATOMIC_RELAXED, __HIP_MEMORY_SCOPE_AGENT); }
        asm volatile("s_waitcnt vmcnt(0) lgkmcnt(0)" ::: "memory"); __builtin_amdgcn_s_barrier(); asm volatile("" ::: "memory");
        unsigned* pc = pcnt + 64 * (u.r0 >> 8);
        if (wid == 0) {
            if (lane == 0) __hip_atomic_fetch_add(pc, 1u, __ATOMIC_RELAXED, __HIP_MEMORY_SCOPE_AGENT);
            unsigned sp = 0;
            while ((unsigned)__builtin_amdgcn_readfirstlane(__hip_atomic_load(pc, __ATOMIC_RELAXED, __HIP_MEMORY_SCOPE_AGENT)) < wnt) { __builtin_amdgcn_s_sleep(1); if (++sp > (1u << 22)) break; }
            __builtin_amdgcn_fence(__ATOMIC_ACQUIRE, "agent");
            asm volatile("s_waitcnt vmcnt(0)" ::: "memory"); }
        asm volatile("" ::: "memory"); __builtin_amdgcn_s_barrier(); asm volatile("" ::: "memory");
    }
    __device__ __forceinline__ float rowscale(const float* slot, int row) const {
        const float t0 = __hip_atomic_load(slot + (size_t)row * 4 + 0, __ATOMIC_RELAXED, __HIP_MEMORY_SCOPE_AGENT), t1 = __hip_atomic_load(slot + (size_t)row * 4 + 1, __ATOMIC_RELAXED, __HIP_MEMORY_SCOPE_AGENT),
                    t2 = __hip_atomic_load(slot + (size_t)row * 4 + 2, __ATOMIC_RELAXED, __HIP_MEMORY_SCOPE_AGENT), t3 = __hip_atomic_load(slot + (size_t)row * 4 + 3, __ATOMIC_RELAXED, __HIP_MEMORY_SCOPE_AGENT);
        return __builtin_amdgcn_rsqf((((t0 + t1) + t2) + t3) * (1.0f / D) + EPS);
    }
    __device__ __forceinline__ void fused(f32x4 (&acc)[2][2][4][2], const Unit& u, int wr, int wc, int fr, int fq, LAS unsigned char* lds, int wid, int lane) const {
        const int row0 = u.r0 + wr * 64 + fr, col0 = u.c0 + wc * 32 + 4 * fq, pn = u.c0 >> 8, tid = wid * 64 + lane;
        LAS float* P = (LAS float*)lds;
#pragma unroll
        for (int ai = 0; ai < 2; ++ai)
#pragma unroll
            for (int m = 0; m < 4; ++m) { float sq = 0.f;
#pragma unroll
                for (int bj = 0; bj < 2; ++bj)
#pragma unroll
                    for (int n = 0; n < 2; ++n) { const f32x4 v = acc[ai][bj][m][n]; sq += (v[0] * v[0] + v[1] * v[1]) + (v[2] * v[2] + v[3] * v[3]); }
                sq += __shfl_xor(sq, 16); sq += __shfl_xor(sq, 32);
                if (fq == 0) P[(ai * HALF + wr * 64 + m * 16 + fr) * 4 + wc] = sq; }
        exchange(P, slot1, cnt, want, u, pn, tid, wid, lane);
        f32x4 gp[2][2];
#pragma unroll
        for (int bj = 0; bj < 2; ++bj)
#pragma unroll
            for (int n = 0; n < 2; ++n) gp[bj][n] = *(const f32x4*)(gpost + col0 + bj * HALF + n * 16);
#pragma unroll
        for (int ai = 0; ai < 2; ++ai)
#pragma unroll
            for (int m = 0; m < 4; ++m) { const int row = row0 + ai * HALF + m * 16; const size_t off = (size_t)row * D + col0;
                const float r1 = rowscale(slot1, row);
                float s2 = 0.f;
#pragma unroll
                for (int bj = 0; bj < 2; ++bj)
#pragma unroll
                    for (int n = 0; n < 2; ++n) { const f32x4 xv = *(const f32x4*)(xsrc + off + bj * HALF + n * 16);
                        const f32x4 xn = xv + acc[ai][bj][m][n] * r1 * gp[bj][n];
                        *(f32x4*)(xdst + off + bj * HALF + n * 16) = xn; acc[ai][bj][m][n] = xn;
                        s2 += (xn[0] * xn[0] + xn[1] * xn[1]) + (xn[2] * xn[2] + xn[3] * xn[3]); }
                s2 += __shfl_xor(s2, 16); s2 += __shfl_xor(s2, 32);
                if (fq == 0) P[(ai * HALF + wr * 64 + m * 16 + fr) * 4 + wc] = s2;
                asm volatile("" ::: "memory"); }
        if (H) {
            exchange(P, slot2, cnt2, want2, u, pn, tid, wid, lane);
#pragma unroll
            for (int bj = 0; bj < 2; ++bj)
#pragma unroll
                for (int n = 0; n < 2; ++n) gp[bj][n] = *(const f32x4*)(gpre + col0 + bj * HALF + n * 16);
#pragma unroll
            for (int ai = 0; ai < 2; ++ai)
#pragma unroll
                for (int m = 0; m < 4; ++m) { const int row = row0 + ai * HALF + m * 16; const size_t off = (size_t)row * D + col0;
                    const float r2 = rowscale(slot2, row);
#pragma unroll
                    for (int bj = 0; bj < 2; ++bj)
#pragma unroll
                        for (int n = 0; n < 2; ++n) { const f32x4 a = acc[ai][bj][m][n] * r2 * gp[bj][n]; u32x2 w; w.x = cvt_pk_bf16(a[0], a[1]); w.y = cvt_pk_bf16(a[2], a[3]); *(u32x2*)(H + off + bj * HALF + n * 16) = w; } } }
    }
};
struct EpiMerge {
    static constexpr bool PERM = true, AFTER_DRAIN = false;
    const bf16_t* ML;
    bf16_t* O;
    static __device__ __forceinline__ f32x2 one_plus_exp_neg(unsigned w) {
        f32x2 x = {__builtin_amdgcn_fmed3f(bflo(w), -60.f, 60.f), __builtin_amdgcn_fmed3f(bfhi(w), -60.f, 60.f)};
        x = x * -1.44269504089f;
        const f32x2 e = {__builtin_amdgcn_exp2f(x.x), __builtin_amdgcn_exp2f(x.y)};
        return e + 1.0f;
    }
    __device__ __forceinline__ bool operator()(f32x4 (&acc)[2][2][4][2], const Unit& u, int wr, int wc, int fr, int fq) const {
        const int sub = u.aux;
        const int row0 = u.r0 + wr * 64 + fr, col0 = u.c0 + wc * 64 + 8 * fq;
        const bf16_t* l0 = ML + (size_t)sub * TC * D;
#pragma unroll
        for (int ai = 0; ai < 2; ++ai)
#pragma unroll
            for (int m = 0; m < 4; ++m) { const size_t off = (size_t)(row0 + ai * HALF + m * 16) * D + col0;
#pragma unroll
                for (int bj = 0; bj < 2; ++bj) {
                    const u32x4 a = *(const u32x4*)(l0 + off + bj * 32);
                    f32x2 f[4];
                    if (sub < 2) {
                        const u32x4 b = *(const u32x4*)(l0 + (size_t)TC * D + off + bj * 32);
#pragma unroll
                        for (int k = 0; k < 4; ++k) { const f32x2 da = one_plus_exp_neg(a[k]), db = one_plus_exp_neg(b[k]); const f32x2 ra = {frcp(da.x), frcp(da.y)}; f[k] = db * ra; }
                    } else {
#pragma unroll
                        for (int k = 0; k < 4; ++k) { const f32x2 da = one_plus_exp_neg(a[k]); f[k] = (f32x2){frcp(da.x), frcp(da.y)}; }
                    }
                    const f32x4 v0 = acc[ai][bj][m][0] * (f32x4){f[0].x, f[0].y, f[1].x, f[1].y}, v1 = acc[ai][bj][m][1] * (f32x4){f[2].x, f[2].y, f[3].x, f[3].y};
                    if (sub < 2) { acc[ai][bj][m][0] = v0; acc[ai][bj][m][1] = v1; }
                    else { u32x4 w; w.x = cvt_pk_bf16(v0[0], v0[1]); w.y = cvt_pk_bf16(v0[2], v0[3]); w.z = cvt_pk_bf16(v1[0], v1[1]); w.w = cvt_pk_bf16(v1[2], v1[3]);
                        *(u32x4*)(O + off + bj * 32) = w; }
                } }
        return sub == 2;
    }
};

struct SchedGrid {
    const char* A; const char* B; int nM, nN, nwg, G, c; size_t tstep;
    __device__ __forceinline__ bool next(int i, Unit& u) const {
        const long L = (long)i * G + c; if (L >= nwg) return false;
        int wgid = (int)L; { const int q = nwg / NXCD, r = nwg % NXCD, xcd = wgid % NXCD, off = wgid / NXCD; wgid = (xcd < r ? xcd * (q + 1) : r * (q + 1) + (xcd - r) * q) + off; }
        const int nig = WGM * nN, gid = wgid / nig, fm = gid * WGM, gsz = (nM - fm) < WGM ? (nM - fm) : WGM;
        const int pm = fm + ((wgid % nig) % gsz), pn = (wgid % nig) / gsz;
        u.A = A + (size_t)pm * tstep; u.B = B + (size_t)pn * tstep; u.r0 = pm * BM; u.c0 = pn * BM; u.aux = 0; return true;
    }
};
struct SchedKV {
    const char* MEMN; const char* WKV; int G, c;
    __device__ __forceinline__ bool next(int i, Unit& u) const {
        const int id = i * G + c; if (id >= 256) return false;
        const size_t tstep = (size_t)BM * D * 2;
        const int l = id >> 6, r = id & 63; const char* w = WKV + (size_t)l * 2048 * D * 2;
        if (r < 32) { const int pm = r >> 2, pn = r & 3; u.A = MEMN + pm * tstep; u.B = w + pn * tstep; u.r0 = pm * BM; u.c0 = pn * BM; u.aux = l << 1; }
        else { const int rr = r - 32, pm = rr >> 3, pn = rr & 7; u.A = w + (size_t)(4 + pm) * tstep; u.B = MEMN + pn * tstep; u.r0 = pm * BM; u.c0 = pn * BM; u.aux = (l << 1) | 1; }
        return true;
    }
};
struct SchedMerge {
    const char* Z; const char* WP; int G, c;
    __device__ __forceinline__ bool next(int i, Unit& u) const {
        const int tile = (i / 3) * G + c, sub = i % 3; if (tile >= (TC / BM) * 4) return false;
        const size_t tstep = (size_t)BM * D * 2;
        const int pm = tile >> 2, pn = tile & 3; const int slot = sub == 0 ? 0 : (sub == 1 ? 4 : 6);
        u.A = Z + (size_t)slot * ZSLOT + pm * tstep; u.B = WP + (size_t)sub * D * D * 2 + pn * tstep; u.r0 = pm * BM; u.c0 = pn * BM; u.aux = sub; return true;
    }
};
}

struct Params { const float* in[22]; float* out; unsigned char* ws; int ph_lo, ph_hi; };
typedef const __attribute__((address_space(4))) Params* KP;
enum { I_X = 0, I_MEM, I_MEMG, I_PREG, I_POSTG, I_WIN, I_LNG, I_LNB, I_WS, I_BS, I_CONVW, I_CONVB, I_WR, I_BR, I_WI, I_BI, I_LAM, I_WKV, I_WPA, I_WPB, I_WPC, I_WOUT };

__device__ __forceinline__ void transpose_item(const float* W, int ldw, bf16_t* WT, int ldt, int nblk, LAS float* scr, int item, int lane, bool remap = false) {
    const int kb = item / nblk, nb = item % nblk, k0 = 64 * kb, n0 = 32 * nb;
    int dn0 = n0;
    if (remap) { if (n0 < 1024) dn0 = ((n0 >> 7) * 8 + ((n0 >> 5) & 3) * 2) * 32; else if (n0 < 2048) dn0 = n0 + 1024; else if (n0 < 3072) { const int ch = n0 - 2048; dn0 = ((ch >> 7) * 8 + ((ch >> 5) & 3) * 2 + 1) * 32; } }
#pragma unroll 8
    for (int i = 0; i < 32; ++i) { const int kk = 2 * i + (lane >> 5); scr[kk * 33 + (lane & 31)] = W[(size_t)(k0 + kk) * ldw + n0 + (lane & 31)]; }
    asm volatile("s_waitcnt lgkmcnt(0)" ::: "memory");
    const int c = lane & 7;
#pragma unroll
    for (int j = 0; j < 4; ++j) { const int n = (lane >> 3) + 8 * j; const LAS float* s = scr + (8 * c) * 33 + n;
        u32x4 o; o.x = cvt_pk_bf16(s[0 * 33], s[1 * 33]); o.y = cvt_pk_bf16(s[2 * 33], s[3 * 33]); o.z = cvt_pk_bf16(s[4 * 33], s[5 * 33]); o.w = cvt_pk_bf16(s[6 * 33], s[7 * 33]);
        *(u32x4*)(WT + (size_t)(dn0 + n) * ldt + k0 + 8 * c) = o; }
    asm volatile("s_waitcnt lgkmcnt(0)" ::: "memory");
}
__device__ __forceinline__ void rms_row_to_bf16(const float* xrow, const float* g, bf16_t* orow, int lane) {
    const f32x4* xr = (const f32x4*)xrow + lane; const f32x4* gr = (const f32x4*)g + lane;
    f32x4 v[4]; float s = 0.f;
#pragma unroll
    for (int j = 0; j < 4; ++j) { v[j] = xr[64 * j]; s += (v[j].x * v[j].x + v[j].y * v[j].y) + (v[j].z * v[j].z + v[j].w * v[j].w); }
    const float r = __builtin_amdgcn_rsqf(wave_sum(s) * (1.0f / D) + EPS);
    u32x2* o8 = (u32x2*)orow + lane;
#pragma unroll
    for (int j = 0; j < 4; ++j) { const f32x4 gv = gr[64 * j]; u32x2 w; w.x = cvt_pk_bf16(v[j].x * r * gv.x, v[j].y * r * gv.y); w.y = cvt_pk_bf16(v[j].z * r * gv.z, v[j].w * r * gv.w); o8[64 * j] = w; }
}
__device__ __forceinline__ void row_to_aprime(const float* xrow, const float* g, bf16_t* orow, float* ss, int lane) {
    const f32x4* xr = (const f32x4*)xrow + lane; const f32x4* gr = (const f32x4*)g + lane;
    f32x4 v[4]; float s = 0.f;
#pragma unroll
    for (int j = 0; j < 4; ++j) { v[j] = xr[64 * j]; s += (v[j].x * v[j].x + v[j].y * v[j].y) + (v[j].z * v[j].z + v[j].w * v[j].w); }
    s = wave_sum(s);
    u32x2* o8 = (u32x2*)orow + lane;
#pragma unroll
    for (int j = 0; j < 4; ++j) { const f32x4 gv = gr[64 * j]; u32x2 w; w.x = cvt_pk_bf16(v[j].x * gv.x, v[j].y * gv.y); w.y = cvt_pk_bf16(v[j].z * gv.z, v[j].w * gv.w); o8[64 * j] = w; }
    if (lane == 0) *(f32x4*)ss = (f32x4){s, 0.f, 0.f, 0.f};
}
__device__ __forceinline__ void phase_prologue(KP p, LAS unsigned char* lds) {
    const int tid = otid(), lane = tid & 63, wave = tid >> 6;
    const int gw = obid() * 8 + wave, NGW = ogrid() * 8;
    LAS float* scr = (LAS float*)(lds + wave * 16384);
    unsigned char* ws = ows(p->ws);
    constexpr int PER_L = 5120 + 1024 + 4 * 512 + 128;
    for (int it = gw; it < DEPTH * PER_L; it += NGW) {
        const int l = it / PER_L; int r = it % PER_L;
        if (r < 5120) { transpose_item(asglobal(p->in[I_WIN]) + (size_t)l * D * INW, INW, (bf16_t*)(ws + WS_WIN) + (size_t)l * INW * D, D, INW / 32, scr, r, lane, true); continue; } r -= 5120;
        if (r < 1024) { transpose_item(asglobal(p->in[I_WKV]) + (size_t)l * D * 2048, 2048, (bf16_t*)(ws + WS_WKV) + (size_t)l * 2048 * D, D, 64, scr, r, lane); continue; } r -= 1024;
        if (r < 1536) { const int b = r / 512; transpose_item(asglobal(p->in[I_WPA + b]) + (size_t)l * D * D, D, (bf16_t*)(ws + WS_WP) + (size_t)(l * 3 + b) * D * D, D, 32, scr, r % 512, lane); continue; } r -= 1536;
        if (r < 512) { transpose_item(asglobal(p->in[I_WOUT]) + (size_t)l * D * D, D, (bf16_t*)(ws + WS_WOUT) + (size_t)l * D * D, D, 32, scr, r, lane); continue; } r -= 512;
        { const int ri = r >> 6, h = (r >> 3) & 7, sub = r & 7;
          transpose_item(asglobal(p->in[ri ? I_WI : I_WR]) + (size_t)(l * 8 + h) * 128 * 128, 128, (bf16_t*)(ws + WS_WLRU) + ((size_t)(l * 8 + h) * 256 + ri * 128) * 128, 128, 4, scr, sub, lane); }
    }
    { const float* W = asglobal(p->in[I_WS]); bf16_t* O = (bf16_t*)(ws + WS_WG);
      for (int i4 = obid() * NTHR + tid; i4 < DEPTH * 8 * 128 * 128 / 4; i4 += ogrid() * NTHR) {
          const int e = i4 * 4, j = e & 127, i = (e >> 7) & 127; f32x4 v = *(const f32x4*)(W + e);
          if (i < 64 && j >= 64) v = (f32x4){0.f, 0.f, 0.f, 0.f};
          u32x2 w; w.x = cvt_pk_bf16(v.x, v.y); w.y = cvt_pk_bf16(v.z, v.w); *(u32x2*)(O + e) = w; } }
    for (int m = gw; m < MROWS; m += NGW) rms_row_to_bf16(asglobal(p->in[I_MEM]) + (size_t)m * D, asglobal(p->in[I_MEMG]), (bf16_t*)(ws + WS_MEMN) + (size_t)m * D, lane);
    for (int m = gw; m < TC; m += NGW) rms_row_to_bf16(asglobal(p->in[I_X]) + (size_t)m * D, asglobal(p->in[I_PREG]), (bf16_t*)(ws + WS_H) + (size_t)m * D, lane);
}

__device__ __forceinline__ int crow(int reg, int h) { return (reg & 3) + 8 * (reg >> 2) + 4 * h; }
constexpr int LR_XB = 0, LR_XA = 17408, LR_UA = 34816, LR_UU = 67584, LR_SEG = 100352, LR_CAR = 104448, LR_CW = 106496, LR_END = 109568;
template <int PASS>
__device__ __forceinline__ void lru_item(KP p, LAS unsigned char* lds, int l, int item, unsigned pass_tag) {
    const int tid = otid(), lane = tid & 63, wave = tid >> 6, l31 = lane & 31, hh = lane >> 5;
    const int e8 = item & 7, head = (item >> 3) & 7, bl = item >> 6;
    unsigned char* ws = ows(p->ws);
    bf16_t* zxb = (bf16_t*)(ws + WS_Z + 3 * ZSLOT); bf16_t* zgb = (bf16_t*)(ws + WS_Z + 4 * ZSLOT); bf16_t* zgo = zgb; unsigned* lau = (unsigned*)(ws + WS_LAU);
    float* agg = (float*)(ws + WS_AGG);
    const int rowbase = bl * SEQ + e8 * 512;
    const int tb = __builtin_amdgcn_readfirstlane(wave & 1), dblk = __builtin_amdgcn_readfirstlane(wave >> 1);
    bf16x8 wr_f[8], wi_f[8];
    { const bf16_t* w = (const bf16_t*)(ws + WS_WLRU) + ((size_t)(l * 8 + head) * 256 + dblk * 32 + l31) * 128 + 8 * hh;
#pragma unroll
      for (int s = 0; s < 8; ++s) { wr_f[s] = *(const bf16x8*)(w + 16 * s); wi_f[s] = *(const bf16x8*)(w + 128 * 128 + 16 * s); } }
    const int dl = dblk * 32 + l31, dg = l * D + head * 128 + dl;
    const float br = asglobal(p->in[I_BR])[dg], bi = asglobal(p->in[I_BI])[dg];
    float c8; { const float lam = asglobal(p->in[I_LAM])[dg]; const float nl = -lam; const float sp = nl > 20.f ? nl : log1pf(fexp(nl)); c8 = 8.0f * sp; }
    const float wser = (c8 < 0.3f) ? 1.0f : 0.0f;
    const unsigned lauoff = (unsigned)((4 * hh) * D + head * 128 + dblk * 32 + l31) * 4u;
    LAS float* CW = (LAS float*)(lds + LR_CW);
    for (int i = tid; i < 640; i += NTHR) { const int k = i >> 7, c = i & 127; CW[i] = (k < 4) ? asglobal(p->in[I_CONVW])[(size_t)(l * 4 + k) * D + head * 128 + c] : asglobal(p->in[I_CONVB])[l * D + head * 128 + c]; }
    LAS float* CAR = (LAS float*)(lds + LR_CAR);
    float cwr[5][8];
#pragma unroll
    for (int k = 0; k < 5; ++k)
#pragma unroll
        for (int e = 0; e < 8; ++e) cwr[k][e] = (k < 4) ? asglobal(p->in[I_CONVW])[(size_t)(l * 4 + k) * D + head * 128 + (tid & 15) * 8 + e] : asglobal(p->in[I_CONVB])[l * D + head * 128 + (tid & 15) * 8 + e];
    if (tid < 128) {
        float A = 1.f, H = 0.f;
        if (PASS == 2) { for (int e = 0; e < e8; ++e) { const float a2 = agg[((size_t)(item - e8 + e) * 128 + tid) * 2], h2 = agg[((size_t)(item - e8 + e) * 128 + tid) * 2 + 1]; H = a2 * H + h2; } }
        CAR[tid * 2] = A; CAR[tid * 2 + 1] = H;
    }
    LAS float* UA = (LAS float*)(lds + LR_UA); LAS float* UU = (LAS float*)(lds + LR_UU); LAS float* SEG = (LAS float*)(lds + LR_SEG);
    u32x4 pre[3];
#pragma unroll
    for (int k3 = 0; k3 < 3; ++k3) { const int i = tid + k3 * NTHR, r = i >> 4, ch = i & 15; pre[k3] = (u32x4){0u, 0u, 0u, 0u};
        if (i < 67 * 16 && e8 * 512 + r - 3 >= 0) pre[k3] = *(const u32x4*)(zxb + (size_t)(rowbase + r - 3) * D + head * 128 + ch * 8); }
    for (int tile = 0; tile < 8; ++tile) {
        const int row0 = rowbase + tile * 64;
        const int spos0 = e8 * 512 + tile * 64;
#pragma unroll
        for (int k3 = 0; k3 < 3; ++k3) { const int i = tid + k3 * NTHR; if (i < 67 * 16) *(LAS u32x4*)(lds + LR_XB + (i >> 4) * 256 + (i & 15) * 16) = pre[k3]; }
        __syncthreads();
        if (tile + 1 < 8) {
#pragma unroll
            for (int k3 = 0; k3 < 3; ++k3) { const int i = tid + k3 * NTHR, r = i >> 4, ch = i & 15; pre[k3] = (u32x4){0u, 0u, 0u, 0u};
                if (i < 67 * 16) pre[k3] = *(const u32x4*)(zxb + (size_t)(row0 + 64 + r - 3) * D + head * 128 + ch * 8); } }
#pragma unroll
        for (int k2 = 0; k2 < 2; ++k2) { const int idx = tid + k2 * NTHR, t = idx >> 4, ch = idx & 15;
            float xc[8];
#pragma unroll
            for (int e = 0; e < 8; ++e) xc[e] = cwr[4][e];
#pragma unroll
            for (int k = 0; k < 4; ++k) { const u32x4 v = *(const LAS u32x4*)(lds + LR_XB + (t + k) * 256 + ch * 16);
                const float x[8] = {bflo(v.x), bfhi(v.x), bflo(v.y), bfhi(v.y), bflo(v.z), bfhi(v.z), bflo(v.w), bfhi(v.w)};
#pragma unroll
                for (int e = 0; e < 8; ++e) xc[e] += x[e] * cwr[k][e]; }
            u32x4 w; w.x = cvt_pk_bf16(xc[0], xc[1]); w.y = cvt_pk_bf16(xc[2], xc[3]); w.z = cvt_pk_bf16(xc[4], xc[5]); w.w = cvt_pk_bf16(xc[6], xc[7]);
            *(LAS u32x4*)(lds + LR_XA + t * 272 + ch * 16) = w;
            *(LAS f32x4*)(UU + t * 128 + ch * 8) = (f32x4){xc[0], xc[1], xc[2], xc[3]}; *(LAS f32x4*)(UU + t * 128 + ch * 8 + 4) = (f32x4){xc[4], xc[5], xc[6], xc[7]}; }
        __syncthreads();
        bf16_t* gp = zgb + (size_t)(row0 + (tid >> 7) * 16) * D + head * 128 + (tid & 127); bf16_t* go = zgo + (size_t)(row0 + (tid >> 7) * 16) * D + head * 128 + (tid & 127); bf16_t gv[16];
        if (PASS == 2) {
#pragma unroll
            for (int t = 0; t < 16; ++t) gv[t] = gp[(size_t)t * D]; }
        f32x16 ar, ai;
#pragma unroll
        for (int i = 0; i < 16; ++i) { ar[i] = 0.f; ai[i] = 0.f; }
#pragma unroll
        for (int s = 0; s < 8; ++s) { const bf16x8 a = *(const LAS bf16x8*)(lds + LR_XA + (tb * 32 + l31) * 272 + (16 * s + 8 * hh) * 2);
            ar = __builtin_amdgcn_mfma_f32_32x32x16_bf16(a, wr_f[s], ar, 0, 0, 0); ai = __builtin_amdgcn_mfma_f32_32x32x16_bf16(a, wi_f[s], ai, 0, 0, 0); }
#pragma unroll
        for (int i = 0; i < 16; ++i) { const int t = tb * 32 + crow(i, hh);
            const float r = sigm(ar[i] + br), ig = sigm(ai[i] + bi);
            const float la = -c8 * r; const float a0 = fexp(la);
            const float dr = bflo(cvt_pk_bf16(one_minus_exp(la, a0, wser), 0.f));
            const float a = 1.0f - dr; const float mult = __builtin_amdgcn_sqrtf(fmaxf(dr * (2.0f - dr), 0.f));
            const float xcv = UU[t * 128 + dl];
            const unsigned pk = cvt_pk_bf16(dr, mult * ig * xcv);
            UA[t * 128 + dl] = a; UU[t * 128 + dl] = bfhi(pk);
            if (PASS == 1) *(unsigned*)((char*)lau + ((size_t)(row0 + tb * 32 + (i & 3) + 8 * (i >> 2)) * D * 4) + lauoff) = pk; }
        __syncthreads();
        { const int d = tid & 127, seg = tid >> 7; float A = 1.f, H = 0.f;
#pragma unroll
          for (int t = 0; t < 16; ++t) { const float a = UA[(seg * 16 + t) * 128 + d], uu = UU[(seg * 16 + t) * 128 + d]; H = a * H + uu; A *= a; }
          SEG[(seg * 128 + d) * 2] = A; SEG[(seg * 128 + d) * 2 + 1] = H;
          __syncthreads();
          const int cb = tile & 1; float cA = CAR[(cb * 128 + d) * 2], cH = CAR[(cb * 128 + d) * 2 + 1];
          for (int s2 = 0; s2 < seg; ++s2) { const float a2 = SEG[(s2 * 128 + d) * 2], h2 = SEG[(s2 * 128 + d) * 2 + 1]; cH = a2 * cH + h2; cA *= a2; }
          if (PASS == 2) { float h = cH;
#pragma unroll
              for (int t = 0; t < 16; ++t) { const float a = UA[(seg * 16 + t) * 128 + d], uu = UU[(seg * 16 + t) * 128 + d]; h = a * h + uu;
                  const float g = bf1(gv[t]); go[(size_t)t * D] = f2bf(h * silu(g)); } }
          if (seg == 3) { CAR[((cb ^ 1) * 128 + d) * 2] = cA * A; CAR[((cb ^ 1) * 128 + d) * 2 + 1] = A * cH + H; }
        }
    }
    __syncthreads();
    if (PASS == 1) {
        if (tid < 128) { __hip_atomic_store(agg + ((size_t)item * 128 + tid) * 2, CAR[tid * 2], __ATOMIC_RELAXED, __HIP_MEMORY_SCOPE_AGENT); __hip_atomic_store(agg + ((size_t)item * 128 + tid) * 2 + 1, CAR[tid * 2 + 1], __ATOMIC_RELAXED, __HIP_MEMORY_SCOPE_AGENT); }
        asm volatile("s_waitcnt vmcnt(0)" ::: "memory");
        __syncthreads();
        if (tid == 0) __hip_atomic_store((unsigned*)(ws + WS_LFLAG) + 16 * item, pass_tag, __ATOMIC_RELAXED, __HIP_MEMORY_SCOPE_AGENT);
    }
    __syncthreads();
}
constexpr int L2_SA = 0, L2_SH = 16384, L2_CIN = 32768;
__device__ __forceinline__ void lru_pass2(KP p, LAS unsigned char* lds, int l, int item, unsigned pass_tag, bool dry = false) {
    const int tid = otid(), dg = tid & 15, seg = tid >> 4;
    const int e8 = item & 7, head = (item >> 3) & 7, bl = item >> 6;
    unsigned char* ws = ows(p->ws);
    bf16_t* zgb = (bf16_t*)(ws + WS_Z + 4 * ZSLOT); bf16_t* zgo = dry ? (bf16_t*)(ws + WS_H) : zgb; const unsigned* lau = (const unsigned*)(ws + WS_LAU); float* agg = (float*)(ws + WS_AGG);
    const int rowbase = bl * SEQ + e8 * 512;
    LAS float* SA = (LAS float*)(lds + L2_SA); LAS float* SH = (LAS float*)(lds + L2_SH); LAS float* CIN = (LAS float*)(lds + L2_CIN);
    if (tid < 64) {
        if (tid < e8) { unsigned sp = 0; while (__hip_atomic_load((unsigned*)(ws + WS_LFLAG) + 16 * (item - e8 + tid), __ATOMIC_RELAXED, __HIP_MEMORY_SCOPE_AGENT) != pass_tag) { __builtin_amdgcn_s_sleep(1); if (++sp > (1u << 22)) break; } }
        __builtin_amdgcn_fence(__ATOMIC_ACQUIRE, "agent");
        asm volatile("s_waitcnt vmcnt(0)" ::: "memory"); }
    __syncthreads();
    float carry = 0.f;
    if (tid < 128) { for (int e = 0; e < e8; ++e) { const float a2 = __hip_atomic_load(agg + ((size_t)(item - e8 + e) * 128 + tid) * 2, __ATOMIC_RELAXED, __HIP_MEMORY_SCOPE_AGENT), h2 = __hip_atomic_load(agg + ((size_t)(item - e8 + e) * 128 + tid) * 2 + 1, __ATOMIC_RELAXED, __HIP_MEMORY_SCOPE_AGENT); carry = a2 * carry + h2; } }
    u32x4 pk[4][2], pkn[4][2], gv[4], gn[4];
    { const size_t o = (size_t)(rowbase + seg * 4) * D + head * 128 + dg * 8;
#pragma unroll
      for (int t = 0; t < 4; ++t) { pkn[t][0] = *(const u32x4*)(lau + o + (size_t)t * D); pkn[t][1] = *(const u32x4*)(lau + o + (size_t)t * D + 4); gn[t] = *(const u32x4*)(zgb + o + (size_t)t * D); } }
    for (int tile = 0; tile < 4; ++tile) {
        const size_t o = (size_t)(rowbase + tile * 128 + seg * 4) * D + head * 128 + dg * 8;
#pragma unroll
        for (int t = 0; t < 4; ++t) { pk[t][0] = pkn[t][0]; pk[t][1] = pkn[t][1]; gv[t] = gn[t]; }
        if (tile + 1 < 4) {
#pragma unroll
            for (int t = 0; t < 4; ++t) { pkn[t][0] = *(const u32x4*)(lau + o + (size_t)(128 + t) * D); pkn[t][1] = *(const u32x4*)(lau + o + (size_t)(128 + t) * D + 4); gn[t] = *(const u32x4*)(zgb + o + (size_t)(128 + t) * D); } }
        float A[8], H[8];
#pragma unroll
        for (int e = 0; e < 8; ++e) { A[e] = 1.f; H[e] = 0.f; }
#pragma unroll
        for (int t = 0; t < 4; ++t)
#pragma unroll
            for (int e = 0; e < 8; ++e) { const unsigned w = pk[t][e >> 2][e & 3]; const float a = 1.0f - bflo(w); H[e] = a * H[e] + bfhi(w); A[e] *= a; }
        *(LAS f32x4*)(SA + seg * 128 + dg * 8) = (f32x4){A[0], A[1], A[2], A[3]}; *(LAS f32x4*)(SA + seg * 128 + dg * 8 + 4) = (f32x4){A[4], A[5], A[6], A[7]};
        *(LAS f32x4*)(SH + seg * 128 + dg * 8) = (f32x4){H[0], H[1], H[2], H[3]}; *(LAS f32x4*)(SH + seg * 128 + dg * 8 + 4) = (f32x4){H[4], H[5], H[6], H[7]};
        __syncthreads();
        if (tid < 128) {
#pragma unroll 8
            for (int s2 = 0; s2 < 32; ++s2) { CIN[s2 * 128 + tid] = carry; carry = SA[s2 * 128 + tid] * carry + SH[s2 * 128 + tid]; } }
        __syncthreads();
        const f32x4 c0 = *(const LAS f32x4*)(CIN + seg * 128 + dg * 8), c1 = *(const LAS f32x4*)(CIN + seg * 128 + dg * 8 + 4);
        float h[8] = {c0[0], c0[1], c0[2], c0[3], c1[0], c1[1], c1[2], c1[3]};
#pragma unroll
        for (int t = 0; t < 4; ++t) { float y[8]; const u32x4 g = gv[t]; const float g8[8] = {bflo(g.x), bfhi(g.x), bflo(g.y), bfhi(g.y), bflo(g.z), bfhi(g.z), bflo(g.w), bfhi(g.w)};
#pragma unroll
            for (int e = 0; e < 8; ++e) { const unsigned w = pk[t][e >> 2][e & 3]; h[e] = (1.0f - bflo(w)) * h[e] + bfhi(w); y[e] = h[e] * silu(g8[e]); }
            u32x4 w4; w4.x = cvt_pk_bf16(y[0], y[1]); w4.y = cvt_pk_bf16(y[2], y[3]); w4.z = cvt_pk_bf16(y[4], y[5]); w4.w = cvt_pk_bf16(y[6], y[7]);
            *(u32x4*)(zgo + o + (size_t)t * D) = w4; }
    }
    __syncthreads();
}
__device__ __forceinline__ void ln_stats(KP p) {
    const int tid = otid(), lane = tid & 63, wave = tid >> 6;
    unsigned char* ws = ows(p->ws);
    const bf16_t* zv = (const bf16_t*)(ws + WS_Z + 1 * ZSLOT); float* st = (float*)(ws + WS_STATS);
    const int bid = obid();
    for (int k = 0; k < 8; ++k) { const int row = bid * 64 + wave * 8 + k; if (row >= TC) break;
        const u32x4* r = (const u32x4*)(zv + (size_t)row * D) + lane; const u32x4 a = r[0], b = r[64];
        float x[16] = {bflo(a.x), bfhi(a.x), bflo(a.y), bfhi(a.y), bflo(a.z), bfhi(a.z), bflo(a.w), bfhi(a.w), bflo(b.x), bfhi(b.x), bflo(b.y), bfhi(b.y), bflo(b.z), bfhi(b.z), bflo(b.w), bfhi(b.w)};
        float s = 0.f;
#pragma unroll
        for (int i = 0; i < 16; ++i) s += x[i];
        const float mean = wave_sum(s) * (1.0f / D); float q = 0.f;
#pragma unroll
        for (int i = 0; i < 16; ++i) { const float d = x[i] - mean; q += d * d; }
        const float rstd = __builtin_amdgcn_rsqf(wave_sum(q) * (1.0f / D) + EPS);
        if (lane == 0) { st[row * 2] = mean; st[row * 2 + 1] = rstd; } }
}

constexpr int GM_LN = 36864;
constexpr int GM_SV = 40960;
__device__ __forceinline__ void gmlp_items(KP p, LAS unsigned char* lds, int l, int c, int G, bool dry = false) {
    const int tid = otid(), lane = tid & 63, wave = tid >> 6, l31 = lane & 31, hh = lane >> 5;
    unsigned char* ws = ows(p->ws);
    const int nitems = (TC / 128) * 8;
    if (c >= nitems) return;
    const int g = c & 7;
    bf16_t* zu = (bf16_t*)(ws + WS_Z); bf16_t* zuo = dry ? (bf16_t*)(ws + WS_H) : zu; const bf16_t* zv = (const bf16_t*)(ws + WS_Z + 1 * ZSLOT); const bf16_t* zga = (const bf16_t*)(ws + WS_Z + 2 * ZSLOT);
    const float* lnp = (const float*)(ws + WS_LNP);
    LAS float* LN = (LAS float*)(lds + GM_LN); LAS float* SV = (LAS float*)(lds + GM_SV);
    if (tid < 256) LN[tid] = (tid < 128) ? asglobal(p->in[I_LNG])[l * D + g * 128 + tid] : asglobal(p->in[I_LNB])[l * D + g * 128 + tid - 128];
    const int cb = wave & 3, ib0 = (wave >> 2) * 2;
    bf16x8 wf[2][8];
    { const bf16_t* wg = (const bf16_t*)(ws + WS_WG) + (size_t)(l * 8 + g) * 128 * 128;
#pragma unroll
      for (int q = 0; q < 2; ++q)
#pragma unroll
        for (int s = 0; s < 8; ++s) wf[q][s] = *(const bf16x8*)(wg + (size_t)((ib0 + q) * 32 + l31) * 128 + 16 * s + 8 * hh); }
    const int c8 = tid & 15, jt = tid >> 4;
    const float* bsp = asglobal(p->in[I_BS]) + (size_t)(l * 8 + g) * 128;
    u32x4 vq[4]; f32x2 pq[4];
    { const int row0 = (c >> 3) * 128;
#pragma unroll
      for (int k = 0; k < 4; ++k) { vq[k] = *(const u32x4*)(zv + (size_t)(row0 + jt + 32 * k) * D + g * 128 + c8 * 8); pq[k] = *(const f32x2*)(lnp + (size_t)(row0 + jt + 32 * k) * 32 + 2 * c8); } }
    __syncthreads();
    for (int item = c; item < nitems; item += G) {
        const int row0 = (item >> 3) * 128;
#pragma unroll
        for (int k = 0; k < 4; ++k) { const int j = jt + 32 * k; float ssum = pq[k].x, qsum = pq[k].y;
#pragma unroll
            for (int o = 1; o < 16; o <<= 1) { ssum += __shfl_xor(ssum, o); qsum += __shfl_xor(qsum, o); }
            const float mean = ssum * (1.0f / D), rstd = __builtin_amdgcn_rsqf(fmaxf(qsum * (1.0f / D) - mean * mean, 0.f) + EPS);
            const u32x4 v = vq[k];
            const float x[8] = {bflo(v.x), bfhi(v.x), bflo(v.y), bfhi(v.y), bflo(v.z), bfhi(v.z), bflo(v.w), bfhi(v.w)};
            const int colb = ((((j >> 3) ^ c8) & 15) * 8 + (j & 7)) * 2;
#pragma unroll
            for (int e = 0; e < 8; ++e) { const float y = (x[e] - mean) * rstd * LN[c8 * 8 + e] + LN[128 + c8 * 8 + e]; *(LAS bf16_t*)(lds + (c8 * 8 + e) * 272 + colb) = f2bf(y); } }
        __syncthreads();
        if (item + G < nitems) { const int rown = ((item + G) >> 3) * 128;
#pragma unroll
            for (int k = 0; k < 4; ++k) { vq[k] = *(const u32x4*)(zv + (size_t)(rown + jt + 32 * k) * D + g * 128 + c8 * 8); pq[k] = *(const f32x2*)(lnp + (size_t)(rown + jt + 32 * k) * 32 + 2 * c8); } }
        u32x4 uq[4]; float bq[4];
#pragma unroll
        for (int k = 0; k < 4; ++k) { const size_t off = (size_t)(row0 + jt + 32 * k) * D + g * 128 + c8 * 8; uq[k] = *(const u32x4*)(zu + off); bq[k] = bsp[jt + 32 * k]; }
        f32x16 acc[2];
#pragma unroll
        for (int q = 0; q < 2; ++q)
#pragma unroll
            for (int i = 0; i < 16; ++i) acc[q][i] = 0.f;
#pragma unroll
        for (int s = 0; s < 8; ++s) { const int ch = cb * 32 + l31; const bf16x8 a = *(const LAS bf16x8*)(lds + ch * 272 + ((((2 * s + hh) ^ (ch >> 3)) & 15) * 16));
#pragma unroll
            for (int q = 0; q < 2; ++q) acc[q] = __builtin_amdgcn_mfma_f32_32x32x16_bf16(a, wf[q][s], acc[q], 0, 0, 0); }
#pragma unroll
        for (int q = 0; q < 2; ++q)
#pragma unroll
            for (int rg = 0; rg < 4; ++rg) *(LAS f32x4*)(SV + ((ib0 + q) * 32 + l31) * 132 + cb * 32 + 8 * rg + 4 * hh) = (f32x4){acc[q][4 * rg], acc[q][4 * rg + 1], acc[q][4 * rg + 2], acc[q][4 * rg + 3]};
        __syncthreads();
#pragma unroll
        for (int k = 0; k < 4; ++k) { const int i = jt + 32 * k; const size_t off = (size_t)(row0 + i) * D + g * 128 + c8 * 8;
            const f32x4 s0 = *(const LAS f32x4*)(SV + i * 132 + c8 * 8), s1 = *(const LAS f32x4*)(SV + i * 132 + c8 * 8 + 4);
            const float sv[8] = {s0[0], s0[1], s0[2], s0[3], s1[0], s1[1], s1[2], s1[3]};
            const u32x4 uu = uq[k];
            const float u8[8] = {bflo(uu.x), bfhi(uu.x), bflo(uu.y), bfhi(uu.y), bflo(uu.z), bfhi(uu.z), bflo(uu.w), bfhi(uu.w)};
            float y[8];
#pragma unroll
            for (int e = 0; e < 8; ++e) y[e] = u8[e] * (sv[e] + bq[k]);
            u32x4 w; w.x = cvt_pk_bf16(y[0], y[1]); w.y = cvt_pk_bf16(y[2], y[3]); w.z = cvt_pk_bf16(y[4], y[5]); w.w = cvt_pk_bf16(y[6], y[7]);
            *(u32x4*)(zuo + off) = w; }
    }
    __syncthreads();
}

constexpr int AT_STRIDE = 528;
__device__ __forceinline__ void attn_item(KP p, LAS unsigned char* lds, int l, int chunk, int item, bool dry = false) {
    const int tid = otid(), lane = tid & 63, wave = tid >> 6, l31 = lane & 31, hh = lane >> 5;
    const int tile = item & 15, hd = (item >> 4) & 3, bl = item >> 6, bg = chunk * BPC + bl;
    unsigned char* ws = ows(p->ws);
    const bf16_t* zq = (const bf16_t*)(ws + WS_Z + 5 * ZSLOT); bf16_t* zgc = (bf16_t*)(ws + WS_Z + 6 * ZSLOT); bf16_t* zgco = dry ? (bf16_t*)(ws + WS_H) : zgc;
    const bf16_t* KM = (const bf16_t*)(ws + WS_KM) + (size_t)l * MROWS * D + (size_t)bg * MEML * D + hd * 256;
    const bf16_t* VT = (const bf16_t*)(ws + WS_VT) + (size_t)l * D * MROWS + (size_t)hd * 256 * MROWS + bg * MEML;
    const int trow = bl * SEQ + tile * 256 + wave * 32 + l31;
    const bf16_t* qp = zq + (size_t)trow * D + hd * 256 + 8 * hh;
    const unsigned koff = (unsigned)((tid >> 5) * D + (tid & 31) * 8) * 2u, voff = (unsigned)((tid >> 5) * MROWS + (tid & 31) * 8) * 2u;
    const unsigned loff = (unsigned)((tid >> 5) * AT_STRIDE + (tid & 31) * 16);
#pragma unroll
    for (int k = 0; k < 16; ++k) *(LAS u32x4*)(lds + loff + k * 16 * AT_STRIDE) = *(const u32x4*)((const char*)KM + (size_t)k * 16 * D * 2 + koff);
    __syncthreads();
    const float k2 = 0.0625f * 1.44269504089f;
    bf16x8 pf[8][2];
    u32x4 vpre[8];
    float mA = 0.f, sumA = 0.f, alphaA = 1.f, sum = 0.f;
#pragma unroll
    for (int half = 0; half < 2; ++half) {
        f32x16 sc[4];
#pragma unroll
        for (int mb = 0; mb < 4; ++mb)
#pragma unroll
            for (int i = 0; i < 16; ++i) sc[mb][i] = 0.f;
        bf16x8 qc[4], qn[4];
#pragma unroll
        for (int s4 = 0; s4 < 4; ++s4) qc[s4] = *(const bf16x8*)(qp + 16 * s4);
#pragma unroll 1
        for (int sg = 0; sg < 4; ++sg) {
            if (sg < 3) {
#pragma unroll
                for (int s4 = 0; s4 < 4; ++s4) qn[s4] = *(const bf16x8*)(qp + 64 * (sg + 1) + 16 * s4); }
#pragma unroll
            for (int s4 = 0; s4 < 4; ++s4)
#pragma unroll
                for (int mb = 0; mb < 4; ++mb) { const bf16x8 a = *(const LAS bf16x8*)(lds + (half * 128 + mb * 32 + l31) * AT_STRIDE + (64 * sg + 16 * s4 + 8 * hh) * 2);
                    sc[mb] = __builtin_amdgcn_mfma_f32_32x32x16_bf16(a, qc[s4], sc[mb], 0, 0, 0); }
#pragma unroll
            for (int s4 = 0; s4 < 4; ++s4) qc[s4] = qn[s4];
        }
        if (half == 1) {
            __builtin_amdgcn_sched_barrier(0);
#pragma unroll
            for (int k = 0; k < 8; ++k) vpre[k] = *(const u32x4*)((const char*)VT + (size_t)k * 16 * MROWS * 2 + voff); }
        float mh = -3.0e38f;
#pragma unroll
        for (int mb = 0; mb < 4; ++mb)
#pragma unroll
            for (int i = 0; i < 16; ++i) mh = fmaxf(mh, sc[mb][i]);
        mh = fmaxf(mh, __shfl_xor(mh, 32));
        float mref;
        if (half == 0) { mA = mh; mref = mh; } else { mref = fmaxf(mA, mh); alphaA = __builtin_amdgcn_exp2f((mA - mref) * k2); }
        float sh = 0.f;
#pragma unroll
        for (int mb = 0; mb < 4; ++mb) {
#pragma unroll
            for (int i = 0; i < 16; ++i) { const float e = __builtin_amdgcn_exp2f((sc[mb][i] - mref) * k2); sc[mb][i] = e; sh += e; }
#pragma unroll
            for (int s2 = 0; s2 < 2; ++s2) { u32x4 w;
                w.x = cvt_pk_bf16(sc[mb][8 * s2 + 0], sc[mb][8 * s2 + 1]); w.y = cvt_pk_bf16(sc[mb][8 * s2 + 2], sc[mb][8 * s2 + 3]);
                w.z = cvt_pk_bf16(sc[mb][8 * s2 + 4], sc[mb][8 * s2 + 5]); w.w = cvt_pk_bf16(sc[mb][8 * s2 + 6], sc[mb][8 * s2 + 7]);
                pf[half * 4 + mb][s2] = __builtin_bit_cast(bf16x8, w); } }
        sh += __shfl_xor(sh, 32);
        if (half == 0) sumA = sh; else sum = sumA * alphaA + sh;
    }
    const float inv = frcp(sum);
    __syncthreads();
#pragma unroll
    for (int k = 0; k < 8; ++k) *(LAS u32x4*)(lds + loff + k * 16 * AT_STRIDE) = vpre[k];
#pragma unroll
    for (int k = 8; k < 16; ++k) *(LAS u32x4*)(lds + loff + k * 16 * AT_STRIDE) = *(const u32x4*)((const char*)VT + (size_t)k * 16 * MROWS * 2 + voff);
    u32x4 gcr[4][2];
    { const size_t off0 = (size_t)trow * D + hd * 256 + 8 * hh;
#pragma unroll
      for (int b4 = 0; b4 < 4; ++b4)
#pragma unroll
        for (int k = 0; k < 2; ++k) gcr[b4][k] = *(const u32x4*)(zgc + off0 + b4 * 32 + 16 * k); }
    __syncthreads();
#pragma unroll
    for (int db = 0; db < 8; ++db) { f32x16 o; u32x4 gc[2];
#pragma unroll
        for (int k = 0; k < 2; ++k) gc[k] = gcr[db & 3][k];
        if (db < 4) { const size_t off1 = (size_t)trow * D + hd * 256 + (db + 4) * 32 + 8 * hh;
#pragma unroll
            for (int k = 0; k < 2; ++k) gcr[db & 3][k] = *(const u32x4*)(zgc + off1 + 16 * k); }
#pragma unroll
        for (int i = 0; i < 16; ++i) o[i] = 0.f;
#pragma unroll
        for (int mb = 0; mb < 8; ++mb) {
            if (mb == 4) {
#pragma unroll
                for (int i = 0; i < 16; ++i) o[i] *= alphaA; }
#pragma unroll
            for (int s2 = 0; s2 < 2; ++s2) { const LAS unsigned char* vp = lds + (db * 32 + l31) * AT_STRIDE + (mb * 32 + 16 * s2 + 4 * hh) * 2;
                const s16x4 lo = *(const LAS s16x4*)vp, hi = *(const LAS s16x4*)(vp + 16);
                const bf16x8 a = __builtin_shufflevector(lo, hi, 0, 1, 2, 3, 4, 5, 6, 7);
                o = __builtin_amdgcn_mfma_f32_32x32x16_bf16(a, pf[mb][s2], o, 0, 0, 0); } }
#pragma unroll
        for (int k = 0; k < 2; ++k) { float v8[8];
#pragma unroll
            for (int j = 0; j < 4; ++j) { typedef unsigned u2v __attribute__((ext_vector_type(2)));
                const u2v sw = __builtin_amdgcn_permlane32_swap(__float_as_uint(o[8 * k + j]), __float_as_uint(o[8 * k + 4 + j]), false, false);
                v8[j] = __uint_as_float(sw[0]); v8[4 + j] = __uint_as_float(sw[1]); }
            const u32x4 g = gc[k]; const float g8[8] = {bflo(g.x), bfhi(g.x), bflo(g.y), bfhi(g.y), bflo(g.z), bfhi(g.z), bflo(g.w), bfhi(g.w)};
            float y[8];
#pragma unroll
            for (int e = 0; e < 8; ++e) y[e] = v8[e] * inv * silu(g8[e]);
            u32x4 w; w.x = cvt_pk_bf16(y[0], y[1]); w.y = cvt_pk_bf16(y[2], y[3]); w.z = cvt_pk_bf16(y[4], y[5]); w.w = cvt_pk_bf16(y[6], y[7]);
            *(u32x4*)(zgco + (size_t)trow * D + hd * 256 + db * 32 + 16 * k + 8 * hh) = w; } }
    __syncthreads();
}

__device__ __forceinline__ void row_phase(KP p, int l, int chunk, bool dry = false) {
    const int tid = otid(), lane = tid & 63, wave = tid >> 6;
    const int gw = obid() * 8 + wave, NGW = ogrid() * 8;
    unsigned char* ws = ows(p->ws);
    const float* outf = (const float*)(ws + WS_Z);
    const float* xsrc = (l == 0) ? asglobal(p->in[I_X]) : asglobal(p->out);
    const float* gpost = asglobal(p->in[I_POSTG]) + l * D; const float* gpre = asglobal(p->in[I_PREG]) + (l + 1 < DEPTH ? l + 1 : 0) * D;
    bf16_t* H = dry ? (bf16_t*)(ws + WS_Z + 4 * ZSLOT) : (bf16_t*)(ws + WS_H);
    float* xout = dry ? (float*)(ws + WS_Z + 2 * ZSLOT) - (size_t)chunk * TC * D : asglobal(p->out);
    for (int r = gw; r < TC; r += NGW) {
        const size_t grow = (size_t)chunk * TC + r;
        const f32x4* orow = (const f32x4*)(outf + (size_t)r * D) + lane; const f32x4* xr = (const f32x4*)(xsrc + grow * D) + lane;
        f32x4 o[4], x[4]; float s = 0.f;
#pragma unroll
        for (int j = 0; j < 4; ++j) { o[j] = orow[64 * j]; x[j] = xr[64 * j]; s += (o[j].x * o[j].x + o[j].y * o[j].y) + (o[j].z * o[j].z + o[j].w * o[j].w); }
        const float r1 = __builtin_amdgcn_rsqf(wave_sum(s) * (1.0f / D) + EPS); float s2 = 0.f;
        f32x4* xo = (f32x4*)(xout + grow * D) + lane;
#pragma unroll
        for (int j = 0; j < 4; ++j) { const f32x4 gv = ((const f32x4*)gpost)[lane + 64 * j]; x[j] = x[j] + o[j] * r1 * gv; xo[64 * j] = x[j];
            s2 += (x[j].x * x[j].x + x[j].y * x[j].y) + (x[j].z * x[j].z + x[j].w * x[j].w); }
        if (l + 1 < DEPTH) {
            const float r2 = __builtin_amdgcn_rsqf(wave_sum(s2) * (1.0f / D) + EPS); u32x2* h8 = (u32x2*)(H + (size_t)r * D) + lane;
#pragma unroll
            for (int j = 0; j < 4; ++j) { const f32x4 gv = ((const f32x4*)gpre)[lane + 64 * j]; u32x2 w; w.x = cvt_pk_bf16(x[j].x * r2 * gv.x, x[j].y * r2 * gv.y); w.y = cvt_pk_bf16(x[j].z * r2 * gv.z, x[j].w * r2 * gv.w); h8[64 * j] = w; }
        } else if (chunk + 1 < NCH) {
            rms_row_to_bf16(asglobal(p->in[I_X]) + ((size_t)(chunk + 1) * TC + r) * D, asglobal(p->in[I_PREG]), H + (size_t)r * D, lane);
        }
    }
}

#define XB_TMO      128
#define XB_XCNT(j)  (256  + 64 * (j))
#define XB_XSUB(j)  (1280 + 64 * (j))
#define XB_XGEN(j)  (2304 + 64 * (j))
#define XB_TOP      3328
#define XB_TOPGEN   3392
#define XCD_BAR_WORDS 3456
#define XB_SPIN_CAP (1u << 22)
__device__ __forceinline__ unsigned xb_ld(unsigned* p)              { return __hip_atomic_load(p, __ATOMIC_RELAXED, __HIP_MEMORY_SCOPE_AGENT); }
__device__ __forceinline__ unsigned xb_add(unsigned* p, unsigned v) { return __hip_atomic_fetch_add(p, v, __ATOMIC_RELAXED, __HIP_MEMORY_SCOPE_AGENT); }
__device__ __forceinline__ unsigned xb_xcc_id() { return (unsigned)__builtin_amdgcn_s_getreg((3 << 11) | 20) & 0xFu; }
#define XB_SPIN(cond, bar) do { unsigned _sp = 0; while (cond) { __builtin_amdgcn_s_sleep(1); \
    if ((++_sp & 255u) == 0u) { if (xb_ld(&(bar)[XB_TMO])) break; if (_sp > XB_SPIN_CAP) { atomicAdd(&(bar)[XB_TMO], 1u); break; } } } } while (0)
struct XcdBarrier { unsigned* bar; unsigned x; volatile LAS unsigned* st; };
__device__ __forceinline__ XcdBarrier xcd_barrier_post(unsigned* bar, volatile LAS unsigned* st) {
    XcdBarrier b; b.bar = bar; b.x = xb_xcc_id(); b.st = st;
    if (threadIdx.x == 0) (void)xb_add(&bar[XB_XCNT(b.x)], 1u);
    return b;
}
__device__ __forceinline__ void xcd_barrier_complete(unsigned* bar, unsigned x, unsigned& nloc, unsigned& nx) {
    const unsigned G = gridDim.x * gridDim.y * gridDim.z;
    unsigned sum, cnt, mine, sp = 0u;
    for (;;) {
        sum = 0u; cnt = 0u; mine = 0u;
#pragma unroll
        for (unsigned j = 0; j < 16; ++j) { const unsigned c = xb_ld(&bar[XB_XCNT(j)]); sum += c; cnt += (c > 0u) ? 1u : 0u; mine = (j == x) ? c : mine; }
        if (sum == G) break;
        __builtin_amdgcn_s_sleep(1);
        if ((++sp & 255u) == 0u) { if (xb_ld(&bar[XB_TMO])) break; if (sp > XB_SPIN_CAP) { atomicAdd(&bar[XB_TMO], 1u); break; } }
    }
    nloc = mine > 0u ? mine : 1u; nx = cnt > 0u ? cnt : 1u;
}
__device__ __forceinline__ void xcd_barrier(const XcdBarrier& b) {
    asm volatile("s_waitcnt vmcnt(0)" ::: "memory");
    __syncthreads();
    if (threadIdx.x == 0) {
        unsigned* bar = (unsigned*)ows((unsigned char*)b.bar);
        __builtin_amdgcn_s_waitcnt(0);
        unsigned nloc = b.st[0], nx = b.st[1];
        if (nloc == 0u) { xcd_barrier_complete(bar, b.x, nloc, nx); b.st[0] = nloc; b.st[1] = nx; }
        const unsigned old = xb_add(&bar[XB_XSUB(b.x)], 1u);
        const unsigned gen = old / nloc;
        if (old + 1u == (gen + 1u) * nloc) {
            __builtin_amdgcn_fence(__ATOMIC_RELEASE, "agent");
            asm volatile("s_waitcnt vmcnt(0)" ::: "memory");
            const unsigned og = xb_add(&bar[XB_TOP], 1u);
            const unsigned tg = og / nx;
            if (og + 1u == (tg + 1u) * nx) xb_add(&bar[XB_TOPGEN], 1u);
            else XB_SPIN(xb_ld(&bar[XB_TOPGEN]) == tg, bar);
            __builtin_amdgcn_fence(__ATOMIC_ACQUIRE, "agent");
            xb_add(&bar[XB_XGEN(b.x)], 1u);
            asm volatile("s_waitcnt vmcnt(0)" ::: "memory");
        } else {
            XB_SPIN(xb_ld(&bar[XB_XGEN(b.x)]) == gen, bar);
            __builtin_amdgcn_fence(__ATOMIC_ACQUIRE, "agent");
            asm volatile("s_waitcnt vmcnt(0)" ::: "memory");
        }
    }
    __syncthreads();
}

constexpr int N_PHASES = 2 + NCH * DEPTH * 4;
__global__ void __launch_bounds__(NTHR, 2) mk_fwd(Params pk) {
    extern __shared__ __attribute__((aligned(16))) unsigned char lds_raw[];
    LAS unsigned char* lds = (LAS unsigned char*)lds_raw;
    unsigned char* ws = pk.ws;
    int G = gridDim.x, c = blockIdx.x;
    volatile LAS unsigned* bst = (volatile LAS unsigned*)(lds + LDS_BYTES - 64);
    if (threadIdx.x < 2) bst[threadIdx.x] = 0u;
    __syncthreads();
    XcdBarrier bar; bar.bar = (unsigned*)(ws + WS_BAR); bar.x = 0; bar.st = bst;
    if (pk.ph_hi - pk.ph_lo > 1) bar = xcd_barrier_post((unsigned*)(ws + WS_BAR), bst);
    const int ph_hi = pk.ph_hi;
    for (int ph = pk.ph_lo; ph < ph_hi; ++ph) {
        KP p = (KP)__builtin_amdgcn_kernarg_segment_ptr(); asm volatile("" : "+s"(p));
        ws = ows(ws); asm volatile("" : "+s"(G), "+s"(c));
        if (ph == 0) { if constexpr ((PH_MASK & 1) != 0) phase_prologue(p, lds); }
        else if (ph == 1) { if constexpr ((PH_MASK & 2) != 0) {
            pg8::SchedKV S{(const char*)(ws + WS_MEMN), (const char*)(ws + WS_WKV), G, c};
            pg8::EpiKV E{(bf16_t*)(ws + WS_KM), (bf16_t*)(ws + WS_VT)};
            pg8::gemm_phase<pg8::EpiKV, pg8::SchedKV, true>(lds, D, S, E); }
        } else {
            const int s = (ph - 2) / 4, k = (ph - 2) % 4, chunk = s / DEPTH, l = s % DEPTH;
            for (int rep = 0; rep < (((DBL >> k) & 1) ? 2 : 1); ++rep) {
            if (rep) xcd_barrier(bar);
            if (k == 0) { if constexpr ((PH_MASK & 4) != 0) {
                pg8::SchedGrid S{(const char*)(ws + WS_H), (const char*)(ws + WS_WIN) + (size_t)l * INW * D * 2, TC / 256, INW / 256, (TC / 256) * (INW / 256), G, c, (size_t)256 * D * 2};
                pg8::EpiBf16 E{(bf16_t*)(ws + WS_Z), D, (size_t)TC * D, 1, (const float*)nullptr, (float*)(ws + WS_LNP)};
                pg8::gemm_phase<pg8::EpiBf16, pg8::SchedGrid, true>(lds, D, S, E); }
            } else if (k == 1) {
                if constexpr ((DRYM & 1) != 0) for (int it = c; it < 256; it += G) lru_item<1>(p, lds, l, it, (unsigned)(s + 1));
                if constexpr ((PH_MASK & 8) != 0) for (int it = c; it < 256; it += G) lru_item<1>(p, lds, l, it, (unsigned)(s + 1));
                if constexpr ((DRYM & 2) != 0) gmlp_items(p, lds, l, c, G, true);
                if constexpr ((PH_MASK & 32) != 0) gmlp_items(p, lds, l, c, G);
                if constexpr ((DRYM & 4) != 0) for (int it = c; it < 256; it += G) attn_item(p, lds, l, chunk, it, true);
                if constexpr ((PH_MASK & 64) != 0) for (int it = c; it < 256; it += G) attn_item(p, lds, l, chunk, it);
                if constexpr ((DRYM & 8) != 0) for (int it = c; it < 256; it += G) lru_pass2(p, lds, l, it, (unsigned)(s + 1), true);
                if constexpr ((PH_MASK & 16) != 0) for (int it = c; it < 256; it += G) lru_pass2(p, lds, l, it, (unsigned)(s + 1));
            } else if (k == 2) { if constexpr ((PH_MASK & 128) != 0) {
                pg8::SchedMerge S{(const char*)(ws + WS_Z), (const char*)(ws + WS_WP) + (size_t)l * 3 * D * D * 2, G, c};
                pg8::EpiMerge E{(const bf16_t*)(ws + WS_Z + 7 * ZSLOT), (bf16_t*)(ws + WS_Z + 5 * ZSLOT)};
                pg8::gemm_phase<pg8::EpiMerge, pg8::SchedMerge, true>(lds, D, S, E); }
            } else { if constexpr ((PH_MASK & 256) != 0) {
                const bool lastl = (l + 1 == DEPTH);
                pg8::SchedGrid S{(const char*)(ws + WS_Z + 5 * ZSLOT), (const char*)(ws + WS_WOUT) + (size_t)l * D * D * 2, TC / 256, 4, (TC / 256) * 4, G, c, (size_t)256 * D * 2};
                pg8::EpiOutNorm E{(l == 0 ? asglobal(p->in[I_X]) : asglobal(p->out)) + (size_t)chunk * TC * D, asglobal(p->out) + (size_t)chunk * TC * D, lastl ? (bf16_t*)nullptr : (bf16_t*)(ws + WS_H),
                                  asglobal(p->in[I_POSTG]) + l * D, asglobal(p->in[I_PREG]) + (lastl ? 0 : l + 1) * D, (float*)(ws + WS_SS1), (float*)(ws + WS_SS2),
                                  (unsigned*)(ws + WS_PCNT), 4u * (unsigned)(s + 1), (unsigned*)(ws + WS_PCNT2), 4u * (unsigned)(chunk * (DEPTH - 1) + l + 1)};
                pg8::gemm_phase<pg8::EpiOutNorm, pg8::SchedGrid, true>(lds, D, S, E);
                if (lastl && chunk + 1 < NCH) {
                    const int wave = otid() >> 6, lane = otid() & 63;
                    for (int m = c * 8 + wave; m < TC; m += G * 8) rms_row_to_bf16(asglobal(p->in[I_X]) + ((size_t)(chunk + 1) * TC + m) * D, asglobal(p->in[I_PREG]), (bf16_t*)(ws + WS_H) + (size_t)m * D, lane);
                } } }
            }
        }
        if (ph + 1 < ph_hi) { if (ph_hi == -12345) cg::this_grid().sync();
                              xcd_barrier(bar); }
    }
}

extern "C" void kernel_launch(void* const* d_in, const int* in_sizes, int n_in, void* d_out, int out_size, void* d_ws, size_t ws_size, hipStream_t stream) {
    static int grid = 0;
    if (grid == 0) {
        if (n_in != 22 || out_size != NT * D || ws_size < WS_END) { fprintf(stderr, "kernel_launch: unexpected problem (n_in %d, out %d, ws %zu < %zu)\n", n_in, out_size, ws_size, (size_t)WS_END); grid = -1; return; }
        if (hipFuncSetAttribute((const void*)mk_fwd, hipFuncAttributeMaxDynamicSharedMemorySize, LDS_BYTES) != hipSuccess) { fprintf(stderr, "kernel_launch: hipFuncSetAttribute failed\n"); grid = -1; return; }
        int dev = 0, cus = 0, per_cu = 0;
        (void)hipGetDevice(&dev); (void)hipDeviceGetAttribute(&cus, hipDeviceAttributeMultiprocessorCount, dev);
        (void)hipOccupancyMaxActiveBlocksPerMultiprocessor(&per_cu, (const void*)mk_fwd, NTHR, LDS_BYTES);
        (void)hipGetLastError();
        grid = cus > 0 ? cus : 256;
        if (per_cu < 1) fprintf(stderr, "kernel_launch: occupancy query says %d blocks per CU\n", per_cu);
    }
    if (grid < 0) return;
    Params p{};
    for (int i = 0; i < 22; ++i) p.in[i] = (const float*)d_in[i];
    p.out = (float*)d_out; p.ws = (unsigned char*)d_ws;
#if MK_MULTI
    for (int ph = 0; ph < N_PHASES; ++ph) { p.ph_lo = ph; p.ph_hi = ph + 1; hipLaunchKernelGGL(mk_fwd, dim3(grid), dim3(NTHR), LDS_BYTES, stream, p); }
#else
    p.ph_lo = 0; p.ph_hi = N_PHASES;
    (void)hipMemsetAsync((char*)d_ws + WS_BAR, 0, WS_ZERO_END - WS_BAR, stream);
    void* args[] = {&p};
    hipError_t e = hipLaunchCooperativeKernel((const void*)mk_fwd, dim3(grid), dim3(NTHR), args, LDS_BYTES, stream);
    if (e != hipSuccess) fprintf(stderr, "cooperative launch failed: %s (grid %d)\n", hipGetErrorString(e), grid);
#endif
}
```
